# Optimizing an MI355X kernel written in HIP

```python
import jax, jax.numpy as jnp
from jax import lax
import numpy as np

D_MODEL = 1024
BATCH = 8
SEQ = 8192
DEPTH = 1

M_HEADS = 4
M_HEAD_DIM = D_MODEL // M_HEADS
M_WIDTH = M_HEADS * M_HEAD_DIM
M_CHUNK = 64
CONV_WIDTH = 4
F_HEADS = 8
F_HEAD_DIM = D_MODEL // F_HEADS
F_WIDTH = F_HEADS * F_HEAD_DIM
Q_BLOCK = 128
IN_SIZES = (M_WIDTH, M_WIDTH, M_WIDTH, M_WIDTH, M_HEADS, M_HEADS,
            F_WIDTH, F_WIDTH, F_WIDTH, F_HEADS, D_MODEL, D_MODEL)
D_IN = sum(IN_SIZES)
P_HEADS = 8
P_KEYS = 128
N_EXPERTS = P_KEYS * P_KEYS
P_TOPK = 16
P_QDIM = 256
P_HALF = P_QDIM // 2
P_CHUNK = 128
EPS = 1e-6
M_INIT = -1e30

kernel_name = 'hybrid_mlstm_fox_peer_block'


def rmsnorm(x, g):
    xf = x.astype(jnp.float32)
    r = lax.rsqrt(jnp.mean(xf * xf, axis=-1, keepdims=True) + EPS)
    return (xf * r).astype(x.dtype) * g


def to_heads(a, n_heads):
    B, T, _ = a.shape
    return a.reshape(B, T, n_heads, -1).transpose(0, 2, 1, 3)


def from_heads(a):
    B, H, T, dh = a.shape
    return a.transpose(0, 2, 1, 3).reshape(B, T, H * dh)


def causal_conv(x, w):
    T = x.shape[1]
    xp = jnp.pad(x, ((0, 0), (CONV_WIDTH - 1, 0), (0, 0)))
    out = xp[:, 0:T] * w[0]
    for j in range(1, CONV_WIDTH):
        out = out + xp[:, j:j + T] * w[j]
    return out


def mlstm_chunkwise(q, k, v, i_pre, f_pre):
    B, H, T, dh = q.shape
    L = M_CHUNK
    NC = T // L
    q = q.astype(jnp.float32) * (dh ** -0.5)
    k = k.astype(jnp.float32)
    v = v.astype(jnp.float32)
    i_pre = i_pre.astype(jnp.float32)
    logf = jax.nn.log_sigmoid(f_pre.astype(jnp.float32))

    def chunks(a):
        return jnp.moveaxis(a.reshape((B, H, NC, L) + a.shape[3:]), 2, 0)

    causal = jnp.tril(jnp.ones((L, L), dtype=bool))

    def step(carry, inp):
        C, n, m = carry
        q_, k_, v_, i_, lf = inp
        b = jnp.cumsum(lf, axis=-1)
        g = b[..., -1]
        D = b[..., :, None] - b[..., None, :] + i_[..., None, :]
        D = jnp.where(causal, D, -jnp.inf)
        inter = b + m[..., None]
        m_t = jnp.maximum(jnp.max(D, axis=-1), inter)
        S = jnp.einsum('bhtd,bhsd->bhts', q_, k_) * jnp.exp(D - m_t[..., None])
        w_inter = jnp.exp(inter - m_t)
        num = jnp.einsum('bhts,bhse->bhte', S, v_) + w_inter[..., None] * jnp.einsum('bhtd,bhde->bhte', q_, C)
        den = jnp.sum(S, axis=-1) + w_inter * jnp.einsum('bhtd,bhd->bht', q_, n)
        h = num / jnp.maximum(jnp.abs(den), jnp.exp(-m_t))[..., None]
        log_w = g[..., None] - b + i_
        m_new = jnp.maximum(g + m, jnp.max(log_w, axis=-1))
        w_s = jnp.exp(log_w - m_new[..., None])
        decay = jnp.exp(g + m - m_new)
        C_new = decay[..., None, None] * C + jnp.einsum('bhs,bhsd,bhse->bhde', w_s, k_, v_)
        n_new = decay[..., None] * n + jnp.einsum('bhs,bhsd->bhd', w_s, k_)
        return (C_new, n_new, m_new), h

    init = (jnp.zeros((B, H, dh, dh), jnp.float32),
            jnp.zeros((B, H, dh), jnp.float32),
            jnp.full((B, H), M_INIT, jnp.float32))
    _, hs = lax.scan(step, init, (chunks(q), chunks(k), chunks(v), chunks(i_pre), chunks(logf)))
    return jnp.moveaxis(hs, 0, 2).reshape(B, H, T, dh)


def forgetting_attention(q, k, v, logf):
    B, H, T, dh = q.shape
    NQ = T // Q_BLOCK
    c = jnp.cumsum(logf, axis=-1)
    kpos = jnp.arange(T)
    scale = dh ** -0.5

    def block(i):
        start = i * Q_BLOCK
        qb = lax.dynamic_slice_in_dim(q, start, Q_BLOCK, axis=2)
        cb = lax.dynamic_slice_in_dim(c, start, Q_BLOCK, axis=2)
        s = jnp.einsum('bhqd,bhkd->bhqk', qb, k).astype(jnp.float32) * scale
        s = s + cb[..., :, None] - c[..., None, :]
        qpos = start + jnp.arange(Q_BLOCK)
        s = jnp.where(qpos[:, None] >= kpos[None, :], s, -jnp.inf)
        p = jax.nn.softmax(s, axis=-1)
        return jnp.einsum('bhqk,bhkd->bhqd', p.astype(v.dtype), v)

    out = lax.map(block, jnp.arange(NQ))
    return jnp.moveaxis(out, 0, 2).reshape(B, H, T, dh)


def peer(xn, w_pq, sub_keys, u_tab, v_tab):
    B, T, D = xn.shape
    qh = jnp.einsum('btd,de->bte', xn, w_pq).reshape(B, T, P_HEADS, 2, P_HALF)
    s = jnp.einsum('bthcd,hcnd->bthcn', qh, sub_keys).astype(jnp.float32)
    vals, idx = lax.top_k(s, P_TOPK)
    cand = vals[..., 0, :, None] + vals[..., 1, None, :]
    cand_id = idx[..., 0, :, None] * P_KEYS + idx[..., 1, None, :]
    cand = cand.reshape(B, T, P_HEADS, P_TOPK * P_TOPK)
    cand_id = cand_id.reshape(B, T, P_HEADS, P_TOPK * P_TOPK)
    top_s, pos = lax.top_k(cand, P_TOPK)
    ids = jnp.take_along_axis(cand_id, pos, axis=-1)
    gate = jax.nn.softmax(top_s, axis=-1)
    NC = T // P_CHUNK
    HK = P_HEADS * P_TOPK
    xc = jnp.moveaxis(xn.reshape(B, NC, P_CHUNK, D), 1, 0)
    ic = jnp.moveaxis(ids.reshape(B, NC, P_CHUNK, HK), 1, 0)
    gc = jnp.moveaxis(gate.reshape(B, NC, P_CHUNK, HK), 1, 0)

    def chunk(args):
        xb, ib, gb = args
        u = u_tab[ib]
        a = jax.nn.gelu(jnp.einsum('bcd,bced->bce', xb, u), approximate=False)
        v = v_tab[ib]
        return jnp.einsum('bce,bced->bcd', (gb * a).astype(v.dtype), v)

    out = lax.map(chunk, (xc, ic, gc))
    return jnp.moveaxis(out, 0, 1).reshape(B, T, D)


def setup_inputs(seed: int = 0) -> dict:
    key = jax.random.key(seed)
    ks = jax.random.split(key, 20)

    def nrm(k, shape, s):
        return s * jax.random.normal(k, shape, jnp.float32)

    L = DEPTH
    offs = [int(o) for o in np.cumsum((0,) + IN_SIZES)]
    x = nrm(ks[0], (BATCH, SEQ, D_MODEL), 1.0)
    norm1_g = 1.0 + nrm(ks[1], (L, D_MODEL), 0.02)
    w_in = nrm(ks[2], (L, D_MODEL, D_IN), D_MODEL ** -0.5)
    b_in = nrm(ks[3], (L, D_IN), 0.02)
    b_in = b_in.at[:, offs[4]:offs[5]].add(nrm(ks[4], (L, M_HEADS), 0.1))
    b_in = b_in.at[:, offs[5]:offs[6]].add(jnp.linspace(3.0, 6.0, M_HEADS))
    b_in = b_in.at[:, offs[9]:offs[10]].add(jnp.linspace(1.0, 5.0, F_HEADS))
    conv_w = nrm(ks[5], (L, CONV_WIDTH, 2 * M_WIDTH), CONV_WIDTH ** -0.5)
    m_norm_g = 1.0 + nrm(ks[6], (L, M_WIDTH), 0.02)
    qn_g = 1.0 + nrm(ks[7], (L, F_HEAD_DIM), 0.02)
    kn_g = 1.0 + nrm(ks[8], (L, F_HEAD_DIM), 0.02)
    w_m_out = nrm(ks[9], (L, M_WIDTH, D_MODEL), M_WIDTH ** -0.5)
    w_f_out = nrm(ks[10], (L, F_WIDTH, D_MODEL), F_WIDTH ** -0.5)
    w_out = nrm(ks[11], (L, D_MODEL, D_MODEL), D_MODEL ** -0.5)
    norm2_g = 1.0 + nrm(ks[12], (L, D_MODEL), 0.02)
    w_pq = nrm(ks[13], (L, D_MODEL, P_HEADS * P_QDIM), D_MODEL ** -0.5)
    sub_keys = nrm(ks[14], (L, P_HEADS, 2, P_KEYS, P_HALF), P_HALF ** -0.5)
    u_tab = nrm(ks[15], (L, N_EXPERTS, D_MODEL), D_MODEL ** -0.5)
    v_tab = nrm(ks[16], (L, N_EXPERTS, D_MODEL), P_HEADS ** -0.5)
    return {'x': x, 'norm1_g': norm1_g, 'w_in': w_in, 'b_in': b_in, 'conv_w': conv_w,
            'm_norm_g': m_norm_g, 'qn_g': qn_g, 'kn_g': kn_g, 'w_m_out': w_m_out,
            'w_f_out': w_f_out, 'w_out': w_out, 'norm2_g': norm2_g, 'w_pq': w_pq,
            'sub_keys': sub_keys, 'u_tab': u_tab, 'v_tab': v_tab}


def reference(x, norm1_g, w_in, b_in, conv_w, m_norm_g, qn_g, kn_g, w_m_out,
              w_f_out, w_out, norm2_g, w_pq, sub_keys, u_tab, v_tab):
    split_at = np.cumsum(IN_SIZES)[:-1].tolist()
    for l in range(DEPTH):
        h = rmsnorm(x, norm1_g[l])
        z = jnp.einsum('btd,de->bte', h, w_in[l]) + b_in[l]
        mq, mk, mv, mo, mi, mf, fq, fk, fv, ff, gm, gf = jnp.split(z, split_at, axis=-1)
        qk = jax.nn.silu(causal_conv(jnp.concatenate([mq, mk], axis=-1), conv_w[l]))
        mq, mk = jnp.split(qk, 2, axis=-1)
        hm = mlstm_chunkwise(to_heads(mq, M_HEADS), to_heads(mk, M_HEADS), to_heads(mv, M_HEADS),
                             mi.transpose(0, 2, 1), mf.transpose(0, 2, 1))
        hm = rmsnorm(hm, m_norm_g[l].reshape(M_HEADS, 1, M_HEAD_DIM)).astype(x.dtype)
        hm = from_heads(hm) * jax.nn.sigmoid(mo)
        fq_h = rmsnorm(to_heads(fq, F_HEADS), qn_g[l])
        fk_h = rmsnorm(to_heads(fk, F_HEADS), kn_g[l])
        logf = jax.nn.log_sigmoid(ff.astype(jnp.float32)).transpose(0, 2, 1)
        hf = from_heads(forgetting_attention(fq_h, fk_h, to_heads(fv, F_HEADS), logf))
        y = (jax.nn.sigmoid(gm) * jnp.einsum('bte,ed->btd', hm, w_m_out[l])
             + jax.nn.sigmoid(gf) * jnp.einsum('bte,ed->btd', hf, w_f_out[l]))
        x = x + jnp.einsum('btd,de->bte', y, w_out[l]).astype(x.dtype)
        x = x + peer(rmsnorm(x, norm2_g[l]), w_pq[l], sub_keys[l], u_tab[l], v_tab[l]).astype(x.dtype)
    return x
```

```cpp
#include <hip/hip_runtime.h>
#include <hip/hip_bf16.h>
#include <cstdio>
#include <cstdint>
#define DBG_STAGE 3
#define MK_ONE_LAUNCH 1
namespace pg8 {
#define PG8_LAS __attribute__((address_space(3)))
typedef unsigned short bf16_t;
typedef short bf16x8 __attribute__((ext_vector_type(8)));
typedef float f32x4 __attribute__((ext_vector_type(4)));
typedef unsigned u32x4 __attribute__((ext_vector_type(4)));
constexpr int BM = 256, BK = 64, HALF = 128, HTB = HALF * BK * 2  , STAGE_BYTES = 8 * HTB, NXCD = 8, WGM = 8;

__host__ __device__ __forceinline__ int lds_byte(int r, int c) { const int st = (r >> 4) * 2 + (c >> 5), rr = r & 15, cc = c & 31, ob = rr * 64 + cc * 2; return st * 1024 + (ob ^ (((ob >> 9) & 1) << 5)); }
__host__ __device__ __forceinline__ void stage_rc(int b, int& R, int& C) { const int st = b / 1024, sb = b % 1024, swz = sb ^ (((sb >> 9) & 1) << 5); R = (st >> 1) * 16 + swz / 64; C = (st & 1) * 32 + (swz % 64) / 2; }
__host__ __device__ __forceinline__ int perm32(int rho) { const int n = rho >> 4, i = rho & 15; return 8 * (i >> 2) + 4 * n + (i & 3); }

struct Unit { int pm, pn; };
struct Gemm { const bf16_t* A; const bf16_t* Bt; int M, N, K; };

struct StaticOrder {
    int nM, nN, nwg, G, c;
    __host__ __device__ void init(int M, int N, int G_, int c_) { nM = M / BM; nN = N / BM; nwg = nM * nN; G = G_; c = c_; }
    __host__ __device__ bool next(int i, Unit& u) const {
        const long L = (long)i * G + c; if (L >= nwg) return false;
        int wgid = (int)L; { const int q = nwg / NXCD, r = nwg % NXCD, xcd = wgid % NXCD, off = wgid / NXCD; wgid = (xcd < r ? xcd * (q + 1) : r * (q + 1) + (xcd - r) * q) + off; }
        const int nig = WGM * nN, gid = wgid / nig, fm = gid * WGM, gsz = (nM - fm) < WGM ? (nM - fm) : WGM;
        u.pm = fm + ((wgid % nig) % gsz); u.pn = (wgid % nig) / gsz; return true;
    }
    __device__ __forceinline__ void a_ready(const Unit&) const {}
    __device__ __forceinline__ void done(const Unit&) const {}
};

struct QueueOrder {
    int nM, nN, per; unsigned* Q; int xcc; PG8_LAS int* slot;
    __device__ __forceinline__ void init(int M, int N, unsigned* Q_, int xcc_, PG8_LAS int* slot_) { nM = M / BM; nN = N / BM; per = nM * nN / NXCD; Q = Q_; xcc = xcc_; slot = slot_; }
    __device__ __forceinline__ int fetch() const {
        for (int s = 0; s < NXCD; ++s) { const int b = (xcc + s) & (NXCD - 1); const unsigned n = __hip_atomic_fetch_add(Q + 64 * b, 1u, __ATOMIC_RELAXED, __HIP_MEMORY_SCOPE_AGENT); if (n < (unsigned)per) return b * per + (int)n; }
        return -1; }
    __device__ __forceinline__ void prime() const { if (threadIdx.x == 0) { slot[0] = fetch(); slot[1] = fetch(); } }
    __device__ __forceinline__ bool next(int i, Unit& u) const {
        if (threadIdx.x == 0) slot[(i + 2) & 3] = fetch();
        const int wgid = __builtin_amdgcn_readfirstlane(slot[i & 3]); if (wgid < 0) return false;
        const int nig = WGM * nN, gid = wgid / nig, fm = gid * WGM, gsz = (nM - fm) < WGM ? (nM - fm) : WGM;
        u.pm = fm + ((wgid % nig) % gsz); u.pn = (wgid % nig) / gsz; return true; }
    __device__ __forceinline__ void a_ready(const Unit&) const {}
    __device__ __forceinline__ void done(const Unit&) const {}
};

struct PanelOrder {
    int pm, nN;
    __host__ __device__ bool next(int i, Unit& u) const { if (i >= nN) return false; u.pm = pm; u.pn = i; return true; }
    __device__ __forceinline__ void a_ready(const Unit&) const {}
    __device__ __forceinline__ void done(const Unit&) const {}
};
__device__ __forceinline__ unsigned cvt_pk_bf16(float lo, float hi) { unsigned r; asm volatile("v_cvt_pk_bf16_f32 %0, %1, %2" : "=v"(r) : "v"(lo), "v"(hi)); return r; }
typedef float f32x2 __attribute__((ext_vector_type(2)));
__device__ __forceinline__ f32x2 gelu_pk(f32x2 v) {
    const f32x2 av = __builtin_elementwise_abs(v), d = av * 0.2316418882f + 1.0f;
    f32x2 t; t.x = __builtin_amdgcn_rcpf(d.x); t.y = __builtin_amdgcn_rcpf(d.y);
    f32x2 q = t * 0.5307027145f + (-0.7265760135f); q = q * t + 0.7107068705f; q = q * t + (-0.142248368f); q = q * t + 0.127414796f; q = q * t;
    const f32x2 s = (v * v) * (-0.72134752044f);
    f32x2 e; e.x = __builtin_amdgcn_exp2f(s.x); e.y = __builtin_amdgcn_exp2f(s.y);
    const f32x2 m = v * (q * e), r = v - m;
    f32x2 o; o.x = v.x < 0.f ? m.x : r.x; o.y = v.y < 0.f ? m.y : r.y; return o;
}

template <int ACT  > struct EpiBf16 {
    static constexpr bool PERM = true, AFTER_DRAIN = false; static_assert(ACT == 0 || ACT == 1, "EpiBf16: ACT is 0 (none) or 1 (gelu_pk)");
    bf16_t* O; int ldc; const float* bias; int split_cols; size_t split_stride; float scale0;
    __device__ __forceinline__ void operator()(const f32x4 (&acc)[2][2][4][2], const Unit& u, int wr, int wc, int fr, int fq) const {
        const int row0 = u.pm * BM + wr * 64 + fr; int colt = u.pn * BM; bf16_t* base = O;
        float sc = 1.f; if (split_cols) { const int t = colt / split_cols; base += (size_t)t * split_stride; colt -= t * split_cols; if (t == 0) sc = scale0; }
        const int col0 = colt + wc * 32 + 8 * fq, bcol0 = u.pn * BM + wc * 32 + 8 * fq;
        f32x4 bv[2][2];
#pragma unroll
        for (int bj = 0; bj < 2; ++bj)
#pragma unroll
            for (int n = 0; n < 2; ++n) bv[bj][n] = bias ? *(const f32x4*)(bias + bcol0 + bj * HALF + 4 * n) : (f32x4){0.f, 0.f, 0.f, 0.f};
#pragma unroll
        for (int ai = 0; ai < 2; ++ai)
#pragma unroll
            for (int m = 0; m < 4; ++m) { bf16_t* rowp = base + (size_t)(row0 + ai * HALF + m * 16) * ldc + col0;
#pragma unroll
                for (int bj = 0; bj < 2; ++bj) { f32x4 v0 = acc[ai][bj][m][0] + bv[bj][0], v1 = acc[ai][bj][m][1] + bv[bj][1];
                    if (ACT == 1) { f32x2 a = gelu_pk((f32x2){v0[0], v0[1]}), b = gelu_pk((f32x2){v0[2], v0[3]}), c = gelu_pk((f32x2){v1[0], v1[1]}), d = gelu_pk((f32x2){v1[2], v1[3]});
                        v0 = (f32x4){a.x, a.y, b.x, b.y}; v1 = (f32x4){c.x, c.y, d.x, d.y}; }
                    v0 = v0 * sc; v1 = v1 * sc; u32x4 w; w.x = cvt_pk_bf16(v0[0], v0[1]); w.y = cvt_pk_bf16(v0[2], v0[3]); w.z = cvt_pk_bf16(v1[0], v1[1]); w.w = cvt_pk_bf16(v1[2], v1[3]);
                    *(u32x4*)(rowp + bj * HALF) = w; } }
    }
};

typedef int v8i_t __attribute__((ext_vector_type(8)));
typedef int v4i_t __attribute__((ext_vector_type(4)));
__device__ __forceinline__ v8i_t cat32(bf16x8 lo, bf16x8 hi) { return __builtin_shufflevector(__builtin_bit_cast(v4i_t, lo), __builtin_bit_cast(v4i_t, hi), 0, 1, 2, 3, 4, 5, 6, 7); }
template <class Epi, class Sched, bool ALIGN_EPI = false, bool SP2 = false, int MODE = 0>
__device__ __forceinline__ void gemm_phase(PG8_LAS unsigned char* lds, const Gemm g, const Sched& S, const Epi& E) {
    constexpr bool FP8 = (MODE == 1);
    int tid_ = threadIdx.x; asm volatile("" : "+v"(tid_));
    const int tid = tid_, wid = __builtin_amdgcn_readfirstlane(tid >> 6), lane = tid & 63, wr = wid >> 2, wc = wid & 3, fr = lane & 15, fq = lane >> 4;
    const int K = g.K, nt = K / BK;
    unsigned voffA[2], voffB[2];
#pragma unroll
    for (int i = 0; i < 2; ++i) { int R, C; stage_rc(tid * 16 + i * 8192, R, C); const int Rb = Epi::PERM ? ((R & ~31) + perm32(R & 31)) : R;
        voffA[i] = (unsigned)(R * K + C) * 2u; voffB[i] = (unsigned)(Rb * K + C) * 2u; }
    const size_t kstep = (size_t)(BK * 2);
    const size_t hstep = (size_t)HALF * K * 2;
    const size_t tstep = 2 * hstep;
    const unsigned ldsw = (unsigned)wid * 1024u;
    const int aoff = lds_byte(wr * 64 + fr, fq * 8), boff = lds_byte(wc * 32 + fr, fq * 8);
#define PG8_SA(b, h) (((b) * 2 + (h)) * HTB)
#define PG8_SB(b, h) ((4 + (b) * 2 + (h)) * HTB)
#define PG8_STAGE(bufoff, gbase, voff) do { _Pragma("unroll") for (int _i = 0; _i < 2; ++_i) \
        __builtin_amdgcn_global_load_lds((const unsigned*)((const char*)(gbase) + (voff)[_i]), (PG8_LAS unsigned*)(lds + (bufoff) + ldsw + _i * 8192), 16, 0, 0); } while (0)
#define PG8_LDA(dst, b, h) do { if constexpr (FP8) { _Pragma("unroll") for (int m = 0; m < 4; ++m) dst##8[m] = cat32(*(const PG8_LAS bf16x8*)(lds + PG8_SA(b, h) + aoff + m * 2048), *(const PG8_LAS bf16x8*)(lds + PG8_SA(b, h) + aoff + m * 2048 + 1024)); } \
        else { _Pragma("unroll") for (int m = 0; m < 4; ++m) _Pragma("unroll") for (int k = 0; k < 2; ++k) dst[m][k] = *(const PG8_LAS bf16x8*)(lds + PG8_SA(b, h) + aoff + m * 2048 + k * 1024); } } while (0)
#define PG8_LDB(dst, b, h) do { if constexpr (FP8) { _Pragma("unroll") for (int n = 0; n < 2; ++n) dst##8[n] = cat32(*(const PG8_LAS bf16x8*)(lds + PG8_SB(b, h) + boff + n * 2048), *(const PG8_LAS bf16x8*)(lds + PG8_SB(b, h) + boff + n * 2048 + 1024)); } \
        else { _Pragma("unroll") for (int n = 0; n < 2; ++n) _Pragma("unroll") for (int k = 0; k < 2; ++k) dst[n][k] = *(const PG8_LAS bf16x8*)(lds + PG8_SB(b, h) + boff + n * 2048 + k * 1024); } } while (0)
#define PG8_MMA(ai, bj, At, Bt) do { __builtin_amdgcn_s_setprio(1); _Pragma("unroll") for (int m = 0; m < 4; ++m) _Pragma("unroll") for (int n = 0; n < 2; ++n) { \
        if constexpr (FP8) acc[ai][bj][m][n] = __builtin_amdgcn_mfma_scale_f32_16x16x128_f8f6f4(Bt##8[n], At##8[m], acc[ai][bj][m][n], 0, 0, 0, 0x7F7F7F7F, 0, 0x7F7F7F7F); \
        else if constexpr (MODE == 2) { _Pragma("unroll") for (int k = 0; k < 2; ++k) acc[ai][bj][m][n] = __builtin_bit_cast(f32x4, __builtin_amdgcn_mfma_i32_16x16x64_i8(__builtin_bit_cast(v4i_t, Bt[n][k]), __builtin_bit_cast(v4i_t, At[m][k]), __builtin_bit_cast(v4i_t, acc[ai][bj][m][n]), 0, 0, 0)); } \
        else { _Pragma("unroll") for (int k = 0; k < 2; ++k) acc[ai][bj][m][n] = __builtin_amdgcn_mfma_f32_16x16x32_bf16(Bt[n][k], At[m][k], acc[ai][bj][m][n], 0, 0, 0); } } __builtin_amdgcn_s_setprio(0); } while (0)
#define PG8_WAIT_V(n) asm volatile("s_waitcnt vmcnt(" #n ")" ::: "memory")
#define PG8_WAIT_L(n) asm volatile("s_waitcnt lgkmcnt(" #n ")" ::: "memory")
#define PG8_BAR __builtin_amdgcn_s_barrier()
#define PG8_SCHED __builtin_amdgcn_sched_barrier(0)
    Unit cur, nxt; int ui = 0;
    if (!S.next(0, cur)) return;
    f32x4 acc[2][2][4][2];
#pragma unroll
    for (int a = 0; a < 2; ++a)
#pragma unroll
        for (int b = 0; b < 2; ++b)
#pragma unroll
            for (int m = 0; m < 4; ++m)
#pragma unroll
                for (int n = 0; n < 2; ++n) acc[a][b][m][n] = (f32x4){0.f, 0.f, 0.f, 0.f};
    bf16x8 At[4][2], B0[2][2], B1[2][2]; v8i_t At8[4], B08[2], B18[2];
    const char* cA = (const char*)g.A + (size_t)cur.pm * tstep; const char* cB = (const char*)g.Bt + (size_t)cur.pn * tstep;
    S.a_ready(cur);
    if constexpr (SP2) {
        PG8_STAGE(PG8_SB(0, 0), cB, voffB); PG8_STAGE(PG8_SB(0, 1), cB + hstep, voffB); PG8_STAGE(PG8_SA(0, 0), cA, voffA); PG8_STAGE(PG8_SA(0, 1), cA + hstep, voffA);
        if (wr == 1) PG8_BAR;
        PG8_WAIT_V(2); PG8_BAR;
        PG8_STAGE(PG8_SB(1, 0), cB + kstep, voffB); PG8_STAGE(PG8_SA(1, 0), cA + kstep, voffA); PG8_STAGE(PG8_SB(1, 1), cB + hstep + kstep, voffB);
        PG8_WAIT_V(6); PG8_BAR;
    } else {
        PG8_STAGE(PG8_SB(0, 0), cB, voffB); PG8_STAGE(PG8_SA(0, 0), cA, voffA); PG8_STAGE(PG8_SB(0, 1), cB + hstep, voffB); PG8_STAGE(PG8_SA(0, 1), cA + hstep, voffA);
        if (wr == 1) PG8_BAR;
        PG8_WAIT_V(4); PG8_BAR;
        PG8_STAGE(PG8_SB(1, 0), cB + kstep, voffB); PG8_STAGE(PG8_SA(1, 0), cA + kstep, voffA); PG8_STAGE(PG8_SB(1, 1), cB + hstep + kstep, voffB);
        PG8_WAIT_V(6); PG8_BAR;
    }
    for (;;) {
        const bool has_next = S.next(ui + 1, nxt);
        const char* nA = has_next ? (const char*)g.A + (size_t)nxt.pm * tstep : cA; const char* nB = has_next ? (const char*)g.Bt + (size_t)nxt.pn * tstep : cB;
_Pragma("nounroll")
        for (int t = 0; t < nt; t += 2) {
            const bool last = (t == nt - 2);
            const char* a1 = cA + (size_t)(t + 1) * kstep;
            const char* a2 = last ? nA : cA + (size_t)(t + 2) * kstep; const char* b2 = last ? nB : cB + (size_t)(t + 2) * kstep;
            const char* a3 = a2 + kstep; const char* b3 = b2 + kstep;
            if (last && has_next) S.a_ready(nxt);
            if constexpr (SP2) {
            PG8_LDB(B0, 0, 0); PG8_LDB(B1, 0, 1); PG8_SCHED; PG8_LDA(At, 0, 0); PG8_STAGE(PG8_SA(1, 1), a1 + hstep, voffA);
            PG8_WAIT_V(8); PG8_WAIT_L(0); PG8_BAR; PG8_MMA(0, 0, At, B0); PG8_MMA(0, 1, At, B1); PG8_BAR; PG8_SCHED;
            PG8_LDA(At, 0, 1); PG8_STAGE(PG8_SB(0, 0), b2, voffB); PG8_STAGE(PG8_SB(0, 1), b2 + hstep, voffB); PG8_STAGE(PG8_SA(0, 0), a2, voffA);
            PG8_WAIT_V(8); PG8_WAIT_L(0); PG8_BAR; PG8_MMA(1, 0, At, B0); PG8_MMA(1, 1, At, B1); PG8_BAR; PG8_SCHED;
            PG8_LDB(B0, 1, 0); PG8_LDB(B1, 1, 1); PG8_SCHED; PG8_LDA(At, 1, 0); PG8_STAGE(PG8_SA(0, 1), a2 + hstep, voffA);
            PG8_WAIT_V(8); PG8_WAIT_L(0); PG8_BAR; PG8_MMA(0, 0, At, B0); PG8_MMA(0, 1, At, B1); PG8_BAR; PG8_SCHED;
            PG8_LDA(At, 1, 1); PG8_STAGE(PG8_SB(1, 0), b3, voffB); PG8_STAGE(PG8_SB(1, 1), b3 + hstep, voffB); PG8_STAGE(PG8_SA(1, 0), a3, voffA);
            PG8_WAIT_V(8); PG8_WAIT_L(0); PG8_BAR; PG8_MMA(1, 0, At, B0); PG8_MMA(1, 1, At, B1); PG8_BAR; PG8_SCHED;
            } else {
            PG8_LDB(B0, 0, 0); PG8_SCHED; PG8_LDA(At, 0, 0); PG8_STAGE(PG8_SA(1, 1), a1 + hstep, voffA);
            PG8_WAIT_L(8); PG8_BAR; PG8_WAIT_L(0); PG8_MMA(0, 0, At, B0); PG8_BAR; PG8_SCHED;
            PG8_LDB(B1, 0, 1); PG8_STAGE(PG8_SB(0, 0), b2, voffB);
            PG8_BAR; PG8_WAIT_L(0); PG8_MMA(0, 1, At, B1); PG8_BAR;
            PG8_LDA(At, 0, 1); PG8_STAGE(PG8_SA(0, 0), a2, voffA);
            PG8_BAR; PG8_WAIT_L(0); PG8_MMA(1, 0, At, B0); PG8_BAR; PG8_SCHED;
            PG8_STAGE(PG8_SB(0, 1), b2 + hstep, voffB);
            PG8_WAIT_V(6); PG8_BAR; PG8_MMA(1, 1, At, B1); PG8_BAR;
            PG8_LDB(B0, 1, 0); PG8_SCHED; PG8_LDA(At, 1, 0); PG8_STAGE(PG8_SA(0, 1), a2 + hstep, voffA);
            PG8_WAIT_L(8); PG8_BAR; PG8_WAIT_L(0); PG8_MMA(0, 0, At, B0); PG8_BAR; PG8_SCHED;
            PG8_LDB(B1, 1, 1); PG8_STAGE(PG8_SB(1, 0), b3, voffB);
            PG8_BAR; PG8_WAIT_L(0); PG8_MMA(0, 1, At, B1); PG8_BAR;
            PG8_LDA(At, 1, 1); PG8_STAGE(PG8_SA(1, 0), a3, voffA);
            PG8_BAR; PG8_WAIT_L(0); PG8_MMA(1, 0, At, B0); PG8_BAR; PG8_SCHED;
            PG8_STAGE(PG8_SB(1, 1), b3 + hstep, voffB);
            PG8_WAIT_V(6); PG8_BAR; PG8_MMA(1, 1, At, B1); PG8_BAR;
            }
        }
        if constexpr (ALIGN_EPI) { if (wr == 0) PG8_BAR; }
        if constexpr (!Epi::AFTER_DRAIN) { E(acc, cur, wr, wc, fr, fq); S.done(cur); }
        if (!has_next) break;
#pragma unroll
        for (int a = 0; a < 2; ++a)
#pragma unroll
            for (int b = 0; b < 2; ++b)
#pragma unroll
                for (int m = 0; m < 4; ++m)
#pragma unroll
                    for (int n = 0; n < 2; ++n) acc[a][b][m][n] = (f32x4){0.f, 0.f, 0.f, 0.f};
        cur = nxt; cA = nA; cB = nB; ++ui;
        if constexpr (ALIGN_EPI) { if (wr == 1) PG8_BAR; }
    }
    PG8_WAIT_V(0);
    if constexpr (!ALIGN_EPI) { if (wr == 0) PG8_BAR; }
    PG8_BAR;
    if constexpr (Epi::AFTER_DRAIN) { E.fused(acc, cur, wr, wc, fr, fq, lds, wid, lane); S.done(cur); }
#undef PG8_SA
#undef PG8_SB
#undef PG8_STAGE
#undef PG8_LDA
#undef PG8_LDB
#undef PG8_MMA
#undef PG8_WAIT_V
#undef PG8_WAIT_L
#undef PG8_BAR
#undef PG8_SCHED
}
}
#define PG8_SP2 true
#define GAS __attribute__((address_space(1)))
#define LAS __attribute__((address_space(3)))
typedef unsigned short bf16raw;
typedef unsigned v4u __attribute__((ext_vector_type(4)));
typedef unsigned v2u __attribute__((ext_vector_type(2)));
typedef float f32x4 __attribute__((ext_vector_type(4)));
typedef float f32x2 __attribute__((ext_vector_type(2)));
typedef float f32x16 __attribute__((ext_vector_type(16)));
typedef short bf16x8 __attribute__((ext_vector_type(8)));
typedef GAS unsigned gu32;
#define RLX_AGENT __ATOMIC_RELAXED, __HIP_MEMORY_SCOPE_AGENT
constexpr int NWAVES = 8, NTHR = 512;
constexpr int BATCH = 8, T = 8192, D = 1024, M = BATCH * T;
constexpr int MH = 4, MD = 256, FH = 8, FD = 128, LCH = 64, NCH = T / LCH;
constexpr int DIN = 9232;
constexpr int PH = 8, PKEYS = 128, PTOP = 16, HK = PH * PTOP, NEXP = 16384;
constexpr float EPS = 1e-6f;
__device__ __forceinline__ unsigned f2bf(float f) { unsigned u = __builtin_bit_cast(unsigned, f); return (u + 0x7fffu + ((u >> 16) & 1u)) >> 16; }
typedef __bf16 bf16x2_t __attribute__((ext_vector_type(2)));
__device__ __forceinline__ unsigned pk2(float lo, float hi) { return __builtin_bit_cast(unsigned, __builtin_convertvector((f32x2){lo, hi}, bf16x2_t)); }
__device__ __forceinline__ float bflo(unsigned w) { return __builtin_bit_cast(float, w << 16); }
__device__ __forceinline__ float bfhi(unsigned w) { return __builtin_bit_cast(float, w & 0xffff0000u); }
__device__ __forceinline__ float bf1(bf16raw h) { return __builtin_bit_cast(float, (unsigned)h << 16); }
__device__ __forceinline__ float wave_sum(float v) {
#pragma unroll
    for (int o = 1; o < 64; o <<= 1) v += __shfl_xor(v, o);
    return v;
}
__device__ __forceinline__ float sigmoidf_(float x) { return __builtin_amdgcn_rcpf(1.0f + __builtin_amdgcn_exp2f(x * -1.4426950408889634f)); }
__device__ __forceinline__ unsigned q8x4_pack(float a, float b, float c, float d, float inv) {
    const unsigned ua = __builtin_bit_cast(unsigned, __builtin_fmaf(a, inv, 12582912.f)), ub = __builtin_bit_cast(unsigned, __builtin_fmaf(b, inv, 12582912.f));
    const unsigned uc = __builtin_bit_cast(unsigned, __builtin_fmaf(c, inv, 12582912.f)), ud = __builtin_bit_cast(unsigned, __builtin_fmaf(d, inv, 12582912.f));
    return __builtin_amdgcn_perm(ub, ua, 0x0c0c0400u) | __builtin_amdgcn_perm(ud, uc, 0x04000c0cu);
}
__device__ __forceinline__ unsigned nib4(unsigned w) { w = (w | (w >> 4)) & 0x00FF00FFu; return (w | (w >> 8)) & 0xFFFFu; }
__device__ __forceinline__ float logsigf_(float x) { return fminf(x, 0.f) - log1pf(__expf(-fabsf(x))); }
__device__ __forceinline__ float gelu_erf(float v) {
    const float av = fabsf(v), t = __builtin_amdgcn_rcpf(av * 0.2316418882f + 1.0f);
    float q = t * 0.5307027145f + (-0.7265760135f); q = q * t + 0.7107068705f; q = q * t + (-0.142248368f); q = q * t + 0.127414796f; q = q * t;
    const float e = __builtin_amdgcn_exp2f((v * v) * (-0.72134752044f));
    const float m = v * (q * e);
    return v < 0.f ? m : v - m;
}
constexpr size_t MiB = 1u << 20;
constexpr size_t WS_CTL = 0, CTL_ZERO_BYTES = 1 * MiB;
constexpr size_t WS_Z16 = 2 * MiB;
constexpr size_t WS_CS = 6 * MiB;
constexpr size_t WS_GROWF = 8 * MiB, WS_GCOLF = 9 * MiB, WS_GWINT = 10 * MiB, WS_GEDEN = 11 * MiB, WS_GWSW = 12 * MiB;
constexpr size_t WS_JLO = 13 * MiB + 262144;
constexpr size_t WS_GDECAY = 13 * MiB, WS_BIASP = 13 * MiB + 65536, WS_BIASG = 13 * MiB + 131072;
constexpr size_t WS_KBAR = 14 * MiB, WS_DSUM = 18 * MiB;
constexpr size_t WS_SKB = 19 * MiB, WS_WGT = 19 * MiB + 524288;
constexpr size_t WS_WINT = 20 * MiB, WS_WMT = 38 * MiB, WS_WFT = 40 * MiB, WS_WOT = 42 * MiB, WS_WPQT = 44 * MiB;
constexpr size_t WS_SP = 48 * MiB, WS_IDS = 80 * MiB, WS_GW = 112 * MiB, WS_UB = 144 * MiB, WS_VB = 176 * MiB;
constexpr size_t WS_R0 = 256 * MiB, RSZ = 128 * MiB;
constexpr size_t WS_END = 1024 * MiB;
constexpr int CW_TMO = 0, CW_BAR = 4096, CW_QU = 8192, CW_QV = 8192 + 512, CW_QF = 8192 + 1024, CW_CMAX = 16384, CW_QG = 9728  , CW_FDONE = 12288  , CW_QM = 10240  ;
constexpr int LDS_BYTES = 163840;
constexpr int LDS_MISC = 160 * 1024 - 256;
#define XB_TMO      128
#define XB_XCNT(j)  (256  + 64 * (j))
#define XB_XSUB(j)  (1280 + 64 * (j))
#define XB_XGEN(j)  (2304 + 64 * (j))
#define XB_TOP      3328
#define XB_TOPGEN   3392
#define XCD_BAR_WORDS 3456
#define XB_SPIN_CAP (1u << 18)

__device__ __forceinline__ unsigned xb_ld(unsigned* p)              { return __hip_atomic_load(p, __ATOMIC_RELAXED, __HIP_MEMORY_SCOPE_AGENT); }
__device__ __forceinline__ unsigned xb_add(unsigned* p, unsigned v) { return __hip_atomic_fetch_add(p, v, __ATOMIC_RELAXED, __HIP_MEMORY_SCOPE_AGENT); }
__device__ __forceinline__ unsigned xb_xcc_id() { return (unsigned)__builtin_amdgcn_s_getreg((3 << 11) | 20) & 0xFu; }
#define XB_SPIN(cond, bar) do { unsigned _sp = 0; while (cond) { __builtin_amdgcn_s_sleep(1); \
    if ((++_sp & 255u) == 0u) { if (xb_ld(&(bar)[XB_TMO])) break; if (_sp > XB_SPIN_CAP) { atomicAdd(&(bar)[XB_TMO], 1u); break; } } } } while (0)

struct XcdBarrier {
    unsigned* bar; unsigned x;
    volatile LAS unsigned* st;
};

__device__ __forceinline__ XcdBarrier xcd_barrier_post(unsigned* bar, volatile LAS unsigned* st) {
    XcdBarrier b; b.bar = bar; b.x = xb_xcc_id(); b.st = st;
    if (threadIdx.x == 0) (void)xb_add(&bar[XB_XCNT(b.x)], 1u);
    return b;
}
__device__ __forceinline__ void xcd_barrier_complete(unsigned* bar, unsigned x, unsigned& nloc, unsigned& nx) {
    const unsigned G = gridDim.x * gridDim.y * gridDim.z;
    unsigned sum, cnt, mine, sp = 0u;
    for (;;) {
        sum = 0u; cnt = 0u; mine = 0u;
#pragma unroll
        for (unsigned j = 0; j < 16; ++j) { const unsigned c = xb_ld(&bar[XB_XCNT(j)]); sum += c; cnt += (c > 0u) ? 1u : 0u; mine = (j == x) ? c : mine; }
        if (sum == G) break;
        __builtin_amdgcn_s_sleep(1);
        if ((++sp & 255u) == 0u) { if (xb_ld(&bar[XB_TMO])) break; if (sp > XB_SPIN_CAP) { atomicAdd(&bar[XB_TMO], 1u); break; } }
    }
    nloc = mine > 0u ? mine : 1u; nx = cnt > 0u ? cnt : 1u;
}

__device__ __forceinline__ void xcd_barrier(const XcdBarrier& b) {
    asm volatile("s_waitcnt vmcnt(0)" ::: "memory");
    __syncthreads();
    if (threadIdx.x == 0) {
        unsigned* bar = b.bar;
        __builtin_amdgcn_s_waitcnt(0);
        unsigned nloc = b.st[0], nx = b.st[1];
        if (nloc == 0u) { xcd_barrier_complete(bar, b.x, nloc, nx); b.st[0] = nloc; b.st[1] = nx; }
        const unsigned old = xb_add(&bar[XB_XSUB(b.x)], 1u);
        const unsigned gen = old / nloc;
        if (old + 1u == (gen + 1u) * nloc) {
            __builtin_amdgcn_fence(__ATOMIC_RELEASE, "agent");
            asm volatile("s_waitcnt vmcnt(0)" ::: "memory");
            const unsigned og = xb_add(&bar[XB_TOP], 1u);
            const unsigned tg = og / nx;
            if (og + 1u == (tg + 1u) * nx) xb_add(&bar[XB_TOPGEN], 1u);
            else XB_SPIN(xb_ld(&bar[XB_TOPGEN]) == tg, bar);
            __builtin_amdgcn_fence(__ATOMIC_ACQUIRE, "agent");
            xb_add(&bar[XB_XGEN(b.x)], 1u);
            asm volatile("s_waitcnt vmcnt(0)" ::: "memory");
        } else {
            XB_SPIN(xb_ld(&bar[XB_XGEN(b.x)]) == gen, bar);
            __builtin_amdgcn_fence(__ATOMIC_ACQUIRE, "agent");
            asm volatile("s_waitcnt vmcnt(0)" ::: "memory");
        }
    }
    __syncthreads();
}
namespace pg8 {
__device__ __forceinline__ float q8f(unsigned w, int k) { return (float)(int)(signed char)(w >> (8 * k)) * (1.f / 16.f); }
struct EpiGate {
    static constexpr bool PERM = true, AFTER_DRAIN = false;
    bf16_t* O; const signed char* Gt; const bf16_t* Add; int ldc;
    __device__ __forceinline__ void operator()(const f32x4 (&acc)[2][2][4][2], const Unit& u, int wr, int wc, int fr, int fq) const {
        const int row0 = u.pm * BM + wr * 64 + fr, col0 = u.pn * BM + wc * 32 + 8 * fq;
        unsigned long long g[2][4][2]; u32x4 ad[2][4][2];
#pragma unroll
        for (int ai = 0; ai < 2; ++ai)
#pragma unroll
            for (int m = 0; m < 4; ++m) { const size_t ro = (size_t)(row0 + ai * HALF + m * 16) * ldc + col0;
#pragma unroll
                for (int bj = 0; bj < 2; ++bj) { g[ai][m][bj] = *(const unsigned long long*)(Gt + ro + bj * HALF); ad[ai][m][bj] = (u32x4){0u, 0u, 0u, 0u}; if (Add && ai == 0) ad[ai][m][bj] = *(const u32x4*)(Add + ro + bj * HALF); } }
#pragma unroll
        for (int ai = 0; ai < 2; ++ai)
#pragma unroll
            for (int m = 0; m < 4; ++m) { const size_t ro = (size_t)(row0 + ai * HALF + m * 16) * ldc + col0;
#pragma unroll
                for (int bj = 0; bj < 2; ++bj) {
                    if (Add && ai == 0 && m > 0) ad[1][m - 1][bj] = *(const u32x4*)(Add + ro + (size_t)(HALF - 16) * ldc + bj * HALF);
                    if (Add && ai == 1 && m == 0) ad[1][3][bj] = *(const u32x4*)(Add + ro + (size_t)48 * ldc + bj * HALF);
                    const f32x4 v0 = acc[ai][bj][m][0], v1 = acc[ai][bj][m][1];
                    const unsigned gw[2] = {(unsigned)g[ai][m][bj], (unsigned)(g[ai][m][bj] >> 32)}, aw[4] = {ad[ai][m][bj].x, ad[ai][m][bj].y, ad[ai][m][bj].z, ad[ai][m][bj].w}; const float vv[8] = {v0[0], v0[1], v0[2], v0[3], v1[0], v1[1], v1[2], v1[3]};
                    unsigned o[4];
#pragma unroll
                    for (int i = 0; i < 4; ++i) { const float a = vv[2 * i] * sigmoidf_(q8f(gw[i >> 1], 2 * (i & 1))) + bflo(aw[i]), b = vv[2 * i + 1] * sigmoidf_(q8f(gw[i >> 1], 2 * (i & 1) + 1)) + bfhi(aw[i]); o[i] = cvt_pk_bf16(a, b); }
                    *(u32x4*)(O + ro + bj * HALF) = (u32x4){o[0], o[1], o[2], o[3]}; } }
    }
};
struct EpiBf16S {
    static constexpr bool PERM = false, AFTER_DRAIN = false;
    bf16_t* O; int ldc; const float* bias; size_t split_stride; float sc;
    __device__ __forceinline__ void operator()(const f32x4 (&acc)[2][2][4][2], const Unit& u, int wr, int wc, int fr, int fq) const {
        typedef unsigned u32x2 __attribute__((ext_vector_type(2)));
        { int t_ = threadIdx.x; asm volatile("" : "+v"(t_)); fr = t_ & 15; fq = (t_ >> 4) & 3; }
        const int row0 = u.pm * BM + wr * 64 + fr; int colt = u.pn * BM; const int t = colt >> 10; bf16_t* base = O + (size_t)t * split_stride; colt -= t << 10;
        const int col0 = colt + wc * 32 + 4 * fq, bcol0 = u.pn * BM + wc * 32 + 4 * fq;
#pragma unroll
        for (int bj = 0; bj < 2; ++bj)
#pragma unroll
            for (int n = 0; n < 2; ++n) { const f32x4 bv = *(const f32x4*)(bias + bcol0 + bj * HALF + 16 * n);
#pragma unroll
                for (int ai = 0; ai < 2; ++ai)
#pragma unroll
                    for (int m = 0; m < 4; ++m) { const f32x4 v = acc[ai][bj][m][n] * sc + bv; u32x2 w; w.x = cvt_pk_bf16(v[0], v[1]); w.y = cvt_pk_bf16(v[2], v[3]);
                        *(u32x2*)(base + (size_t)(row0 + ai * HALF + m * 16) * ldc + col0 + bj * HALF + 16 * n) = w; } }
    }
};
struct EpiQ8 {
    static constexpr bool PERM = true, AFTER_DRAIN = false;
    signed char* O; int ldc; const float* bias; const float* sw; const float* sh; size_t off1, off2;
    __device__ __forceinline__ void operator()(const f32x4 (&acc)[2][2][4][2], const Unit& u, int wr, int wc, int fr, int fq) const {
        typedef int i32x4 __attribute__((ext_vector_type(4)));
        { int t_ = threadIdx.x; asm volatile("" : "+v"(t_)); fr = t_ & 15; fq = (t_ >> 4) & 3; }
        const int row0 = u.pm * BM + wr * 64 + fr; int colt = u.pn * BM; const int t = colt >> 10; signed char* base = O + (t == 0 ? (size_t)0 : t == 1 ? off1 : off2); colt -= t << 10;
        const int col0 = colt + wc * 32 + 8 * fq, bcol0 = u.pn * BM + wc * 32 + 8 * fq;
        float rs[2][4];
#pragma unroll
        for (int ai = 0; ai < 2; ++ai)
#pragma unroll
            for (int m = 0; m < 4; ++m) rs[ai][m] = sh[row0 + ai * HALF + m * 16];
        f32x4 bv_[2][2], cs_[2][2];
#pragma unroll
        for (int bj = 0; bj < 2; ++bj)
#pragma unroll
            for (int n = 0; n < 2; ++n) { bv_[bj][n] = bias ? *(const f32x4*)(bias + bcol0 + bj * HALF + 4 * n) : (f32x4){0.f, 0.f, 0.f, 0.f}; cs_[bj][n] = *(const f32x4*)(sw + bcol0 + bj * HALF + 4 * n); }
#pragma unroll
        for (int bj = 0; bj < 2; ++bj) { const f32x4 (&bv)[2] = bv_[bj]; const f32x4 (&cs)[2] = cs_[bj];
#pragma unroll
            for (int ai = 0; ai < 2; ++ai)
#pragma unroll
                for (int m = 0; m < 4; ++m) { unsigned w2[2];
#pragma unroll
                    for (int n = 0; n < 2; ++n) { const i32x4 iv = __builtin_bit_cast(i32x4, acc[ai][bj][m][n]);
                        const f32x4 v = ((f32x4){(float)iv[0], (float)iv[1], (float)iv[2], (float)iv[3]} * cs[n] * rs[ai][m] + bv[n]) * 16.f;
                        w2[n] = q8x4_pack(__builtin_amdgcn_fmed3f(v[0], -127.f, 127.f), __builtin_amdgcn_fmed3f(v[1], -127.f, 127.f), __builtin_amdgcn_fmed3f(v[2], -127.f, 127.f), __builtin_amdgcn_fmed3f(v[3], -127.f, 127.f), 1.f); }
                    *(unsigned long long*)(base + (size_t)(row0 + ai * HALF + m * 16) * ldc + col0 + bj * HALF) = (unsigned long long)w2[0] | ((unsigned long long)w2[1] << 32); } }
    }
};
struct EpiI8 {
    static constexpr bool PERM = true, AFTER_DRAIN = false;
    bf16_t* O; int ldc; const float* bias; const float* sw; const float* sh; size_t split_stride;
    __device__ __forceinline__ void operator()(const f32x4 (&acc)[2][2][4][2], const Unit& u, int wr, int wc, int fr, int fq) const {
        typedef int i32x4 __attribute__((ext_vector_type(4)));
        { int t_ = threadIdx.x; asm volatile("" : "+v"(t_)); fr = t_ & 15; fq = (t_ >> 4) & 3; }
        const int row0 = u.pm * BM + wr * 64 + fr; int colt = u.pn * BM; const int t = split_stride ? (colt >> 10) : 0; bf16_t* base = O + (size_t)t * split_stride; colt -= t << 10;
        const int col0 = colt + wc * 32 + 8 * fq, bcol0 = u.pn * BM + wc * 32 + 8 * fq;
        float rs[2][4];
#pragma unroll
        for (int ai = 0; ai < 2; ++ai)
#pragma unroll
            for (int m = 0; m < 4; ++m) rs[ai][m] = sh[row0 + ai * HALF + m * 16];
        f32x4 bv_[2][2], cs_[2][2];
#pragma unroll
        for (int bj = 0; bj < 2; ++bj)
#pragma unroll
            for (int n = 0; n < 2; ++n) { bv_[bj][n] = bias ? *(const f32x4*)(bias + bcol0 + bj * HALF + 4 * n) : (f32x4){0.f, 0.f, 0.f, 0.f}; cs_[bj][n] = *(const f32x4*)(sw + bcol0 + bj * HALF + 4 * n); }
#pragma unroll
        for (int bj = 0; bj < 2; ++bj) { const f32x4 (&bv)[2] = bv_[bj]; const f32x4 (&cs)[2] = cs_[bj];
#pragma unroll
            for (int ai = 0; ai < 2; ++ai)
#pragma unroll
                for (int m = 0; m < 4; ++m) { u32x4 w;
#pragma unroll
                    for (int n = 0; n < 2; ++n) { const i32x4 iv = __builtin_bit_cast(i32x4, acc[ai][bj][m][n]);
                        const f32x4 v = (f32x4){(float)iv[0], (float)iv[1], (float)iv[2], (float)iv[3]} * cs[n] * rs[ai][m] + bv[n];
                        if (n == 0) { w.x = cvt_pk_bf16(v[0], v[1]); w.y = cvt_pk_bf16(v[2], v[3]); } else { w.z = cvt_pk_bf16(v[0], v[1]); w.w = cvt_pk_bf16(v[2], v[3]); } }
                    *(u32x4*)(base + (size_t)(row0 + ai * HALF + m * 16) * ldc + col0 + bj * HALF) = w; } }
    }
};
struct EpiRes {
    static constexpr bool PERM = true, AFTER_DRAIN = false;
    const float* X; float* O; int ldc;
    __device__ __forceinline__ void operator()(const f32x4 (&acc)[2][2][4][2], const Unit& u, int wr, int wc, int fr, int fq) const {
        const int row0 = u.pm * BM + wr * 64 + fr, col0 = u.pn * BM + wc * 32 + 8 * fq;
#pragma unroll
        for (int ai = 0; ai < 2; ++ai)
#pragma unroll
            for (int m = 0; m < 4; ++m) { const size_t ro = (size_t)(row0 + ai * HALF + m * 16) * ldc + col0;
#pragma unroll
                for (int bj = 0; bj < 2; ++bj)
#pragma unroll
                    for (int n = 0; n < 2; ++n) { const size_t off = ro + bj * HALF + n * 4; *(f32x4*)(O + off) = *(const f32x4*)(X + off) + acc[ai][bj][m][n]; } }
    }
};
struct EpiGateI8 {
    static constexpr bool PERM = true, AFTER_DRAIN = false;
    bf16_t* O; const signed char* Gt; const bf16_t* Add; int ldc; const float* sw; const float* sh;
    __device__ __forceinline__ void operator()(const f32x4 (&acc)[2][2][4][2], const Unit& u, int wr, int wc, int fr, int fq) const {
        typedef int i32x4 __attribute__((ext_vector_type(4)));
        const int row0 = u.pm * BM + wr * 64 + fr, col0 = u.pn * BM + wc * 32 + 8 * fq;
        f32x4 c0[2], c1[2]; float rs[2][4]; unsigned long long g[2][4][2]; u32x4 ad[2][4][2];
#pragma unroll
        for (int bj = 0; bj < 2; ++bj) { c0[bj] = *(const f32x4*)(sw + col0 + bj * HALF); c1[bj] = *(const f32x4*)(sw + col0 + bj * HALF + 4); }
#pragma unroll
        for (int ai = 0; ai < 2; ++ai)
#pragma unroll
            for (int m = 0; m < 4; ++m) { const int row = row0 + ai * HALF + m * 16; rs[ai][m] = sh[row];
#pragma unroll
                for (int bj = 0; bj < 2; ++bj) { const size_t ro = (size_t)row * ldc + col0 + bj * HALF; g[ai][m][bj] = *(const unsigned long long*)(Gt + ro); ad[ai][m][bj] = (u32x4){0u, 0u, 0u, 0u}; if (Add) ad[ai][m][bj] = *(const u32x4*)(Add + ro); } }
#pragma unroll
        for (int ai = 0; ai < 2; ++ai)
#pragma unroll
            for (int m = 0; m < 4; ++m) { const int row = row0 + ai * HALF + m * 16;
#pragma unroll
                for (int bj = 0; bj < 2; ++bj) { const size_t ro = (size_t)row * ldc + col0 + bj * HALF;
                    const i32x4 i0 = __builtin_bit_cast(i32x4, acc[ai][bj][m][0]), i1 = __builtin_bit_cast(i32x4, acc[ai][bj][m][1]);
                    const f32x4 v0 = (f32x4){(float)i0[0], (float)i0[1], (float)i0[2], (float)i0[3]} * c0[bj] * rs[ai][m], v1 = (f32x4){(float)i1[0], (float)i1[1], (float)i1[2], (float)i1[3]} * c1[bj] * rs[ai][m];
                    const unsigned gw[2] = {(unsigned)g[ai][m][bj], (unsigned)(g[ai][m][bj] >> 32)}, aw[4] = {ad[ai][m][bj].x, ad[ai][m][bj].y, ad[ai][m][bj].z, ad[ai][m][bj].w}; const float vv[8] = {v0[0], v0[1], v0[2], v0[3], v1[0], v1[1], v1[2], v1[3]};
                    unsigned o[4];
#pragma unroll
                    for (int i = 0; i < 4; ++i) { const float a = vv[2 * i] * sigmoidf_(q8f(gw[i >> 1], 2 * (i & 1))) + bflo(aw[i]), b = vv[2 * i + 1] * sigmoidf_(q8f(gw[i >> 1], 2 * (i & 1) + 1)) + bfhi(aw[i]); o[i] = cvt_pk_bf16(a, b); }
                    *(u32x4*)(O + ro) = (u32x4){o[0], o[1], o[2], o[3]}; } }
    }
};
struct EpiGates16I8 {
    static constexpr bool PERM = false, AFTER_DRAIN = false;
    float* Z; const float* bias; const float* sw; const float* sh;
    __device__ __forceinline__ void operator()(const f32x4 (&acc)[2][2][4][2], const Unit& u, int wr, int wc, int fr, int fq) const {
        typedef int i32x4 __attribute__((ext_vector_type(4)));
        if (wc != 0) return;
        const f32x4 bv = *(const f32x4*)(bias + 4 * fq), cs = *(const f32x4*)(sw + 4 * fq); const int row0 = u.pm * BM + wr * 64 + fr;
#pragma unroll
        for (int ai = 0; ai < 2; ++ai)
#pragma unroll
            for (int m = 0; m < 4; ++m) { const int row = row0 + ai * HALF + m * 16; const i32x4 iv = __builtin_bit_cast(i32x4, acc[ai][0][m][0]);
                *(f32x4*)(Z + (size_t)row * 16 + 4 * fq) = (f32x4){(float)iv[0], (float)iv[1], (float)iv[2], (float)iv[3]} * cs * sh[row] + bv; }
    }
};
struct EpiResB16 {
    static constexpr bool PERM = true, AFTER_DRAIN = false;
    const float* X; bf16_t* O; int ldc;
    __device__ __forceinline__ void operator()(const f32x4 (&acc)[2][2][4][2], const Unit& u, int wr, int wc, int fr, int fq) const {
        const int row0 = u.pm * BM + wr * 64 + fr, col0 = u.pn * BM + wc * 32 + 8 * fq;
        f32x4 x0[2][4][2], x1[2][4][2];
#pragma unroll
        for (int m = 0; m < 4; ++m) { const size_t ro = (size_t)(row0 + m * 16) * ldc + col0;
#pragma unroll
            for (int bj = 0; bj < 2; ++bj) { x0[0][m][bj] = *(const f32x4*)(X + ro + bj * HALF); x1[0][m][bj] = *(const f32x4*)(X + ro + bj * HALF + 4); } }
#pragma unroll
        for (int ai = 0; ai < 2; ++ai)
#pragma unroll
            for (int m = 0; m < 4; ++m) { const size_t ro = (size_t)(row0 + ai * HALF + m * 16) * ldc + col0, rn = ro + (size_t)HALF * ldc;
#pragma unroll
                for (int bj = 0; bj < 2; ++bj) { const f32x4 v0 = x0[ai][m][bj] + acc[ai][bj][m][0], v1 = x1[ai][m][bj] + acc[ai][bj][m][1];
                    u32x4 w; w.x = cvt_pk_bf16(v0[0], v0[1]); w.y = cvt_pk_bf16(v0[2], v0[3]); w.z = cvt_pk_bf16(v1[0], v1[1]); w.w = cvt_pk_bf16(v1[2], v1[3]);
                    *(u32x4*)(O + ro + bj * HALF) = w;
                    if (ai == 0) { x0[1][m][bj] = *(const f32x4*)(X + rn + bj * HALF); x1[1][m][bj] = *(const f32x4*)(X + rn + bj * HALF + 4); } } }
    }
};
struct EpiGates16 {
    static constexpr bool PERM = false, AFTER_DRAIN = false;
    float* Z; const float* bias;
    __device__ __forceinline__ void operator()(const f32x4 (&acc)[2][2][4][2], const Unit& u, int wr, int wc, int fr, int fq) const {
        if (wc != 0) return;
        const f32x4 bv = *(const f32x4*)(bias + 4 * fq); const int row0 = u.pm * BM + wr * 64 + fr;
#pragma unroll
        for (int ai = 0; ai < 2; ++ai)
#pragma unroll
            for (int m = 0; m < 4; ++m) *(f32x4*)(Z + (size_t)(row0 + ai * HALF + m * 16) * 16 + 4 * fq) = acc[ai][0][m][0] + bv;
    }
};
template <class Sched>
__device__ __forceinline__ void gemm_dual(PG8_LAS unsigned char* lds, const Gemm g0, const Gemm g1, const Sched& S, const signed char* Gm, const signed char* Gf, const float* sw, const float* sh, bf16_t* O, int ldc) {
    int tid_ = threadIdx.x; asm volatile("" : "+v"(tid_));
    const int tid = tid_, wid = __builtin_amdgcn_readfirstlane(tid >> 6), lane = tid & 63, wr = wid >> 2, wc = wid & 3, fr = lane & 15, fq = lane >> 4;
    const int K0 = g0.K, K1 = g1.K, nt0 = K0 / BK, nt1 = K1 / BK;
    unsigned vA0, vB0, vA1, vB1;
    { int R, C; stage_rc(tid * 16, R, C); const int Rb = (R & ~31) + perm32(R & 31);
      vA0 = (unsigned)(R * K0 + C) * 2u; vB0 = (unsigned)(Rb * K0 + C) * 2u; vA1 = (unsigned)(R * K1 + C) * 2u; vB1 = (unsigned)(Rb * K1 + C) * 2u; }
    const size_t kstep = (size_t)(BK * 2), hs0 = (size_t)HALF * K0 * 2, hs1 = (size_t)HALF * K1 * 2, ts0 = 2 * hs0, ts1 = 2 * hs1;
    const unsigned ldsw = (unsigned)wid * 1024u;
    const int aoff = lds_byte(wr * 64 + fr, fq * 8), boff = lds_byte(wc * 32 + fr, fq * 8);
#define PG8_SA(b, h) (((b) * 2 + (h)) * HTB)
#define PG8_SB(b, h) ((4 + (b) * 2 + (h)) * HTB)
#define PG8_STAGE(bufoff, gbase, voff, hstp) do { _Pragma("unroll") for (int _i = 0; _i < 2; ++_i) \
        __builtin_amdgcn_global_load_lds((const unsigned*)((const char*)(gbase) + (size_t)_i * ((hstp) >> 1) + (voff)), (PG8_LAS unsigned*)(lds + (bufoff) + ldsw + _i * 8192), 16, 0, 0); } while (0)
#define PG8_LDA(dst, b, h) do { _Pragma("unroll") for (int m = 0; m < 4; ++m) _Pragma("unroll") for (int k = 0; k < 2; ++k) dst[m][k] = *(const PG8_LAS bf16x8*)(lds + PG8_SA(b, h) + aoff + m * 2048 + k * 1024); } while (0)
#define PG8_LDB(dst, b, h) do { _Pragma("unroll") for (int n = 0; n < 2; ++n) _Pragma("unroll") for (int k = 0; k < 2; ++k) dst[n][k] = *(const PG8_LAS bf16x8*)(lds + PG8_SB(b, h) + boff + n * 2048 + k * 1024); } while (0)
#define PG8_MMA(md, ai, bj, At, Bt) do { __builtin_amdgcn_s_setprio(1); _Pragma("unroll") for (int m = 0; m < 4; ++m) _Pragma("unroll") for (int n = 0; n < 2; ++n) { \
        if constexpr ((md) == 2) { _Pragma("unroll") for (int k = 0; k < 2; ++k) acc[ai][bj][m][n] = __builtin_bit_cast(f32x4, __builtin_amdgcn_mfma_i32_16x16x64_i8(__builtin_bit_cast(v4i_t, Bt[n][k]), __builtin_bit_cast(v4i_t, At[m][k]), __builtin_bit_cast(v4i_t, acc[ai][bj][m][n]), 0, 0, 0)); } \
        else { _Pragma("unroll") for (int k = 0; k < 2; ++k) acc[ai][bj][m][n] = __builtin_amdgcn_mfma_f32_16x16x32_bf16(Bt[n][k], At[m][k], acc[ai][bj][m][n], 0, 0, 0); } } __builtin_amdgcn_s_setprio(0); } while (0)
#define PG8_WAIT_V(n) asm volatile("s_waitcnt vmcnt(" #n ")" ::: "memory")
#define PG8_WAIT_L(n) asm volatile("s_waitcnt lgkmcnt(" #n ")" ::: "memory")
#define PG8_BAR __builtin_amdgcn_s_barrier()
#define PG8_SCHED __builtin_amdgcn_sched_barrier(0)
#define PG8_KLOOP(md, nt, cA, cB, vA, vB, hs, nA, nB, nvA, nvB, nhs) do { _Pragma("nounroll") for (int t = 0; t < (nt); t += 2) { \
        const bool last = (t == (nt) - 2); \
        const char* a1 = (cA) + (size_t)(t + 1) * kstep; \
        const char* a2 = last ? (nA) : (cA) + (size_t)(t + 2) * kstep; const char* b2 = last ? (nB) : (cB) + (size_t)(t + 2) * kstep; \
        const char* a3 = a2 + kstep; const char* b3 = b2 + kstep; \
        const unsigned xA = last ? (nvA) : (vA), xB = last ? (nvB) : (vB); const size_t xh = last ? (nhs) : (hs); \
        PG8_LDB(B0, 0, 0); PG8_LDB(B1, 0, 1); PG8_SCHED; PG8_LDA(At, 0, 0); PG8_STAGE(PG8_SA(1, 1), a1 + (hs), vA, hs); \
        PG8_WAIT_V(8); PG8_WAIT_L(0); PG8_BAR; PG8_MMA(md, 0, 0, At, B0); PG8_MMA(md, 0, 1, At, B1); PG8_BAR; PG8_SCHED; \
        PG8_LDA(At, 0, 1); PG8_STAGE(PG8_SB(0, 0), b2, xB, xh); PG8_STAGE(PG8_SB(0, 1), b2 + xh, xB, xh); PG8_STAGE(PG8_SA(0, 0), a2, xA, xh); \
        PG8_WAIT_V(8); PG8_WAIT_L(0); PG8_BAR; PG8_MMA(md, 1, 0, At, B0); PG8_MMA(md, 1, 1, At, B1); PG8_BAR; PG8_SCHED; \
        PG8_LDB(B0, 1, 0); PG8_LDB(B1, 1, 1); PG8_SCHED; PG8_LDA(At, 1, 0); PG8_STAGE(PG8_SA(0, 1), a2 + xh, xA, xh); \
        PG8_WAIT_V(8); PG8_WAIT_L(0); PG8_BAR; PG8_MMA(md, 0, 0, At, B0); PG8_MMA(md, 0, 1, At, B1); PG8_BAR; PG8_SCHED; \
        PG8_LDA(At, 1, 1); PG8_STAGE(PG8_SB(1, 0), b3, xB, xh); PG8_STAGE(PG8_SB(1, 1), b3 + xh, xB, xh); PG8_STAGE(PG8_SA(1, 0), a3, xA, xh); \
        PG8_WAIT_V(8); PG8_WAIT_L(0); PG8_BAR; PG8_MMA(md, 1, 0, At, B0); PG8_MMA(md, 1, 1, At, B1); PG8_BAR; PG8_SCHED; } } while (0)
    Unit cur, nxt; int ui = 0;
    if (!S.next(0, cur)) return;
    f32x4 acc[2][2][4][2];
#pragma unroll
    for (int a = 0; a < 2; ++a)
#pragma unroll
        for (int b = 0; b < 2; ++b)
#pragma unroll
            for (int m = 0; m < 4; ++m)
#pragma unroll
                for (int n = 0; n < 2; ++n) acc[a][b][m][n] = (f32x4){0.f, 0.f, 0.f, 0.f};
    bf16x8 At[4][2], B0[2][2], B1[2][2];
    const char* cA0 = (const char*)g0.A + (size_t)cur.pm * ts0; const char* cB0 = (const char*)g0.Bt + (size_t)cur.pn * ts0;
    const char* cA1 = (const char*)g1.A + (size_t)cur.pm * ts1; const char* cB1 = (const char*)g1.Bt + (size_t)cur.pn * ts1;
    PG8_STAGE(PG8_SB(0, 0), cB0, vB0, hs0); PG8_STAGE(PG8_SB(0, 1), cB0 + hs0, vB0, hs0); PG8_STAGE(PG8_SA(0, 0), cA0, vA0, hs0); PG8_STAGE(PG8_SA(0, 1), cA0 + hs0, vA0, hs0);
    if (wr == 1) PG8_BAR;
    PG8_WAIT_V(2); PG8_BAR;
    PG8_STAGE(PG8_SB(1, 0), cB0 + kstep, vB0, hs0); PG8_STAGE(PG8_SA(1, 0), cA0 + kstep, vA0, hs0); PG8_STAGE(PG8_SB(1, 1), cB0 + hs0 + kstep, vB0, hs0);
    PG8_WAIT_V(6); PG8_BAR;
    typedef int i32x4 __attribute__((ext_vector_type(4)));
    for (;;) {
        const bool has_next = S.next(ui + 1, nxt);
        PG8_KLOOP(2, nt0, cA0, cB0, vA0, vB0, hs0, cA1, cB1, vA1, vB1, hs1);
        if (wr == 0) PG8_BAR;
        {
            int t_ = threadIdx.x; asm volatile("" : "+v"(t_));
            const int row0 = cur.pm * BM + wr * 64 + (t_ & 15), col0 = cur.pn * BM + wc * 32 + 8 * ((t_ >> 4) & 3);
            f32x4 c0[2], c1[2];
#pragma unroll
            for (int bj = 0; bj < 2; ++bj) { c0[bj] = *(const f32x4*)(sw + col0 + bj * HALF); c1[bj] = *(const f32x4*)(sw + col0 + bj * HALF + 4); }
#pragma unroll
            for (int ai = 0; ai < 2; ++ai) { float rs[4]; unsigned long long gm[4][2], gf[4][2];
#pragma unroll
                for (int m = 0; m < 4; ++m) { const int row = row0 + ai * HALF + m * 16; rs[m] = sh[row];
#pragma unroll
                    for (int bj = 0; bj < 2; ++bj) { const size_t ro = (size_t)row * ldc + col0 + bj * HALF; gm[m][bj] = *(const unsigned long long*)(Gm + ro); gf[m][bj] = *(const unsigned long long*)(Gf + ro); } }
#pragma unroll
                for (int m = 0; m < 4; ++m)
#pragma unroll
                    for (int bj = 0; bj < 2; ++bj) {
                        const unsigned mw[2] = {(unsigned)gm[m][bj], (unsigned)(gm[m][bj] >> 32)}, fw[2] = {(unsigned)gf[m][bj], (unsigned)(gf[m][bj] >> 32)};
#pragma unroll
                        for (int n = 0; n < 2; ++n) { const i32x4 iv = __builtin_bit_cast(i32x4, acc[ai][bj][m][n]); const f32x4 cs = n ? c1[bj] : c0[bj]; f32x4 v;
#pragma unroll
                            for (int i = 0; i < 4; ++i) { const float ea = __builtin_amdgcn_exp2f(q8f(mw[n], i) * -1.4426950408889634f), eb = __builtin_amdgcn_exp2f(q8f(fw[n], i) * -1.4426950408889634f);
                                v[i] = (float)iv[i] * cs[i] * rs[m] * ((1.f + eb) * __builtin_amdgcn_rcpf(1.f + ea)); }
                            acc[ai][bj][m][n] = v; } } }
        }
        if (wr == 1) PG8_BAR;
        const char* nA = has_next ? (const char*)g0.A + (size_t)nxt.pm * ts0 : cA0; const char* nB = has_next ? (const char*)g0.Bt + (size_t)nxt.pn * ts0 : cB0;
        PG8_KLOOP(0, nt1, cA1, cB1, vA1, vB1, hs1, nA, nB, vA0, vB0, hs0);
        if (wr == 0) PG8_BAR;
        {
            int t_ = threadIdx.x; asm volatile("" : "+v"(t_));
            const int row0 = cur.pm * BM + wr * 64 + (t_ & 15), col0 = cur.pn * BM + wc * 32 + 8 * ((t_ >> 4) & 3);
            unsigned long long gf[2][4][2];
#pragma unroll
            for (int ai = 0; ai < 2; ++ai)
#pragma unroll
                for (int m = 0; m < 4; ++m)
#pragma unroll
                    for (int bj = 0; bj < 2; ++bj) gf[ai][m][bj] = *(const unsigned long long*)(Gf + (size_t)(row0 + ai * HALF + m * 16) * ldc + col0 + bj * HALF);
#pragma unroll
            for (int ai = 0; ai < 2; ++ai)
#pragma unroll
                for (int m = 0; m < 4; ++m)
#pragma unroll
                    for (int bj = 0; bj < 2; ++bj) { const unsigned fw[2] = {(unsigned)gf[ai][m][bj], (unsigned)(gf[ai][m][bj] >> 32)}; const f32x4 v0 = acc[ai][bj][m][0], v1 = acc[ai][bj][m][1]; u32x4 w;
                        w.x = cvt_pk_bf16(v0[0] * sigmoidf_(q8f(fw[0], 0)), v0[1] * sigmoidf_(q8f(fw[0], 1))); w.y = cvt_pk_bf16(v0[2] * sigmoidf_(q8f(fw[0], 2)), v0[3] * sigmoidf_(q8f(fw[0], 3)));
                        w.z = cvt_pk_bf16(v1[0] * sigmoidf_(q8f(fw[1], 0)), v1[1] * sigmoidf_(q8f(fw[1], 1))); w.w = cvt_pk_bf16(v1[2] * sigmoidf_(q8f(fw[1], 2)), v1[3] * sigmoidf_(q8f(fw[1], 3)));
                        *(u32x4*)(O + (size_t)(row0 + ai * HALF + m * 16) * ldc + col0 + bj * HALF) = w; }
        }
        if (!has_next) break;
#pragma unroll
        for (int a = 0; a < 2; ++a)
#pragma unroll
            for (int b = 0; b < 2; ++b)
#pragma unroll
                for (int m = 0; m < 4; ++m)
#pragma unroll
                    for (int n = 0; n < 2; ++n) acc[a][b][m][n] = (f32x4){0.f, 0.f, 0.f, 0.f};
        cur = nxt; cA0 = nA; cB0 = nB; cA1 = (const char*)g1.A + (size_t)cur.pm * ts1; cB1 = (const char*)g1.Bt + (size_t)cur.pn * ts1; ++ui;
        if (wr == 1) PG8_BAR;
    }
    PG8_WAIT_V(0);
    PG8_BAR;
#undef PG8_SA
#undef PG8_SB
#undef PG8_STAGE
#undef PG8_LDA
#undef PG8_LDB
#undef PG8_MMA
#undef PG8_WAIT_V
#undef PG8_WAIT_L
#undef PG8_BAR
#undef PG8_SCHED
#undef PG8_KLOOP
}
}
namespace fox {
using bf16 = __hip_bfloat16;
constexpr int D = 128, SQ = 8192, SKV = 8192, QOFF = 0, WINDOW = SKV, PITCH = 1024;
constexpr float THR = 8.f; constexpr bool WSKIP = false;
constexpr float SCALE = 0.08838834764831845f;
constexpr int NW = 8, QBLK = 32, KVBLK = 64, QB = NW * QBLK;
constexpr int SHM_V = KVBLK * D * 2, SHM_K = KVBLK * D * 2;
constexpr int LDS_CS = 2 * SHM_V + 2 * SHM_K + NW * 64 * 4; constexpr int LDS_BYTES = LDS_CS + 2 * 64 * 4;

typedef short bf16x8 __attribute__((ext_vector_type(8)));
typedef short s16x4 __attribute__((ext_vector_type(4)));
typedef float f32x16 __attribute__((ext_vector_type(16)));
typedef float f32x4 __attribute__((ext_vector_type(4)));
typedef unsigned u32x4 __attribute__((ext_vector_type(4)));
template <class A, class Bt> struct same_t { static constexpr bool v = false; };
template <class A> struct same_t<A, A> { static constexpr bool v = true; };

#define KSWZ(row, colB) ((row) * 256 + ((colB) ^ (((row) & 7) << 4)))
#define SBAR() __builtin_amdgcn_sched_barrier(0)
__device__ __forceinline__ int v_st(int k, int c) { const int kk = (k & ~0xC) | ((k & 4) << 1) | ((k & 8) >> 1); return ((kk >> 3) * 4 + (c >> 5)) * 512 + ((kk & 7) * 32 + (c & 31)) * 2; }
__device__ __forceinline__ int v_rd_base(int lane) { return ((lane & 3) << 3) | (((lane >> 2) & 3) << 6) | (((lane >> 4) & 1) << 5) | (((lane >> 5) & 1) << 8); }
constexpr int v_rd_off(int d0, int ks, int half) { return d0 * 512 + ks * 4096 + half * 2048; }
__device__ __forceinline__ int crow(int r, int hi) { return (r & 3) + 8 * (r >> 2) + 4 * hi; }
__device__ __forceinline__ unsigned cvtpk(float lo, float hi) {
    unsigned r; asm volatile("v_cvt_pk_bf16_f32 %0, %1, %2" : "=v"(r) : "v"(lo), "v"(hi)); return r;
}
__device__ __forceinline__ bf16x8 pack8(f32x4 a, f32x4 b) {
    u32x4 w = {cvtpk(a[0], a[1]), cvtpk(a[2], a[3]), cvtpk(b[0], b[1]), cvtpk(b[2], b[3])};
    return *reinterpret_cast<bf16x8*>(&w);
}
template <class T> __device__ __forceinline__ bf16x8 load8(const T* p) {
    if constexpr (same_t<T, float>::v) { return pack8(*(const f32x4*)p, *(const f32x4*)(p + 4)); }
    else { return *reinterpret_cast<const bf16x8*>(p); }
}
__device__ __forceinline__ void mask_tile(f32x16& p0, f32x16& p1, int dq, unsigned W) {
    const float NEG = -__builtin_inff();
#pragma unroll
    for (int r = 0; r < 16; ++r) {
        const int c = (r & 3) + 8 * (r >> 2);
        if ((unsigned)(dq - c) >= W) p0[r] = NEG;
        if ((unsigned)(dq - c - 32) >= W) p1[r] = NEG;
    }
}
__device__ __forceinline__ void partialSM(f32x16& p0, f32x16& p1, float& m_reg, float& mn, float& alpha) {
    float pmax = p0[0]; for (int r = 1; r < 16; ++r) pmax = fmaxf(pmax, p0[r]); for (int r = 0; r < 16; ++r) pmax = fmaxf(pmax, p1[r]);
    { auto rr = __builtin_amdgcn_permlane32_swap(__float_as_uint(pmax), __float_as_uint(pmax), false, false);
      pmax = fmaxf(__uint_as_float(rr[0]), __uint_as_float(rr[1])); }
    constexpr float C2 = 1.4426950408889634f * SCALE;
    if (__builtin_expect(__all((pmax - m_reg) * SCALE <= THR), 1)) { mn = m_reg; alpha = 1.f; }
    else { mn = fmaxf(m_reg, pmax); alpha = __builtin_amdgcn_exp2f((m_reg - mn) * C2); m_reg = mn; }
    const float mnL = -mn * C2;
    for (int r = 0; r < 16; ++r) p0[r] = fmaf(p0[r], C2, mnL); for (int r = 0; r < 16; ++r) p1[r] = fmaf(p1[r], C2, mnL);
    for (int r = 0; r < 16; ++r) p0[r] = __builtin_amdgcn_exp2f(p0[r]);
}
__device__ __forceinline__ void finishSM(f32x16& p0, f32x16& p1, float alpha, float& l_reg, bf16x8& pa0, bf16x8& pa1, bf16x8& pa2, bf16x8& pa3) {
    for (int r = 0; r < 16; ++r) p1[r] = __builtin_amdgcn_exp2f(p1[r]);
    float ps = 0; for (int r = 0; r < 16; ++r) ps += p0[r]; for (int r = 0; r < 16; ++r) ps += p1[r];
    { auto rr = __builtin_amdgcn_permlane32_swap(__float_as_uint(ps), __float_as_uint(ps), false, false);
      ps = __uint_as_float(rr[0]) + __uint_as_float(rr[1]); }
    l_reg = l_reg * alpha + ps;
#define PK4(P, B_, OUT) do { unsigned a0 = cvtpk(P[B_+0], P[B_+1]), a1 = cvtpk(P[B_+2], P[B_+3]);                          \
        unsigned b0 = cvtpk(P[B_+4], P[B_+5]), b1 = cvtpk(P[B_+6], P[B_+7]);                                             \
        auto r0 = __builtin_amdgcn_permlane32_swap(a0, b0, false, false); auto r1 = __builtin_amdgcn_permlane32_swap(a1, b1, false, false); \
        u32x4 w = {r0[0], r1[0], r0[1], r1[1]}; OUT = *reinterpret_cast<bf16x8*>(&w); } while (0)
    PK4(p0, 0, pa0); PK4(p0, 8, pa1); PK4(p1, 0, pa2); PK4(p1, 8, pa3);
#undef PK4
}
template <int KB, bool SK>
__device__ __forceinline__ void qkt(f32x16& p0, f32x16& p1, const char* K_lds, int r32, int hi, const bf16x8* qr, bool act, const float* cs_lds) {
    if (SK && !act) { const float NEG = -__builtin_inff();
#pragma unroll
        for (int r = 0; r < 16; ++r) { p0[r] = NEG; p1[r] = NEG; } return; }
    { const float* ck_ = cs_lds + KB * 64 + 4 * hi;
#pragma unroll
      for (int g_ = 0; g_ < 4; ++g_) { const f32x4 c0_ = *(const f32x4*)(ck_ + 8 * g_), c1_ = *(const f32x4*)(ck_ + 32 + 8 * g_);
#pragma unroll
          for (int i_ = 0; i_ < 4; ++i_) { p0[4 * g_ + i_] = c0_[i_]; p1[4 * g_ + i_] = c1_[i_]; } } }
    const char* kb[4];
#pragma unroll
    for (int dd = 0; dd < 4; ++dd) kb[dd] = K_lds + KB * SHM_K + KSWZ(r32, (dd * 16 + hi * 8) * 2);
#pragma unroll
    for (int d0 = 0; d0 < 8; ++d0) { const char* a = kb[d0 & 3] + (d0 >> 2) * 128;
        bf16x8 b0 = *reinterpret_cast<const bf16x8*>(a);
        bf16x8 b1 = *reinterpret_cast<const bf16x8*>(a + 32 * 256);
        p0 = __builtin_amdgcn_mfma_f32_32x32x16_bf16(b0, qr[d0], p0, 0, 0, 0);
        p1 = __builtin_amdgcn_mfma_f32_32x32x16_bf16(b1, qr[d0], p1, 0, 0, 0); }
}
template <int VB, bool SK>
__device__ __forceinline__ void pv_tile(f32x16* o, int vb0, bf16x8 pa0, bf16x8 pa1, bf16x8 pa2, bf16x8 pa3, bool act) {
    if (SK && !act) return;
#define TRRD(dst, off) asm volatile("ds_read_b64_tr_b16 %0, %1 offset:%2" : "=&v"(dst) : "v"(vb0), "i"(off) : "memory")
#define PV_D0(d0) do { s16x4 l0, l1, l2, l3, h0, h1, h2, h3; constexpr int b_ = VB * SHM_V + v_rd_off(d0, 0, 0);     \
        TRRD(l0, b_); TRRD(h0, b_ + 2048); TRRD(l1, b_ + 4096); TRRD(h1, b_ + 6144); TRRD(l2, b_ + 8192); TRRD(h2, b_ + 10240); TRRD(l3, b_ + 12288); TRRD(h3, b_ + 14336); \
        asm volatile("s_waitcnt lgkmcnt(0)" ::: "memory"); SBAR();                 \
        o[d0] = __builtin_amdgcn_mfma_f32_32x32x16_bf16(pa0, (bf16x8){l0[0], l0[1], l0[2], l0[3], h0[0], h0[1], h0[2], h0[3]}, o[d0], 0, 0, 0);   \
        o[d0] = __builtin_amdgcn_mfma_f32_32x32x16_bf16(pa1, (bf16x8){l1[0], l1[1], l1[2], l1[3], h1[0], h1[1], h1[2], h1[3]}, o[d0], 0, 0, 0);   \
        o[d0] = __builtin_amdgcn_mfma_f32_32x32x16_bf16(pa2, (bf16x8){l2[0], l2[1], l2[2], l2[3], h2[0], h2[1], h2[2], h2[3]}, o[d0], 0, 0, 0);   \
        o[d0] = __builtin_amdgcn_mfma_f32_32x32x16_bf16(pa3, (bf16x8){l3[0], l3[1], l3[2], l3[3], h3[0], h3[1], h3[2], h3[3]}, o[d0], 0, 0, 0); } while (0)
    PV_D0(0); PV_D0(1); PV_D0(2); PV_D0(3);
#undef PV_D0
#undef TRRD
}

template <class TIn> struct FoxBases { const TIn* K; const TIn* V; const float* CS; };
template <class TIn, class TOut> struct BlockRef { const TIn* Q; unsigned kv; unsigned cs; int P0; int jlo; };
template <class TIn> struct Seam {
    bf16x8 qr[8];
    bf16x8 st_v0, st_v1, st_k0, st_k1; float st_c; f32x4 sf0, sf1, sf2, sf3;
    f32x4 tq[16];
};
__device__ __forceinline__ int swa_jlo(int P0, int W) { const int lowk = P0 - W + 1; return lowk > 0 ? lowk / KVBLK : 0; }
#define ROW(p, k0, rr) ((p) + (size_t)(k0) * PITCH + (((rr) == sr) ? ro0 : ro1))
#define VMW() asm volatile("s_waitcnt vmcnt(0)" ::: "memory")
#define VMWN(n) asm volatile("s_waitcnt vmcnt(%0)" :: "i"(n) : "memory")
#define SLOAD_H(Kp, Vp, Cp, k0) do { if (tid < 64) S.st_c = (Cp)[(k0) + tid]; S.st_v0 = load8<TIn>(ROW(Vp, k0, sr)); S.st_v1 = load8<TIn>(ROW(Vp, k0, 32 + sr));              \
                         S.st_k0 = load8<TIn>(ROW(Kp, k0, sr)); S.st_k1 = load8<TIn>(ROW(Kp, k0, 32 + sr)); } while (0)
#define SWRITE_HK(bf) do { if (tid < 64) cs_lds[(bf) * 64 + tid] = S.st_c; *(bf16x8*)(K_lds + (bf) * SHM_K + kws) = S.st_k0; *(bf16x8*)(K_lds + (bf) * SHM_K + kws + 32 * 256) = S.st_k1; } while (0)
#define SWRITE_HV(bf) do { *(bf16x8*)(V_lds + (bf) * SHM_V + vst0) = S.st_v0; *(bf16x8*)(V_lds + (bf) * SHM_V + vst1) = S.st_v1; } while (0)
#define SWRITE_H(bf) do { SWRITE_HV(bf); SWRITE_HK(bf); } while (0)
#define SLOAD_F(p, k0) do { S.sf0 = *(const f32x4*)ROW(p, k0, sr); S.sf1 = *(const f32x4*)(ROW(p, k0, sr) + 4);                \
                            S.sf2 = *(const f32x4*)ROW(p, k0, 32 + sr); S.sf3 = *(const f32x4*)(ROW(p, k0, 32 + sr) + 4); } while (0)
#define SWRITE_KF(bf) do { *(bf16x8*)(K_lds + (bf) * SHM_K + kws) = pack8(S.sf0, S.sf1); *(bf16x8*)(K_lds + (bf) * SHM_K + kws + 32 * 256) = pack8(S.sf2, S.sf3); } while (0)
#define SWRITE_VF(bf) do { *(bf16x8*)(V_lds + (bf) * SHM_V + vst0) = pack8(S.sf0, S.sf1); *(bf16x8*)(V_lds + (bf) * SHM_V + vst1) = pack8(S.sf2, S.sf3); } while (0)
template <class TIn, class TOut>
__device__ __forceinline__ void causal_swa_prime(const FoxBases<TIn>& FB, const BlockRef<TIn, TOut>& cur, int W, char* lds, Seam<TIn>& S) {
    constexpr bool F32 = same_t<TIn, float>::v;
    const int tid = threadIdx.x, wid = __builtin_amdgcn_readfirstlane(tid >> 6), lane = tid & 63, r32 = lane & 31, hi = lane >> 5;
    const int sr = tid >> 4, sc = (tid & 15) * 8, kws = KSWZ(sr, sc * 2); const unsigned ro0 = (unsigned)(sr * PITCH + sc), ro1 = ro0 + 32u * PITCH; char* K_lds = lds + 2 * SHM_V; float* cs_lds = (float*)(lds + LDS_CS);
    const int kb0 = cur.P0 + QB - KVBLK;
    for (int d0 = 0; d0 < 8; ++d0) S.qr[d0] = load8<TIn>(cur.Q + (unsigned)((wid * QBLK + r32) * PITCH) + d0 * 16 + hi * 8);
    if constexpr (F32) { SLOAD_F((const float*)(FB.K + cur.kv), kb0); VMW(); SWRITE_KF(0); SBAR(); SLOAD_F((const float*)(FB.V + cur.kv), kb0); }
    else { SLOAD_H(FB.K + cur.kv, FB.V + cur.kv, FB.CS + cur.cs, kb0); VMW(); SWRITE_HK(0); }
    __syncthreads();
}
template <class TIn, class TOut>
__device__ __forceinline__ void causal_swa_block(const FoxBases<TIn>& FB, const BlockRef<TIn, TOut>& cur, const BlockRef<TIn, TOut>& nxt, int skv, int W, char* lds, Seam<TIn>& S) {
    constexpr bool F32 = same_t<TIn, float>::v;
    const int tid = threadIdx.x, wid = __builtin_amdgcn_readfirstlane(tid >> 6), lane = tid & 63, r32 = lane & 31, hi = lane >> 5;
    const int j_lo = cur.jlo;
    int j_hi = (cur.P0 + QB - 1) / KVBLK + 1; if (j_hi > skv / KVBLK) j_hi = skv / KVBLK;
    const int NT = j_hi - j_lo;
    const int kbn = nxt.P0 + QB - KVBLK;
    const int qlo = cur.P0 + wid * QBLK, qm = qlo + r32 - 4 * hi;
    char* V_lds = lds; char* K_lds = lds + 2 * SHM_V; float* cs_lds = (float*)(lds + LDS_CS);
    float* ws = (float*)(lds + 2 * SHM_V + 2 * SHM_K) + wid * 64; float* li_l = ws, * al_l = ws + 32;
    float m_reg = -1e30f, l_reg = 0; f32x16 o[4] = {};
    const int sr = tid >> 4, sc = (tid & 15) * 8, vst0 = v_st(sr, sc), vst1 = v_st(32 + sr, sc), kws = KSWZ(sr, sc * 2); const unsigned ro0 = (unsigned)(sr * PITCH + sc), ro1 = ro0 + 32u * PITCH;
    const int vb0 = (int)(uintptr_t)V_lds + v_rd_base(lane);
    const TIn* Kh = FB.K + cur.kv; const TIn* Vh = FB.V + cur.kv; const float* Ch = FB.CS + cur.cs;
#define RESC(a) do { if (__any((a) < 1.f)) { if (hi == 0) al_l[r32] = (a); asm volatile("s_waitcnt lgkmcnt(0)" ::: "memory");              \
                     for (int d_ = 0; d_ < 4; ++d_) for (int r = 0; r < 16; ++r) o[d_][r] *= al_l[crow(r, hi)]; } } while (0)
#define KBASE(t) ((j_hi - 1 - (t)) * KVBLK)
#define ACT(t) (KBASE(t) <= qlo + QBLK - 1 && KBASE(t) + KVBLK - 1 >= qlo - W + 1)
#define MASKT(P0_, P1_, t) do { const int kb_ = KBASE(t); if ((!SK || ACT(t)) && (kb_ + KVBLK - 1 > qlo || kb_ <= qlo + QBLK - 1 - W)) mask_tile(P0_, P1_, qm - kb_, (unsigned)W); } while (0)
    constexpr int NQL = F32 ? 16 : 8;
    constexpr bool SK = WSKIP && !F32;
#define SEAM_K0() do { VMWN(NQL); if constexpr (F32) { SWRITE_KF(0); SBAR(); SLOAD_F((const float*)(FB.V + nxt.kv), kbn); } else { SWRITE_HK(0); } SBAR(); } while (0)
    f32x16 pA0, pA1, pB0, pB1; float mnA, mnB, alA, alB; bf16x8 pa0, pa1, pa2, pa3;
    if constexpr (F32) { VMW(); SWRITE_VF(0); SBAR(); } else { SWRITE_HV(0); SBAR(); }
    if (NT > 1) { if constexpr (F32) SLOAD_F((const float*)Kh, KBASE(1)); else SLOAD_H(Kh, Vh, Ch, KBASE(1)); }
    SBAR(); qkt<0, SK>(pA0, pA1, K_lds, r32, hi, S.qr, ACT(0), cs_lds);
    if constexpr (F32) { if (NT > 1) { VMW(); SWRITE_KF(1); SBAR(); SLOAD_F((const float*)Vh, KBASE(1)); } }
    MASKT(pA0, pA1, 0); partialSM(pA0, pA1, m_reg, mnA, alA);
    if (NT > 1) { VMW(); if constexpr (F32) { SWRITE_VF(1); SBAR(); if (NT > 2) SLOAD_F((const float*)Kh, KBASE(2)); } else SWRITE_H(1); }
    __syncthreads();
#define HALF_STEP(PX0, PX1, mnX, alX, PY0, PY1, alY, t, KB, VB, SB) do {                                                      \
        SBAR(); qkt<KB, SK>(PX0, PX1, K_lds, r32, hi, S.qr, ACT(t), cs_lds);                                             \
        finishSM(PY0, PY1, alY, l_reg, pa0, pa1, pa2, pa3); SBAR();                                                           \
        if ((t) + 1 < NT) { if constexpr (F32) { VMW(); SWRITE_KF(SB); SBAR(); SLOAD_F((const float*)Vh, KBASE((t) + 1)); }  \
                            else { SLOAD_H(Kh, Vh, Ch, KBASE((t) + 1)); } SBAR(); }                                               \
        pv_tile<VB, SK>(o, vb0, pa0, pa1, pa2, pa3, ACT((t) - 1)); MASKT(PX0, PX1, (t)); partialSM(PX0, PX1, m_reg, mnX, alX);                                        \
        __syncthreads();                                                                                                      \
        if ((t) + 1 < NT) { VMW(); if constexpr (F32) { SWRITE_VF(SB); SBAR(); if ((t) + 2 < NT) SLOAD_F((const float*)Kh, KBASE((t) + 2)); } \
                            else { SWRITE_H(SB); } }                                                                          \
        RESC(alX); __syncthreads(); } while (0)
    for (int t = 1; t + 1 < NT; t += 2) {
        HALF_STEP(pB0, pB1, mnB, alB, pA0, pA1, alA, t, 1, 0, 0);
        HALF_STEP(pA0, pA1, mnA, alA, pB0, pB1, alB, t + 1, 0, 1, 1);
    }
    const bool even = (NT & 1) == 0;
    if (even) { SBAR(); qkt<1, SK>(pB0, pB1, K_lds, r32, hi, S.qr, ACT(NT - 1), cs_lds); SBAR(); }
#define QROW(e) (nxt.Q + (unsigned)((wid * QBLK + r32) * PITCH) + ((e) >> 1) * 16 + hi * 8 + ((e) & 1) * 4)
    if constexpr (F32) { SLOAD_F((const float*)(FB.K + nxt.kv), kbn); SBAR();
#pragma unroll
        for (int e = 0; e < 8; ++e) S.tq[e] = *(const f32x4*)QROW(e); }
    else { SLOAD_H(FB.K + nxt.kv, FB.V + nxt.kv, FB.CS + nxt.cs, kbn); SBAR();
#pragma unroll
        for (int d0 = 0; d0 < 8; ++d0) S.qr[d0] = load8<TIn>(nxt.Q + (unsigned)((wid * QBLK + r32) * PITCH) + d0 * 16 + hi * 8); }
    SBAR();
    finishSM(pA0, pA1, alA, l_reg, pa0, pa1, pa2, pa3); SBAR();
    if constexpr (F32) {
#pragma unroll
        for (int e = 8; e < 16; ++e) S.tq[e] = *(const f32x4*)QROW(e); SBAR(); }
#undef QROW
    pv_tile<0, SK>(o, vb0, pa0, pa1, pa2, pa3, ACT(even ? NT - 2 : NT - 1));
    if (even) { MASKT(pB0, pB1, NT - 1); partialSM(pB0, pB1, m_reg, mnB, alB); __syncthreads(); RESC(alB);
        finishSM(pB0, pB1, alB, l_reg, pa0, pa1, pa2, pa3); SBAR(); pv_tile<1, SK>(o, vb0, pa0, pa1, pa2, pa3, ACT(NT - 1)); }
    SBAR(); SEAM_K0();
    if (hi == 0) li_l[r32] = l_reg; asm volatile("s_waitcnt lgkmcnt(0)" ::: "memory");
    float rli[16];
#pragma unroll
    for (int r = 0; r < 16; ++r) rli[r] = __builtin_amdgcn_rcpf(li_l[crow(r, hi)]);
    TOut* Ow = (TOut*)cur.Q + (unsigned)((wid * QBLK) * PITCH);
#pragma unroll
    for (int r = 0; r < 16; ++r) { const int orow = crow(r, hi);
#pragma unroll
        for (int d0 = 0; d0 < 4; ++d0) { const float v = o[d0][r] * rli[r];
            if constexpr (same_t<TOut, float>::v) { Ow[(unsigned)(orow * PITCH) + d0 * 32 + r32] = v; }
            else { const float vn = __shfl_xor(v, 1);
                   if ((r32 & 1) == 0) *(unsigned*)(Ow + (unsigned)(orow * PITCH) + d0 * 32 + r32) = cvtpk(v, vn); } } }
    if constexpr (F32) {
#pragma unroll
        for (int d0 = 0; d0 < 8; ++d0) S.qr[d0] = pack8(S.tq[2 * d0], S.tq[2 * d0 + 1]); }
    __syncthreads();
#undef RESC
#undef KBASE
#undef ACT
#undef MASKT
#undef SEAM_K0
#undef HALF_STEP
}
#undef ROW
#undef VMW
#undef VMWN
#undef SLOAD_H
#undef SWRITE_HK
#undef SWRITE_HV
#undef SWRITE_H
#undef SLOAD_F
#undef SWRITE_KF
#undef SWRITE_VF

}
namespace fox {
constexpr float SKIP_LOG = 12.f;
__device__ __forceinline__ BlockRef<bf16, bf16> mkref(int b, int n, const bf16* Q, const int* JLO) {
    const int h = 7 - (n >> 5), qb = 31 - (n & 31), bh = b * 8 + h; const unsigned base = (unsigned)b * SKV * PITCH + (unsigned)h * D;
    BlockRef<bf16, bf16> r; r.Q = Q + base + (size_t)qb * QB * PITCH; r.kv = base; r.cs = (unsigned)bh * SKV; r.P0 = qb * QB;
    r.jlo = JLO[bh * 32 + qb];
    return r;
}
__device__ __forceinline__ void jlo_table(const float* CS, const float* DQK, const float* qg, const float* kg, int* JLO, int gw, int NGW, int lane) {
    float gq = fmaxf(fabsf(qg[lane]), fabsf(qg[64 + lane])), gk = fmaxf(fabsf(kg[lane]), fabsf(kg[64 + lane]));
#pragma unroll
    for (int o = 1; o < 64; o <<= 1) { gq = fmaxf(gq, __shfl_xor(gq, o)); gk = fmaxf(gk, __shfl_xor(gk, o)); }
    const float qkmax = 128.f * gq * gk;
    for (int i = gw; i < 64 * 32; i += NGW) { const int bh = i >> 5, qb = i & 31, b = bh >> 3, h = bh & 7; const float* cs = CS + (size_t)bh * SKV;
        float dmin = 3.4e38f;
#pragma unroll
        for (int r = 0; r < 4; ++r) dmin = fminf(dmin, DQK[((size_t)b * SKV + qb * QB + 64 * r + lane) * 8 + h]);
#pragma unroll
        for (int o = 1; o < 64; o <<= 1) dmin = fminf(dmin, __shfl_xor(dmin, o));
        dmin = fmaxf(dmin - 0.01f * fabsf(dmin) - 0.01f, -qkmax);
        const float thr = cs[qb * QB] - qkmax + dmin - SKIP_LOG * 11.313708498984761f; const int nt = 4 * qb;
        const bool c0 = lane < nt && cs[64 * lane + 63] < thr, c1 = lane + 64 < nt && cs[64 * (lane + 64) + 63] < thr;
        const int j = __popcll(__ballot(c0)) + __popcll(__ballot(c1));
        if (lane == 0) JLO[i] = j; }
}
__device__ __forceinline__ int fetch_ticket(unsigned* Qw, int xcc) {
    for (int s = 0; s < 8; ++s) { const int b = (xcc + s) & 7; const unsigned n = __hip_atomic_fetch_add(Qw + 64 * b, 1u, __ATOMIC_RELAXED, __HIP_MEMORY_SCOPE_AGENT); if (n < 256u) return b * 256 + (int)n; }
    return 1 << 20;
}
__device__ __forceinline__ void phase(char* lds, const bf16* Q, const bf16* K, const bf16* V, bf16* O, const float* CS, const int* JLO, unsigned* Qw, int xcc, unsigned* done = nullptr) {
    const int tid = threadIdx.x; const FoxBases<bf16> FB{K, V, CS}; (void)O;
    volatile int* tk = (volatile int*)(lds + LDS_BYTES);
    __syncthreads();
    if (tid == 0) { tk[0] = fetch_ticket(Qw, xcc); tk[1] = fetch_ticket(Qw, xcc); }
    __syncthreads();
    int n0 = __builtin_amdgcn_readfirstlane(tk[0]), n1 = __builtin_amdgcn_readfirstlane(tk[1]);
    if (n0 >= 2048) return;
    BlockRef<bf16, bf16> cur = mkref(n0 >> 8, n0 & 255, Q, JLO);
    Seam<bf16> S;
    causal_swa_prime<bf16, bf16>(FB, cur, WINDOW, lds, S);
    for (;;) {
        const bool last = n1 >= 2048;
        const BlockRef<bf16, bf16> nxt = last ? cur : mkref(n1 >> 8, n1 & 255, Q, JLO);
        if (tid == 0 && !last) tk[0] = fetch_ticket(Qw, xcc);
        causal_swa_block<bf16, bf16>(FB, cur, nxt, SKV, WINDOW, lds, S);
        if (done && tid == 0) __hip_atomic_fetch_add(done, 1u, __ATOMIC_RELAXED, __HIP_MEMORY_SCOPE_AGENT);
        if (last) break;
        cur = nxt; n1 = __builtin_amdgcn_readfirstlane(tk[0]);
        __syncthreads();
    }
}
}
__device__ __forceinline__ int sortable(float f) { int i = __builtin_bit_cast(int, f); return i ^ ((i >> 31) & 0x7fffffff); }
__device__ __forceinline__ float unsortable(int i) { return __builtin_bit_cast(float, i ^ ((i >> 31) & 0x7fffffff)); }
__device__ __forceinline__ int med3i(int a, int b, int c) { int r; asm("v_med3_i32 %0, %1, %2, %3" : "=v"(r) : "v"(a), "v"(b), "v"(c)); return r; }
__device__ __forceinline__ void ins16(int (&t)[16], int x) {
#pragma unroll
    for (int i = 15; i >= 1; --i) t[i] = med3i(t[i - 1], t[i], x);
    t[0] = t[0] > x ? t[0] : x;
}
struct P9Args { const bf16raw* QH; const bf16raw* SKB; unsigned short* IDS; float* GW; };
constexpr int P9_KP = 136;
__device__ __forceinline__ void p9_half(const P9Args& a, const LAS bf16raw* SK, size_t tok, int h, int c, int m32, int hh, int (&t)[16]) {
    bf16x8 bq[8];
#pragma unroll
    for (int kk = 0; kk < 8; ++kk) bq[kk] = *(const bf16x8*)(a.QH + tok * 2048 + h * 256 + c * 128 + 16 * kk + 8 * hh);
#pragma unroll
    for (int i = 0; i < 16; ++i) t[i] = (int)0x80000000;
#pragma unroll
    for (int kt = 0; kt < 4; ++kt) {
        f32x16 acc;
#pragma unroll
        for (int r = 0; r < 16; ++r) acc[r] = 0.f;
#pragma unroll
        for (int kk = 0; kk < 8; ++kk) { const bf16x8 af = *(const LAS bf16x8*)(SK + (32 * kt + m32) * P9_KP + 16 * kk + 8 * hh);
            acc = __builtin_amdgcn_mfma_f32_32x32x16_bf16(af, bq[kk], acc, 0, 0, 0); }
#pragma unroll
        for (int r = 0; r < 16; ++r) { const int kidx = 32 * kt + (r & 3) + 8 * (r >> 2) + 4 * hh; ins16(t, (sortable(acc[r]) & ~127) | (127 - kidx)); }
    }
    int p[16];
#pragma unroll
    for (int i = 0; i < 16; ++i) { auto rr = __builtin_amdgcn_permlane32_swap((unsigned)t[i], (unsigned)t[i], false, false); p[i] = (int)(hh ? rr[0] : rr[1]); }
#pragma unroll
    for (int i = 0; i < 16; ++i) t[i] = t[i] > p[15 - i] ? t[i] : p[15 - i];
#pragma unroll
    for (int d = 8; d >= 1; d >>= 1)
#pragma unroll
        for (int i = 0; i < 16; ++i) if ((i & d) == 0) { const int hi_ = t[i] > t[i + d] ? t[i] : t[i + d], lo_ = t[i] > t[i + d] ? t[i + d] : t[i]; t[i] = hi_; t[i + d] = lo_; }
}
__device__ __forceinline__ void p9_stage(const bf16raw* SKB, LAS unsigned char* lds, int buf, int hc, int tid) {
#pragma unroll
    for (int k = 0; k < 4; ++k) { const int i = tid + 512 * k, row = i >> 4, ch = i & 15;
        *(LAS v4u*)(lds + buf * (128 * P9_KP * 2) + row * (P9_KP * 2) + 16 * ch) = *(const v4u*)(SKB + ((size_t)hc * 128 + row) * 128 + 8 * ch); }
}
__device__ __forceinline__ int pick8(unsigned long long lo, unsigned long long hi, int i) { const unsigned long long w = (i & 8) ? hi : lo; return (int)((w >> (8 * (i & 7))) & 255ull); }
__device__ __forceinline__ void p9_topk(LAS unsigned char* lds, const P9Args& a, int wg0, int nwg, int wave, int lane, int tid) {
    const int m32 = lane & 31, hh = lane >> 5;
    for (int tw = wg0; tw < M / 256; tw += nwg) {
        const size_t tok = (size_t)tw * 256 + 32 * wave + m32;
        __syncthreads();
        p9_stage(a.SKB, lds, 0, 0, tid);
        __syncthreads();
        for (int h = 0; h < PH; ++h) {
            int L0[16], L1[16];
            p9_stage(a.SKB, lds, 1, 2 * h + 1, tid);
            p9_half(a, (const LAS bf16raw*)(lds), tok, h, 0, m32, hh, L0);
            __syncthreads();
            if (h + 1 < PH) p9_stage(a.SKB, lds, 0, 2 * h + 2, tid);
            p9_half(a, (const LAS bf16raw*)(lds + 128 * P9_KP * 2), tok, h, 1, m32, hh, L1);
            float v0[16], v1[16]; unsigned long long P0l = 0, P0h = 0, P1l = 0, P1h = 0;
#pragma unroll
            for (int i = 0; i < 16; ++i) { v0[i] = unsortable(L0[i] & ~127); v1[i] = unsortable(L1[i] & ~127);
                if (i < 8) { P0l |= (unsigned long long)(127 - (L0[i] & 127)) << (8 * (i & 7)); P1l |= (unsigned long long)(127 - (L1[i] & 127)) << (8 * (i & 7)); }
                else { P0h |= (unsigned long long)(127 - (L0[i] & 127)) << (8 * (i & 7)); P1h |= (unsigned long long)(127 - (L1[i] & 127)) << (8 * (i & 7)); } }
            int t2[16];
#pragma unroll
            for (int j = 0; j < 16; ++j) t2[j] = (sortable(v0[0] + v1[j]) & ~255) | (255 - j);
#pragma unroll
            for (int i = 1; i < 16; ++i)
#pragma unroll
                for (int j = 0; j < 16; ++j) if ((i + 1) * (j + 1) <= 16) ins16(t2, (sortable(v0[i] + v1[j]) & ~255) | (255 - (16 * i + j)));
            const float ts0 = unsortable(t2[0] & ~255); float ex[16]; int ids[16]; float sum = 0.f;
#pragma unroll
            for (int k = 0; k < 16; ++k) { ex[k] = __expf(unsortable(t2[k] & ~255) - ts0); sum += ex[k];
                const int ci = 255 - (t2[k] & 255), i = ci >> 4, j = ci & 15;
                ids[k] = pick8(P0l, P0h, i) * 128 + pick8(P1l, P1h, j); }
            const float inv = __builtin_amdgcn_rcpf(sum);
            if (hh == 0) {
#pragma unroll
                for (int q = 0; q < 2; ++q) *(v4u*)(a.IDS + tok * HK + h * 16 + 8 * q) = (v4u){(unsigned)ids[8 * q] | ((unsigned)ids[8 * q + 1] << 16), (unsigned)ids[8 * q + 2] | ((unsigned)ids[8 * q + 3] << 16), (unsigned)ids[8 * q + 4] | ((unsigned)ids[8 * q + 5] << 16), (unsigned)ids[8 * q + 6] | ((unsigned)ids[8 * q + 7] << 16)};
            } else {
#pragma unroll
                for (int q = 0; q < 4; ++q) *(f32x4*)(a.GW + tok * HK + h * 16 + 4 * q) = (f32x4){ex[4 * q] * inv, ex[4 * q + 1] * inv, ex[4 * q + 2] * inv, ex[4 * q + 3] * inv};
            }
            __syncthreads();
        }
    }
}

constexpr float U_SCALE = 256.f, V_SCALE = 16.f, U4_STEP = 0.345f, X7_RESCALE = 127.f / 63.f;
constexpr size_t SLICE_BYTES = (size_t)NEXP * 128;
__device__ __forceinline__ void cvt16p(const v4u r, f32x2 (&f)[8]) {
    const unsigned w[4] = {r.x, r.y, r.z, r.w};
#pragma unroll
    for (int i = 0; i < 4; ++i) { f[2 * i] = __builtin_amdgcn_cvt_pk_f32_fp8((int)w[i], false); f[2 * i + 1] = __builtin_amdgcn_cvt_pk_f32_fp8((int)w[i], true); }
}
__device__ __forceinline__ unsigned e2m1_code(float x) {
    const float m = fabsf(x);
    const unsigned c = (unsigned)(m > 0.25f) + (unsigned)(m >= 0.75f) + (unsigned)(m > 1.25f) + (unsigned)(m >= 1.75f) + (unsigned)(m > 2.5f) + (unsigned)(m >= 3.5f) + (unsigned)(m > 5.f);
    return c | (x < 0.f ? 8u : 0u);
}
__device__ __forceinline__ float e2m1_val(unsigned c) { const unsigned m = c & 7u; const float v = m < 4u ? 0.5f * (float)m : m == 4u ? 2.f : m == 5u ? 3.f : m == 6u ? 4.f : 6.f; return (c & 8u) ? -v : v; }
typedef __amdgpu_buffer_rsrc_t prsrc_t;
__device__ __forceinline__ v4u pbld16(prsrc_t r, unsigned voff) { return __builtin_bit_cast(v4u, __builtin_amdgcn_raw_buffer_load_b128(r, (int)voff, 0, 0)); }
template <int CTRL> __device__ __forceinline__ float dpp_add(float v) { return v + __builtin_bit_cast(float, __builtin_amdgcn_update_dpp(0, __builtin_bit_cast(int, v), CTRL, 0xf, 0xf, false)); }
template <int CTRL> __device__ __forceinline__ int dpp_addi(int v) { return v + __builtin_amdgcn_update_dpp(0, v, CTRL, 0xf, 0xf, false); }
__device__ __forceinline__ void p15_udot(const unsigned char* XH, const unsigned char* XL, const unsigned char* U4S, const unsigned short* IDS, short* PA, unsigned* Q, int xcc, int lane) {
    const int sub = lane & 7, tk = lane >> 3;
    for (int sidx = 0; sidx < 4; ++sidx) { const int s = (xcc + sidx) & 3; const prsrc_t tab = __builtin_amdgcn_make_buffer_rsrc((void*)(U4S + (size_t)s * SLICE_BYTES), (short)0, (int)SLICE_BYTES, 0x00020000);
        for (;;) {
            unsigned t0 = 0; if (lane == 0) t0 = __hip_atomic_fetch_add(Q + 64 * s, 16u, __ATOMIC_RELAXED, __HIP_MEMORY_SCOPE_AGENT);
            t0 = (unsigned)__builtin_amdgcn_readfirstlane((int)t0);
            if (t0 >= (unsigned)M) break;
            for (int it = 0; it < 2; ++it) { const size_t t = (size_t)t0 + 8 * it + tk;
                const v4u xh = *(const v4u*)(XH + t * 512 + 128 * s + 16 * sub), xl = *(const v4u*)(XL + t * 512 + 128 * s + 16 * sub);
                int res[16];
#pragma unroll
                for (int b8 = 0; b8 < 8; ++b8) { const int i0 = 16 * b8;
                    int id[16];
#pragma unroll
                    for (int q = 0; q < 2; ++q) { const v4u v = *(const v4u*)(IDS + t * HK + i0 + 8 * q); id[8 * q] = v.x & 0xffffu; id[8 * q + 1] = v.x >> 16; id[8 * q + 2] = v.y & 0xffffu; id[8 * q + 3] = v.y >> 16; id[8 * q + 4] = v.z & 0xffffu; id[8 * q + 5] = v.z >> 16; id[8 * q + 6] = v.w & 0xffffu; id[8 * q + 7] = v.w >> 16; }
                    v4u row[16];
#pragma unroll
                    for (int i = 0; i < 16; ++i) row[i] = pbld16(tab, (unsigned)id[i] * 128u + 16u * sub);
                    int r0 = 0, r1 = 0;
#pragma unroll
                    for (int i = 0; i < 16; ++i) { int ph = __builtin_amdgcn_sdot8((int)xh.x, (int)row[i].x, 0, false); ph = __builtin_amdgcn_sdot8((int)xh.y, (int)row[i].y, ph, false);
                        ph = __builtin_amdgcn_sdot8((int)xh.z, (int)row[i].z, ph, false); ph = __builtin_amdgcn_sdot8((int)xh.w, (int)row[i].w, ph, false);
                        int p = __builtin_amdgcn_sdot8((int)xl.x, (int)row[i].x, ph << 3, false); p = __builtin_amdgcn_sdot8((int)xl.y, (int)row[i].y, p, false);
                        p = __builtin_amdgcn_sdot8((int)xl.z, (int)row[i].z, p, false); p = __builtin_amdgcn_sdot8((int)xl.w, (int)row[i].w, p, false);
                        p = dpp_addi<0xB1>(p); p = dpp_addi<0x4E>(p); p = dpp_addi<0x141>(p);
                        if (sub == (i & 7)) { if (i < 8) r0 = p; else r1 = p; } }
                    res[2 * b8] = r0; res[2 * b8 + 1] = r1; }
#pragma unroll
                for (int q = 0; q < 2; ++q) { unsigned w[4];
#pragma unroll
                    for (int z = 0; z < 4; ++z) { const int lo = min(max(res[8 * q + 2 * z], -32767), 32767), hi = min(max(res[8 * q + 2 * z + 1], -32767), 32767); w[z] = ((unsigned)lo & 0xffffu) | ((unsigned)hi << 16); }
                    *(v4u*)(PA + ((size_t)s * M + t) * HK + q * 64 + sub * 8) = (v4u){w[0], w[1], w[2], w[3]}; }
            }
        }
    }
}
struct ActL1 { short pa[2][4]; unsigned short id[2]; float gw[2]; float sx; };
struct ActL2 { float su[2], sv[2]; };
__device__ __forceinline__ void act_l1(const short* PA, const float* GW, const float* SX, const unsigned short* IDS, int t, int lane, ActL1& r) {
    r.sx = SX[t];
#pragma unroll
    for (int h = 0; h < 2; ++h) { const int e = lane + 64 * h, pos = (e >> 6) * 64 + (e & 7) * 8 + ((e >> 3) & 7);
#pragma unroll
        for (int s = 0; s < 4; ++s) r.pa[h][s] = PA[((size_t)s * M + t) * HK + pos];
        r.id[h] = IDS[(size_t)t * HK + e]; r.gw[h] = GW[(size_t)t * HK + e]; }
}
__device__ __forceinline__ void p15b_act(const short* PA, const float* GW, unsigned char* W4, float* WSC, const float* SX, const float* SU, const float* SV, const unsigned short* IDS, int gw, int NGW, int lane) {
    if (gw >= M) return;
    ActL1 a0, a1, a2; ActL2 b0, b1;
    act_l1(PA, GW, SX, IDS, gw, lane, a0); act_l1(PA, GW, SX, IDS, gw + NGW < M ? gw + NGW : gw, lane, a1);
#pragma unroll
    for (int h = 0; h < 2; ++h) { b0.su[h] = SU[a0.id[h]]; b0.sv[h] = SV[a0.id[h]]; }
    for (int t = gw; t < M; t += NGW) { const int t2 = t + 2 * NGW; act_l1(PA, GW, SX, IDS, t2 < M ? t2 : t, lane, a2);
#pragma unroll
        for (int h = 0; h < 2; ++h) { b1.su[h] = SU[a1.id[h]]; b1.sv[h] = SV[a1.id[h]]; }
        float w[2]; const float sx = a0.sx * X7_RESCALE;
#pragma unroll
        for (int h = 0; h < 2; ++h) { const int a = (int)a0.pa[h][0] + (int)a0.pa[h][1] + (int)a0.pa[h][2] + (int)a0.pa[h][3]; w[h] = a0.gw[h] * gelu_erf((float)a * sx * b0.su[h]) * b0.sv[h]; }
        float mx = fmaxf(fabsf(w[0]), fabsf(w[1]));
#pragma unroll
        for (int o = 1; o < 64; o <<= 1) mx = fmaxf(mx, __shfl_xor(mx, o));
        mx = fmaxf(mx, 1e-30f); const float sc = 6.f / mx; if (lane == 0) WSC[t] = mx * (1.f / 6.f);
#pragma unroll
        for (int h = 0; h < 2; ++h) { float x = w[h] * sc;
#pragma unroll
            for (int r = 0; r < 4; ++r) { const unsigned c = e2m1_code(fminf(fmaxf(x, -6.f), 6.f)); x = (x - e2m1_val(c)) * 4.f;
                const unsigned oc = (unsigned)__shfl_xor((int)c, 1);
                if (!(lane & 1)) W4[(size_t)t * 256 + r * 64 + 32 * h + (lane >> 1)] = (unsigned char)(c | (oc << 4)); } }
        a0 = a1; a1 = a2; b0 = b1; }
}
typedef int pv2i __attribute__((ext_vector_type(2)));
typedef int pv8i __attribute__((ext_vector_type(8)));
struct VsRows { v4u row[16]; };
#define VS_GAS __attribute__((address_space(1)))
template <class T> __device__ __forceinline__ VS_GAS T* vs_uni(T* p) {
    const unsigned long long v = (unsigned long long)p; const unsigned lo = (unsigned)__builtin_amdgcn_readfirstlane((int)(unsigned)v), hi = (unsigned)__builtin_amdgcn_readfirstlane((int)(unsigned)(v >> 32));
    return (VS_GAS T*)(((unsigned long long)hi << 32) | lo);
}
__device__ __forceinline__ void vs_ids(const unsigned short* IDS, size_t t, int r, int (&id)[16]) {
    const VS_GAS unsigned short* ip = vs_uni(IDS + t * HK) + 16 * r;
#pragma unroll
    for (int q = 0; q < 2; ++q) { const v4u v = *(const VS_GAS v4u*)(ip + 8 * q); id[8 * q] = v.x & 0xffffu; id[8 * q + 1] = v.x >> 16; id[8 * q + 2] = v.y & 0xffffu; id[8 * q + 3] = v.y >> 16; id[8 * q + 4] = v.z & 0xffffu; id[8 * q + 5] = v.z >> 16; id[8 * q + 6] = v.w & 0xffffu; id[8 * q + 7] = v.w >> 16; }
}
__device__ __forceinline__ void vs_gather(prsrc_t tab, const int (&id)[16], int sub, VsRows& R) {
#pragma unroll
    for (int n = 0; n < 16; ++n) R.row[n] = pbld16(tab, (unsigned)id[n] * 128u + 16u * sub);
}
struct VsSmall { v4u a; float xi[4]; float isc; };
__device__ __forceinline__ void vs_small(const unsigned char* W4, const float* WSC, const bf16raw* X1B, size_t t, int s, int lane, VsSmall& S) {
    const int j = lane & 15, kg = lane >> 4;
    S.a = *(const VS_GAS v4u*)(vs_uni(W4 + t * 256) + (j & 3) * 64 + 16 * kg);
    const VS_GAS bf16raw* xb = vs_uni(X1B + t * D + 256 * s);
    S.isc = *vs_uni(WSC + t);
#pragma unroll
    for (int G = 0; G < 4; ++G) S.xi[G] = __builtin_bit_cast(float, (unsigned)xb[64 * G + lane] << 16);
}
template <bool PF1, bool PF2, int MODE = 0>
__device__ __forceinline__ void vs_unit(float& keep, LAS unsigned char* wl, prsrc_t tab, const unsigned short* IDS, const unsigned char* W4, const float* WSC, const bf16raw* X1B, float* OUT, size_t t, size_t t1, size_t t2, int s, int lane, VsRows& cur, VsRows& nxt, int (&idg)[16], int (&idl)[16], VsSmall& sc, VsSmall& sn) {
    const int sub = lane & 7, r = lane >> 3, j = lane & 15, kg = lane >> 4;
    if (PF1) vs_small(W4, WSC, X1B, t1, s, lane, sn);
    if (PF2) vs_ids(IDS, t2, r, idl);
    asm volatile("" ::: "memory");
    if (PF1) {
#pragma unroll
        for (int k = 0; k < 16; ++k) asm volatile("" : "+v"(idg[k]));
        vs_gather(tab, idg, sub, nxt); }
    asm volatile("" ::: "memory");
#pragma unroll
    for (int n = 0; n < 16; ++n) { const int e = 16 * r + n; *(LAS v4u*)(wl + e * 128 + ((sub ^ ((e >> 1) & 7)) << 4)) = cur.row[n]; }
    asm volatile("" ::: "memory");
    const int row0 = 32 * kg + j, row1 = row0 + 16, f0 = (row0 >> 1) & 7, f1 = (row1 >> 1) & 7;
    const v4u a0 = sc.a;
    float o[4];
#pragma unroll
    for (int G = 0; G < 4; ++G) { f32x4 acc = (f32x4){0.f, 0.f, 0.f, 0.f};
#pragma unroll
        for (int q = 0; q < 4; ++q) { const int g = 4 * G + q, c = g >> 1, hf = 8 * (g & 1);
            const pv2i b0 = __builtin_amdgcn_ds_read_tr4_b64_v2i32((LAS pv2i*)(wl + row0 * 128 + ((c ^ f0) << 4) + hf));
            const pv2i b1 = __builtin_amdgcn_ds_read_tr4_b64_v2i32((LAS pv2i*)(wl + row1 * 128 + ((c ^ f1) << 4) + hf));
            const bool mine = (j >> 2) == q;
            const pv8i A = (pv8i){mine ? (int)a0.x : 0, mine ? (int)a0.y : 0, mine ? (int)a0.z : 0, mine ? (int)a0.w : 0, 0, 0, 0, 0};
            const pv8i B = (pv8i){b0.x, b0.y, b1.x, b1.y, 0, 0, 0, 0};
            acc = __builtin_amdgcn_mfma_scale_f32_16x16x128_f8f6f4(A, B, acc, 4, 4, 0, 0x7F7F7F7F, 0, 0x7F7F7F7F); }
        o[G] = ((acc[0] + acc[1] * 0.25f) + (acc[2] * (1.f / 16.f) + acc[3] * (1.f / 64.f))) * sc.isc; }
    asm volatile("" ::: "memory");
    VS_GAS float* ob = vs_uni(OUT + t * D + 256 * s);
#pragma unroll
    for (int G = 0; G < 4; ++G) { if (MODE == 0) ob[64 * G + lane] = sc.xi[G] + o[G]; else keep += sc.xi[G] + o[G]; }
}
__device__ __forceinline__ unsigned vs_ticket(unsigned* q, int lane) { unsigned t0 = 0; if (lane == 0) t0 = __hip_atomic_fetch_add(q, 16u, __ATOMIC_RELAXED, __HIP_MEMORY_SCOPE_AGENT); return t0; }
template <int MODE = 0>
__device__ __forceinline__ void p16_vsum(LAS unsigned char* lds, const unsigned char* V4S, const unsigned short* IDS, const unsigned char* W4, const float* WSC, const bf16raw* X1B, float* OUT, unsigned* Q, int xcc, int wave, int lane) {
    LAS unsigned char* wl = lds + wave * 16384; float keep = 0.f;
    const int sub = lane & 7, r = lane >> 3;
    for (int sidx = 0; sidx < 4; ++sidx) { const int s = (xcc + sidx) & 3; const prsrc_t tab = __builtin_amdgcn_make_buffer_rsrc((void*)(V4S + (size_t)s * SLICE_BYTES), (short)0, (int)SLICE_BYTES, 0x00020000);
        unsigned tkc = (unsigned)__builtin_amdgcn_readfirstlane((int)vs_ticket(Q + 64 * s, lane));
        if (tkc >= (unsigned)M) continue;
        VsRows ra, rb; int idA[16], idB[16]; VsSmall sa, sb;
        vs_ids(IDS, (size_t)tkc, r, idA); vs_gather(tab, idA, sub, ra); vs_ids(IDS, (size_t)tkc + 1, r, idB); vs_small(W4, WSC, X1B, (size_t)tkc, s, lane, sa);
        for (;;) {
            const unsigned tkn_raw = vs_ticket(Q + 64 * s, lane);
#pragma unroll
            for (int u = 0; u < 14; u += 2) { unsigned tu = tkc + u; asm volatile("" : "+s"(tu));
                vs_unit<true, true, MODE>(keep, wl, tab, IDS, W4, WSC, X1B, OUT, (size_t)tu, (size_t)tu + 1, (size_t)tu + 2, s, lane, ra, rb, idB, idA, sa, sb);
                vs_unit<true, true, MODE>(keep, wl, tab, IDS, W4, WSC, X1B, OUT, (size_t)tu + 1, (size_t)tu + 2, (size_t)tu + 3, s, lane, rb, ra, idA, idB, sb, sa); }
            const unsigned tkn = (unsigned)__builtin_amdgcn_readfirstlane((int)tkn_raw);
            if (tkn < (unsigned)M) { vs_unit<true, true, MODE>(keep, wl, tab, IDS, W4, WSC, X1B, OUT, (size_t)tkc + 14, (size_t)tkc + 15, (size_t)tkn, s, lane, ra, rb, idB, idA, sa, sb);
                                     vs_unit<true, true, MODE>(keep, wl, tab, IDS, W4, WSC, X1B, OUT, (size_t)tkc + 15, (size_t)tkn, (size_t)tkn + 1, s, lane, rb, ra, idA, idB, sb, sa); tkc = tkn; }
            else { vs_unit<true, false, MODE>(keep, wl, tab, IDS, W4, WSC, X1B, OUT, (size_t)tkc + 14, (size_t)tkc + 15, 0, s, lane, ra, rb, idB, idA, sa, sb);
                   vs_unit<false, false, MODE>(keep, wl, tab, IDS, W4, WSC, X1B, OUT, (size_t)tkc + 15, 0, 0, s, lane, rb, ra, idA, idB, sb, sa); break; }
        }
    }
    if (MODE != 0 && keep == 123.456f) OUT[lane] = keep;
}
__device__ __forceinline__ void quant_u_i4_sliced(const float* src, unsigned char* dst, float* su, int gw, int NGW, int lane) {
    for (int e = gw; e < NEXP; e += NGW) { const int c0 = 16 * lane; f32x4 v[4]; float ss = 0.f;
#pragma unroll
        for (int q = 0; q < 4; ++q) { v[q] = *(const f32x4*)(src + (size_t)e * D + c0 + 4 * q); ss += (v[q].x * v[q].x + v[q].y * v[q].y) + (v[q].z * v[q].z + v[q].w * v[q].w); }
#pragma unroll
        for (int o = 1; o < 64; o <<= 1) ss += __shfl_xor(ss, o);
        const float sc = fmaxf(sqrtf(ss * (1.f / 1024.f)) * U4_STEP, 1e-30f), inv = 1.f / sc; if (lane == 0) su[e] = sc;
        unsigned o2[2];
#pragma unroll
        for (int h = 0; h < 2; ++h) { unsigned w = 0u;
#pragma unroll
            for (int q = 0; q < 2; ++q)
#pragma unroll
                for (int z = 0; z < 4; ++z) { const int qi = (int)fminf(fmaxf(__builtin_rintf(v[2 * h + q][z] * inv), -7.f), 7.f); w |= (unsigned)(qi & 15) << (16 * q + 4 * z); }
            o2[h] = w; }
        *(unsigned long long*)(dst + (size_t)(c0 >> 8) * SLICE_BYTES + (size_t)e * 128 + ((c0 & 255) >> 1)) = (unsigned long long)o2[0] | ((unsigned long long)o2[1] << 32); }
}
__device__ __forceinline__ void cvt_fp4_sliced(const float* src, unsigned char* dst, float* SV, size_t gtid, size_t gthreads) {
    for (size_t i = gtid; i < (size_t)NEXP * 64; i += gthreads) { const size_t e = i >> 6; const int m_ = (int)(i & 63);
        f32x4 v[4]; float mx = 0.f;
#pragma unroll
        for (int q = 0; q < 4; ++q) { v[q] = *(const f32x4*)(src + e * D + 16 * m_ + 4 * q); mx = fmaxf(fmaxf(mx, fmaxf(fabsf(v[q].x), fabsf(v[q].y))), fmaxf(fabsf(v[q].z), fabsf(v[q].w))); }
#pragma unroll
        for (int o = 1; o < 64; o <<= 1) mx = fmaxf(mx, __shfl_xor(mx, o));
        const float sc = fmaxf(mx, 1e-30f) * (1.f / 6.f), inv = 1.f / sc; if (m_ == 0) SV[e] = sc;
        unsigned w0 = 0u, w1 = 0u;
#pragma unroll
        for (int q = 0; q < 2; ++q)
#pragma unroll
            for (int z = 0; z < 4; ++z) { w0 |= e2m1_code(v[q][z] * inv) << (16 * q + 4 * z); w1 |= e2m1_code(v[2 + q][z] * inv) << (16 * q + 4 * z); }
        *(unsigned long long*)(dst + (size_t)(m_ >> 4) * SLICE_BYTES + e * 128 + 8 * (m_ & 15)) = (unsigned long long)w0 | ((unsigned long long)w1 << 32);
    }
}
__device__ __forceinline__ void transpose_item(const float* W, int ldw, int col0, int K, bf16raw* WT, int row_off, LAS float* scr, int kb, int nb, int lane) {
    const int k0 = 64 * kb, n0 = 32 * nb;
#pragma unroll 8
    for (int i = 0; i < 32; ++i) { const int kk = 2 * i + (lane >> 5); scr[kk * 33 + (lane & 31)] = W[(size_t)(k0 + kk) * ldw + col0 + n0 + (lane & 31)]; }
    asm volatile("s_waitcnt lgkmcnt(0)" ::: "memory");
    const int c = lane & 7;
#pragma unroll
    for (int j = 0; j < 4; ++j) { const int n = (lane >> 3) + 8 * j; const LAS float* s = scr + (8 * c) * 33 + n;
        v4u o; o.x = pk2(s[0 * 33], s[1 * 33]); o.y = pk2(s[2 * 33], s[3 * 33]); o.z = pk2(s[4 * 33], s[5 * 33]); o.w = pk2(s[6 * 33], s[7 * 33]);
        *(v4u*)(WT + (size_t)(row_off + n0 + n) * K + k0 + 8 * c) = o; }
    asm volatile("s_waitcnt lgkmcnt(0)" ::: "memory");
}
__device__ __forceinline__ unsigned pk4_fp8(float a, float b, float c, float d) { int w = 0; w = __builtin_amdgcn_cvt_pk_fp8_f32(fminf(fmaxf(a, -448.f), 448.f), fminf(fmaxf(b, -448.f), 448.f), w, false);
    w = __builtin_amdgcn_cvt_pk_fp8_f32(fminf(fmaxf(c, -448.f), 448.f), fminf(fmaxf(d, -448.f), 448.f), w, true); return (unsigned)w; }
__device__ __forceinline__ void transpose_item_fp8(const float* W, int ldw, int col0, int K, unsigned char* WT, int row_off, LAS float* scr, int kb, int nb, int lane, float scale) {
    const int k0 = 64 * kb, n0 = 32 * nb;
#pragma unroll 8
    for (int i = 0; i < 32; ++i) { const int kk = 2 * i + (lane >> 5); scr[kk * 33 + (lane & 31)] = W[(size_t)(k0 + kk) * ldw + col0 + n0 + (lane & 31)]; }
    asm volatile("s_waitcnt lgkmcnt(0)" ::: "memory");
    const int c = lane & 7;
#pragma unroll
    for (int j = 0; j < 4; ++j) { const int n = (lane >> 3) + 8 * j; const LAS float* s = scr + (8 * c) * 33 + n;
        v2u o; o.x = pk4_fp8(s[0 * 33] * scale, s[1 * 33] * scale, s[2 * 33] * scale, s[3 * 33] * scale); o.y = pk4_fp8(s[4 * 33] * scale, s[5 * 33] * scale, s[6 * 33] * scale, s[7 * 33] * scale);
        *(v2u*)(WT + (size_t)(row_off + n0 + n) * K + k0 + 8 * c) = o; }
    asm volatile("s_waitcnt lgkmcnt(0)" ::: "memory");
}
__device__ __forceinline__ int win_src_col(int g);
__device__ __forceinline__ int gate_src_col(int n);
__device__ __forceinline__ void colmax_item(const float* W, int ldw, int col0, unsigned* cmax, int row_off, int nb, int kq, int lane) {
    const int n0 = 32 * nb; float mx = 0.f;
#pragma unroll 8
    for (int i = 0; i < 64; ++i) { const int kk = 128 * kq + 2 * i + (lane >> 5); mx = fmaxf(mx, fabsf(W[(size_t)kk * ldw + col0 + n0 + (lane & 31)])); }
    mx = fmaxf(mx, __shfl_xor(mx, 32));
    if (lane < 32) atomicMax(cmax + row_off + n0 + lane, __builtin_bit_cast(unsigned, mx));
}
__device__ __forceinline__ void quant_item_i8(const float* W, int ldw, int col0, signed char* WT, const unsigned* cmax, float* sw, int row_off, LAS float* scr, int kb, int nb, int lane) {
    const int k0 = 64 * kb, n0 = 32 * nb;
    const float sc = fmaxf(__builtin_bit_cast(float, cmax[row_off + n0 + (lane & 31)]), 1e-30f) * (1.f / 127.f), inv = 1.f / sc;
    if (kb == 0 && lane < 32) sw[row_off + n0 + lane] = sc;
#pragma unroll 8
    for (int i = 0; i < 32; ++i) { const int kk = 2 * i + (lane >> 5); scr[kk * 33 + (lane & 31)] = W[(size_t)(k0 + kk) * ldw + col0 + n0 + (lane & 31)] * inv; }
    asm volatile("s_waitcnt lgkmcnt(0)" ::: "memory");
    const int c = lane & 7;
#pragma unroll
    for (int j = 0; j < 4; ++j) { const int n = (lane >> 3) + 8 * j; const LAS float* s = scr + (8 * c) * 33 + n; int q[8];
#pragma unroll
        for (int e2 = 0; e2 < 8; ++e2) q[e2] = (int)__builtin_rintf(s[e2 * 33]);
        v2u o; o.x = (unsigned)(q[0] & 255) | ((unsigned)(q[1] & 255) << 8) | ((unsigned)(q[2] & 255) << 16) | ((unsigned)(q[3] & 255) << 24);
        o.y = (unsigned)(q[4] & 255) | ((unsigned)(q[5] & 255) << 8) | ((unsigned)(q[6] & 255) << 16) | ((unsigned)(q[7] & 255) << 24);
        *(v2u*)(WT + (size_t)(row_off + n0 + n) * 1024 + k0 + 8 * c) = o; }
    asm volatile("s_waitcnt lgkmcnt(0)" ::: "memory");
}
__device__ __forceinline__ void p0b_quant_w(LAS unsigned char* lds, const float* w_in, const float* wpq, const float* wm, signed char* WT, float* sw, const unsigned* cmax, int gw, int NGW, int wave, int lane) {
    LAS float* scr = (LAS float*)(lds + wave * 16384);
    for (int it = gw; it < 9 * 512 + 1024 + 512; it += NGW) {
        if (it < 9 * 512) { const int g = it / 512, q = it % 512; quant_item_i8(w_in, DIN, win_src_col(g), WT, cmax, sw, 1024 * g, scr, q / 32, q % 32, lane); }
        else if (it < 9 * 512 + 1024) { const int q = it - 9 * 512; quant_item_i8(wpq, 2048, 0, WT, cmax, sw, 9216, scr, q / 64, q % 64, lane); }
        else { const int q = it - 9 * 512 - 1024; quant_item_i8(wm, 1024, 0, WT, cmax, sw, 11264, scr, q / 32, q % 32, lane); } }
    for (int i = gw * 64 + lane; i < 256 * 1024; i += NGW * 64) { const int n = i >> 10, k = i & 1023; signed char qv = 0;
        if (n < 16) { const float sc = fmaxf(__builtin_bit_cast(float, cmax[12288 + n]), 1e-30f) * (1.f / 127.f); qv = (signed char)(int)__builtin_rintf(w_in[(size_t)k * DIN + gate_src_col(n)] / sc); if (k == 0) sw[12288 + n] = sc; }
        WT[(size_t)(12288 + n) * 1024 + k] = qv; }
}
__device__ __forceinline__ void cvt_bf16_stream(const float* src, bf16raw* dst, size_t n, size_t gtid, size_t gthreads) {
    for (size_t i = gtid * 8; i < n; i += gthreads * 8) { const f32x4 a = *(const f32x4*)(src + i), b = *(const f32x4*)(src + i + 4);
        v4u o; o.x = pk2(a.x, a.y); o.y = pk2(a.z, a.w); o.z = pk2(b.x, b.y); o.w = pk2(b.z, b.w); *(v4u*)(dst + i) = o; }
}
constexpr float H8_SCALE = 16.f, W8_SCALE = 256.f;
__device__ __forceinline__ void rms_row_load(const float* xrow, int lane, f32x4 (&v)[4]) {
    const f32x4* xr = (const f32x4*)xrow + lane;
#pragma unroll
    for (int j = 0; j < 4; ++j) v[j] = xr[64 * j];
}
__device__ __forceinline__ void rms_row_load_b16(const bf16raw* xrow, int lane, f32x4 (&v)[4]) {
#pragma unroll
    for (int j = 0; j < 4; ++j) { const v2u w = *(const v2u*)(xrow + 256 * j + 4 * lane); v[j] = (f32x4){bflo(w.x), bfhi(w.x), bflo(w.y), bfhi(w.y)}; }
}
__device__ __forceinline__ void rms_gain_load(const float* gain, int lane, f32x4 (&gr)[4]) {
#pragma unroll
    for (int j = 0; j < 4; ++j) gr[j] = ((const f32x4*)gain + lane)[64 * j];
}
__device__ __forceinline__ void rms_row_to_bf16(const f32x4 (&v)[4], const f32x4 (&gr)[4], bf16raw* orow, int lane, unsigned char* o8row = nullptr, float* shrow = nullptr, unsigned char* xhrow = nullptr, unsigned char* xlrow = nullptr) {
    float s = 0.f;
#pragma unroll
    for (int j = 0; j < 4; ++j) { s += (v[j].x * v[j].x + v[j].y * v[j].y) + (v[j].z * v[j].z + v[j].w * v[j].w); }
    const float rstd = __builtin_amdgcn_rsqf(wave_sum(s) * (1.f / 1024.f) + EPS);
    unsigned long long* o8 = (unsigned long long*)orow + lane;
    f32x4 hh[4]; float mx = 0.f;
#pragma unroll
    for (int j = 0; j < 4; ++j) { const f32x4 g = gr[j]; hh[j] = (f32x4){v[j].x * rstd * g.x, v[j].y * rstd * g.y, v[j].z * rstd * g.z, v[j].w * rstd * g.w};
        if (orow) o8[64 * j] = (unsigned long long)pk2(hh[j].x, hh[j].y) | ((unsigned long long)pk2(hh[j].z, hh[j].w) << 32);
        mx = fmaxf(fmaxf(mx, fmaxf(fabsf(hh[j].x), fabsf(hh[j].y))), fmaxf(fabsf(hh[j].z), fabsf(hh[j].w))); }
    if (o8row) {
#pragma unroll
        for (int o = 1; o < 64; o <<= 1) mx = fmaxf(mx, __shfl_xor(mx, o));
        const float sc = fmaxf(mx, 1e-30f) * (1.f / 127.f), inv = __builtin_amdgcn_rcpf(sc);
        if (lane == 0) *shrow = sc;
#pragma unroll
        for (int j = 0; j < 4; ++j) ((unsigned*)o8row)[64 * j + lane] = q8x4_pack(hh[j].x, hh[j].y, hh[j].z, hh[j].w, inv);
        if (xhrow) { const float inv7 = inv * (63.f / 127.f);
#pragma unroll
            for (int j = 0; j < 4; ++j) { const unsigned p7 = q8x4_pack(hh[j].x, hh[j].y, hh[j].z, hh[j].w, inv7);
                ((unsigned short*)xhrow)[64 * j + lane] = (unsigned short)nib4((p7 >> 3) & 0x0F0F0F0Fu);
                ((unsigned short*)xlrow)[64 * j + lane] = (unsigned short)nib4(p7 & 0x07070707u); } } }
}
template <class R, class LD, class PR>
__device__ __forceinline__ void rows_pipe3(int m0, int m1, int mstep, const LD& LOAD, const PR& PROC) {
    if (m0 >= m1) return;
    R r0, r1, r2; LOAD(m0, r0); LOAD(m0 + mstep < m1 ? m0 + mstep : m0, r1);
    for (int m = m0; m < m1; m += 3 * mstep) { const int ma = m + mstep, mb = ma + mstep, mc = mb + mstep, md = mc + mstep;
        LOAD(mb < m1 ? mb : m0, r2); PROC(m, r0); if (ma >= m1) break;
        LOAD(mc < m1 ? mc : m0, r0); PROC(ma, r1); if (mb >= m1) break;
        LOAD(md < m1 ? md : m0, r1); PROC(mb, r2); }
}
struct RowF32 { f32x4 v[4]; };
struct RowB16 { v2u w[4]; };
__device__ __forceinline__ void rms_rows_phase(const float* X, const float* gain, bf16raw* O, int m0, int m1, int mstep, int lane, unsigned char* O8 = nullptr, float* SH = nullptr, unsigned char* XH = nullptr, unsigned char* XL = nullptr) {
    f32x4 gr[4]; rms_gain_load(gain, lane, gr);
    rows_pipe3<RowF32>(m0, m1, mstep, [&](int m, RowF32& r) { rms_row_load(X + (size_t)m * D, lane, r.v); },
        [&](int m, const RowF32& r) { rms_row_to_bf16(r.v, gr, O ? O + (size_t)m * D : nullptr, lane, O8 ? O8 + (size_t)m * D : nullptr, SH ? SH + m : nullptr, XH ? XH + (size_t)m * 512 : nullptr, XL ? XL + (size_t)m * 512 : nullptr); });
}
__device__ __forceinline__ void rms_row_load_raw16(const bf16raw* xrow, int lane, v2u (&w)[4]) {
#pragma unroll
    for (int j = 0; j < 4; ++j) w[j] = *(const v2u*)(xrow + 256 * j + 4 * lane);
}
__device__ __forceinline__ void rms_rows_phase_b16(const bf16raw* X, const float* gain, int m0, int m1, int mstep, int lane, unsigned char* O8, float* SH, unsigned char* XH = nullptr, unsigned char* XL = nullptr) {
    f32x4 gr[4]; rms_gain_load(gain, lane, gr);
    rows_pipe3<RowB16>(m0, m1, mstep, [&](int m, RowB16& r) { rms_row_load_raw16(X + (size_t)m * D, lane, r.w); },
        [&](int m, const RowB16& r) { f32x4 v[4];
#pragma unroll
            for (int j = 0; j < 4; ++j) v[j] = (f32x4){bflo(r.w[j].x), bfhi(r.w[j].x), bflo(r.w[j].y), bfhi(r.w[j].y)};
            rms_row_to_bf16(v, gr, nullptr, lane, O8 + (size_t)m * D, SH + m, XH ? XH + (size_t)m * 512 : nullptr, XL ? XL + (size_t)m * 512 : nullptr); });
}
__device__ __forceinline__ int win_src_col(int g) { return g == 0 ? 0 : g == 1 ? 1024 : g == 2 ? 2048 : g == 3 ? 4104 : g == 4 ? 5128 : g == 5 ? 6152 : g == 6 ? 3072 : g == 7 ? 7184 : 8208; }
__device__ __forceinline__ int gate_src_col(int n) { return n < 8 ? 4096 + n : 7176 + (n - 8); }
struct P0Args { const float *x, *n1g, *w_in, *b_in, *wm, *wf, *wo, *wpq, *sk, *ut, *vt; bf16raw *WinT, *WgT, *WmT, *WfT, *WoT, *WpqT, *SKB, *UB, *VB, *H; float *biasP, *biasG; unsigned char* H8; bf16raw* WinTb; float* SH; unsigned* CMAX; };
__device__ __forceinline__ void p0_prologue(LAS unsigned char* lds, const P0Args& a, int vcu, int G, int wave, int lane, int tid) {
    LAS float* scr = (LAS float*)(lds + wave * 16384);
    const int gw = vcu * NWAVES + wave, NGW = G * NWAVES;
    constexpr int NI_G = 16 * 32;
    constexpr int NITEMS = 9 * NI_G + 3 * NI_G + 2 * NI_G;
    for (int it = gw; it < NITEMS; it += NGW) {
        int r = it;
        if (r < 9 * NI_G) { if (r < 288 * 8) { const int g = r / 256, nb = (r % 256) / 8, kq = r % 8; colmax_item(a.w_in, DIN, win_src_col(g), a.CMAX, 1024 * g, nb, kq, lane); }
            else if (r < 288 * 8 + 64 * 8) { const int q = r - 288 * 8; colmax_item(a.wpq, 2048, 0, a.CMAX, 9216, q / 8, q % 8, lane); }
            else if (r < 288 * 8 + 64 * 8 + 32 * 8) { const int q = r - 288 * 8 - 64 * 8; colmax_item(a.wm, 1024, 0, a.CMAX, 11264, q / 8, q % 8, lane); }
            else if (r == 288 * 8 + 64 * 8 + 32 * 8) { float mx = 0.f; const int col = gate_src_col(lane & 15);
                for (int k = (lane >> 4) * 256; k < (lane >> 4) * 256 + 256; ++k) mx = fmaxf(mx, fabsf(a.w_in[(size_t)k * DIN + col]));
                mx = fmaxf(mx, __shfl_xor(mx, 16)); mx = fmaxf(mx, __shfl_xor(mx, 32)); if (lane < 16) atomicMax(a.CMAX + 12288 + lane, __builtin_bit_cast(unsigned, mx)); }
            continue; } r -= 9 * NI_G;
        if (r < NI_G) { continue; } r -= NI_G;
        if (r < NI_G) { transpose_item(a.wf, D, 0, D, a.WfT, 0, scr, r / 32, r % 32, lane); continue; } r -= NI_G;
        if (r < NI_G) { transpose_item(a.wo, D, 0, D, a.WoT, 0, scr, r / 32, r % 32, lane); continue; } r -= NI_G;
        (void)0;
    }
    const size_t gtid = (size_t)vcu * NTHR + tid, gthreads = (size_t)G * NTHR;
    for (size_t i = gtid; i < 9216; i += gthreads) a.biasP[i] = a.b_in[win_src_col((int)(i >> 10)) + (int)(i & 1023)];
    for (size_t i = gtid; i < 16; i += gthreads) a.biasG[i] = a.b_in[gate_src_col((int)i)];
    cvt_bf16_stream(a.sk, a.SKB, (size_t)PH * 2 * 128 * 128, gtid, gthreads);
    quant_u_i4_sliced(a.ut, (unsigned char*)a.UB, (float*)((unsigned char*)a.UB + 16 * MiB), gw, NGW, lane);
    cvt_fp4_sliced(a.vt, (unsigned char*)a.VB, (float*)((unsigned char*)a.VB + 16 * MiB), gtid, gthreads);
    rms_rows_phase(a.x, a.n1g, nullptr, gw, M, NGW, lane, a.H8, a.SH);
}

__device__ __forceinline__ float wave_incl_sum(float v, int lane) {
#pragma unroll
    for (int o = 1; o < 64; o <<= 1) { const float t = __shfl_up(v, o); if (lane >= o) v += t; }
    return v;
}
__device__ __forceinline__ float wave_incl_max(float v, int lane) {
#pragma unroll
    for (int o = 1; o < 64; o <<= 1) { const float t = __shfl_up(v, o); if (lane >= o) v = fmaxf(v, t); }
    return v;
}
struct ScanArgs { const float* Z16; float *CS, *ROWF, *COLF, *WINT, *EDEN, *WSW, *DECAY; };
__device__ __forceinline__ void p_scans(const ScanArgs& a, int gwave, int lane) {
    if (gwave < BATCH * MH) {
        const int bh = gwave, b = bh >> 2, hm = bh & 3; float m_prev = -1e30f;
        const float* zp = a.Z16 + ((size_t)b * T + lane) * 16; float ipn[4], fpn[4];
#pragma unroll
        for (int u = 0; u < 4; ++u) { ipn[u] = zp[(size_t)(64 * u) * 16 + hm]; fpn[u] = zp[(size_t)(64 * u) * 16 + 4 + hm]; }
        for (int c0 = 0; c0 < NCH; c0 += 4) {
            float ipc[4], fpc[4];
#pragma unroll
            for (int u = 0; u < 4; ++u) { ipc[u] = ipn[u]; fpc[u] = fpn[u]; }
            if (c0 + 4 < NCH) {
#pragma unroll
                for (int u = 0; u < 4; ++u) { ipn[u] = zp[(size_t)(64 * (c0 + 4 + u)) * 16 + hm]; fpn[u] = zp[(size_t)(64 * (c0 + 4 + u)) * 16 + 4 + hm]; } }
#pragma unroll
            for (int u = 0; u < 4; ++u) { const int c = c0 + u; const size_t gi = (size_t)bh * T + 64 * c + lane;
                const float ip = ipc[u], fp = fpc[u];
                const float bt = wave_incl_sum(logsigf_(fp), lane), g = __shfl(bt, 63);
                const float at = ip - bt, pm = wave_incl_max(at, lane), amax = __shfl(pm, 63);
                const float mt = fmaxf(bt + pm, bt + m_prev), m_new = fmaxf(g + m_prev, g + amax);
                a.ROWF[gi] = bt - mt; a.COLF[gi] = at; a.WINT[gi] = __expf(bt - mt + m_prev); a.EDEN[gi] = __expf(-mt); a.WSW[gi] = __expf(at + g - m_new);
                if (lane == 0) a.DECAY[bh * NCH + c] = __expf(g + m_prev - m_new);
                m_prev = m_new; }
        }
    } else if (gwave < BATCH * MH + BATCH * FH) {
        const int bh = gwave - BATCH * MH, b = bh >> 3, hf = bh & 7; float carry = 0.f;
        const float* zp = a.Z16 + ((size_t)b * T + lane) * 16 + 8 + hf; float fn[4];
#pragma unroll
        for (int u = 0; u < 4; ++u) fn[u] = zp[(size_t)(64 * u) * 16];
        for (int c0 = 0; c0 < NCH; c0 += 4) {
            float fc[4];
#pragma unroll
            for (int u = 0; u < 4; ++u) fc[u] = fn[u];
            if (c0 + 4 < NCH) {
#pragma unroll
                for (int u = 0; u < 4; ++u) fn[u] = zp[(size_t)(64 * (c0 + 4 + u)) * 16]; }
#pragma unroll
            for (int u = 0; u < 4; ++u) { const int c = c0 + u;
                const float s = wave_incl_sum(logsigf_(fc[u]), lane) + carry;
                a.CS[(size_t)bh * T + 64 * c + lane] = -s * 11.313708498984761f;
                carry = __shfl(s, 63); }
        }
    }
}

__device__ __forceinline__ void qknorm_vals(const v4u a, const v4u b, bf16raw* row, const f32x4 (&g)[4], int lane, float (&v)[16]) {
    v4u* p = (v4u*)(row + 16 * lane);
    const unsigned w[8] = {a.x, a.y, a.z, a.w, b.x, b.y, b.z, b.w};
    float s = 0.f;
#pragma unroll
    for (int i = 0; i < 8; ++i) { v[2 * i] = bflo(w[i]); v[2 * i + 1] = bfhi(w[i]); s += v[2 * i] * v[2 * i] + v[2 * i + 1] * v[2 * i + 1]; }
    s += __shfl_xor(s, 1); s += __shfl_xor(s, 2); s += __shfl_xor(s, 4);
    const float rstd = __builtin_amdgcn_rsqf(s * (1.f / 128.f) + EPS);
    unsigned o[8];
#pragma unroll
    for (int i = 0; i < 4; ++i) { const f32x4 gg = g[i]; o[2 * i] = pk2(v[4 * i] * rstd * gg.x, v[4 * i + 1] * rstd * gg.y); o[2 * i + 1] = pk2(v[4 * i + 2] * rstd * gg.z, v[4 * i + 3] * rstd * gg.w); }
#pragma unroll
    for (int i = 0; i < 8; ++i) { v[2 * i] = bflo(o[i]); v[2 * i + 1] = bfhi(o[i]); }
    p[0] = (v4u){o[0], o[1], o[2], o[3]}; p[1] = (v4u){o[4], o[5], o[6], o[7]};
}
struct QkRow { v4u qa, qb, ka, kb; };
__device__ __forceinline__ void qk_load(const bf16raw* FQ, const bf16raw* FK, int m, int lane, QkRow& r) {
    const v4u* pq = (const v4u*)(FQ + (size_t)m * D + 16 * lane); const v4u* pk = (const v4u*)(FK + (size_t)m * D + 16 * lane); r.qa = pq[0]; r.qb = pq[1]; r.ka = pk[0]; r.kb = pk[1];
}
__device__ __forceinline__ void p2b_qknorm(bf16raw* FQ, bf16raw* FK, const float* qg, const float* kg, float* DQK, int gw, int NGW, int lane) {
    f32x4 gq[4], gk[4];
#pragma unroll
    for (int i = 0; i < 4; ++i) { gq[i] = ((const f32x4*)(qg + 16 * (lane & 7)))[i]; gk[i] = ((const f32x4*)(kg + 16 * (lane & 7)))[i]; }
    rows_pipe3<QkRow>(gw, M, NGW, [&](int m, QkRow& r) { qk_load(FQ, FK, m, lane, r); },
        [&](int m, const QkRow& c0) { float vq[16], vk[16];
            qknorm_vals(c0.qa, c0.qb, FQ + (size_t)m * D, gq, lane, vq); qknorm_vals(c0.ka, c0.kb, FK + (size_t)m * D, gk, lane, vk);
            float d = 0.f;
#pragma unroll
            for (int i = 0; i < 16; ++i) d += vq[i] * vk[i];
            d += __shfl_xor(d, 1); d += __shfl_xor(d, 2); d += __shfl_xor(d, 4);
            if ((lane & 7) == 0) DQK[(size_t)m * 8 + (lane >> 3)] = d; });
}

struct HmRow { v4u a, b, ma; };
__device__ __forceinline__ void p4_hmnorm(const bf16raw* HR, const signed char* MO, const float* gain, signed char* HM8, float* SHM, int m0, int m1, int mstep, int lane) {
    f32x4 g[4];
#pragma unroll
    for (int i = 0; i < 4; ++i) g[i] = ((const f32x4*)(gain + 16 * lane))[i];
    rows_pipe3<HmRow>(m0, m1, mstep, [&](int m, HmRow& r) { const v4u* p = (const v4u*)(HR + (size_t)m * D + 16 * lane); r.a = p[0]; r.b = p[1]; r.ma = *(const v4u*)(MO + (size_t)m * D + 16 * lane); },
        [&](int m, const HmRow& r) {
        const unsigned w[8] = {r.a.x, r.a.y, r.a.z, r.a.w, r.b.x, r.b.y, r.b.z, r.b.w}, mw[4] = {r.ma.x, r.ma.y, r.ma.z, r.ma.w};
        float v[16]; float s = 0.f;
#pragma unroll
        for (int i = 0; i < 8; ++i) { v[2 * i] = bflo(w[i]); v[2 * i + 1] = bfhi(w[i]); s += v[2 * i] * v[2 * i] + v[2 * i + 1] * v[2 * i + 1]; }
        s += __shfl_xor(s, 1); s += __shfl_xor(s, 2); s += __shfl_xor(s, 4); s += __shfl_xor(s, 8);
        const float rstd = __builtin_amdgcn_rsqf(s * (1.f / 256.f) + EPS);
        float mx = 0.f;
#pragma unroll
        for (int i = 0; i < 4; ++i) { const f32x4 gg = g[i];
            v[4 * i] *= rstd * gg.x * sigmoidf_(pg8::q8f(mw[i], 0)); v[4 * i + 1] *= rstd * gg.y * sigmoidf_(pg8::q8f(mw[i], 1)); v[4 * i + 2] *= rstd * gg.z * sigmoidf_(pg8::q8f(mw[i], 2)); v[4 * i + 3] *= rstd * gg.w * sigmoidf_(pg8::q8f(mw[i], 3));
            mx = fmaxf(fmaxf(mx, fmaxf(fabsf(v[4 * i]), fabsf(v[4 * i + 1]))), fmaxf(fabsf(v[4 * i + 2]), fabsf(v[4 * i + 3]))); }
#pragma unroll
        for (int o = 1; o < 64; o <<= 1) mx = fmaxf(mx, __shfl_xor(mx, o));
        const float sc = fmaxf(mx, 1e-30f) * (1.f / 127.f), inv = __builtin_amdgcn_rcpf(sc); if (lane == 0) SHM[m] = sc;
        unsigned o4[4];
#pragma unroll
        for (int i = 0; i < 4; ++i) o4[i] = q8x4_pack(v[4 * i], v[4 * i + 1], v[4 * i + 2], v[4 * i + 3], inv);
        *(v4u*)(HM8 + (size_t)m * D + 16 * lane) = (v4u){o4[0], o4[1], o4[2], o4[3]}; });
}
constexpr int P2_RP = 264;
constexpr int P2_QS = 0, P2_KS = 33792, P2_VS = 67584, P2_DSL = 101376, P2_KB = P2_DSL + 256;
struct P2Args { const bf16raw *MQ, *MK, *MV; const float* conv_w; bf16raw *QC, *KWT, *VT, *SP; float *KBAR, *DSUM; const float *ROWF, *COLF, *WSW; };
struct P2Raw { v4u q[7], k[7], v[4]; };
__device__ __forceinline__ void p2_load(const P2Args& a, P2Raw& r, int unit, int rg, int cc) {
    const int bh = unit / NCH, c = unit % NCH, b = bh >> 2, hm = bh & 3; const size_t col = (size_t)256 * hm + 8 * cc;
#pragma unroll
    for (int i = 0; i < 7; ++i) { const int tm = 64 * c + 4 * rg - 3 + i; const size_t o = ((size_t)b * T + (tm < 0 ? 0 : tm)) * D + col;
        const v4u z = (v4u){0u, 0u, 0u, 0u}; const v4u qv = *(const v4u*)(a.MQ + o), kv = *(const v4u*)(a.MK + o); r.q[i] = tm < 0 ? z : qv; r.k[i] = tm < 0 ? z : kv; }
#pragma unroll
    for (int i = 0; i < 4; ++i) r.v[i] = *(const v4u*)(a.MV + ((size_t)b * T + 64 * c + 4 * rg + i) * D + col);
}
__device__ __forceinline__ void p2_conv_row(const v4u (&x)[7], int i, const float (&w)[4][8], float (&o)[8]) {
#pragma unroll
    for (int e = 0; e < 8; ++e) o[e] = 0.f;
#pragma unroll
    for (int j = 0; j < 4; ++j) { const v4u xv = x[i + j];
        o[0] += w[j][0] * bflo(xv.x); o[1] += w[j][1] * bfhi(xv.x); o[2] += w[j][2] * bflo(xv.y); o[3] += w[j][3] * bfhi(xv.y);
        o[4] += w[j][4] * bflo(xv.z); o[5] += w[j][5] * bfhi(xv.z); o[6] += w[j][6] * bflo(xv.w); o[7] += w[j][7] * bfhi(xv.w); }
#pragma unroll
    for (int e = 0; e < 8; ++e) o[e] = o[e] * sigmoidf_(o[e]);
}
__device__ __forceinline__ void p2_prep(LAS unsigned char* lds, const P2Args& a, int vcu, int G, int wave, int lane, int tid) {
    LAS bf16raw* qs = (LAS bf16raw*)(lds + P2_QS); LAS bf16raw* ks = (LAS bf16raw*)(lds + P2_KS); LAS bf16raw* vs = (LAS bf16raw*)(lds + P2_VS);
    LAS float* dsl = (LAS float*)(lds + P2_DSL); LAS float* kbp = (LAS float*)(lds + P2_KB);
    const int rg = tid >> 5, cc = tid & 31;
    int unit = vcu; if (unit >= BATCH * MH * NCH) return;
    P2Raw raw; p2_load(a, raw, unit, rg, cc);
    for (; unit < BATCH * MH * NCH; unit += G) {
        const int bh = unit / NCH, c = unit % NCH, b = bh >> 2, hm = bh & 3, ch0 = 256 * hm; const size_t tok0 = (size_t)b * T + 64 * c, gi0 = (size_t)bh * T + 64 * c;
        float wq[4][8], wk[4][8];
#pragma unroll
        for (int j = 0; j < 4; ++j) { const f32x4 a0 = *(const f32x4*)(a.conv_w + j * 2048 + ch0 + 8 * cc), a1 = *(const f32x4*)(a.conv_w + j * 2048 + ch0 + 8 * cc + 4), b0 = *(const f32x4*)(a.conv_w + j * 2048 + 1024 + ch0 + 8 * cc), b1 = *(const f32x4*)(a.conv_w + j * 2048 + 1024 + ch0 + 8 * cc + 4);
            wq[j][0] = a0.x; wq[j][1] = a0.y; wq[j][2] = a0.z; wq[j][3] = a0.w; wq[j][4] = a1.x; wq[j][5] = a1.y; wq[j][6] = a1.z; wq[j][7] = a1.w;
            wk[j][0] = b0.x; wk[j][1] = b0.y; wk[j][2] = b0.z; wk[j][3] = b0.w; wk[j][4] = b1.x; wk[j][5] = b1.y; wk[j][6] = b1.z; wk[j][7] = b1.w; }
        if (tid < 64) dsl[tid] = 0.f;
#pragma unroll
        for (int i = 0; i < 4; ++i) { const int r = 4 * rg + i; float o[8];
            p2_conv_row(raw.q, i, wq, o);
            const v4u pq = (v4u){pk2(o[0] * 0.0625f, o[1] * 0.0625f), pk2(o[2] * 0.0625f, o[3] * 0.0625f), pk2(o[4] * 0.0625f, o[5] * 0.0625f), pk2(o[6] * 0.0625f, o[7] * 0.0625f)};
            *(LAS v4u*)(qs + r * P2_RP + 8 * cc) = pq; *(v4u*)(a.QC + (tok0 + r) * D + ch0 + 8 * cc) = pq;
            p2_conv_row(raw.k, i, wk, o);
            *(LAS v4u*)(ks + r * P2_RP + 8 * cc) = (v4u){pk2(o[0], o[1]), pk2(o[2], o[3]), pk2(o[4], o[5]), pk2(o[6], o[7])};
            *(LAS v4u*)(vs + r * P2_RP + 8 * cc) = raw.v[i]; }
        if (unit + G < BATCH * MH * NCH) p2_load(a, raw, unit + G, rg, cc);
        __syncthreads();
        { const int sch = tid & 7; const f32x4 w0 = *(const f32x4*)(a.WSW + gi0 + 8 * sch), w1 = *(const f32x4*)(a.WSW + gi0 + 8 * sch + 4);
          const float ww[8] = {w0.x, w0.y, w0.z, w0.w, w1.x, w1.y, w1.z, w1.w};
#pragma unroll
          for (int q = 0; q < 4; ++q) { const int dk = (tid >> 3) + 64 * q; unsigned hb[8]; float part = 0.f;
#pragma unroll
              for (int e = 0; e < 8; ++e) { const float kv = bf1(ks[(8 * sch + e) * P2_RP + dk]) * ww[e]; hb[e] = f2bf(kv); part += bf1((bf16raw)hb[e]); }
              *(v4u*)(a.KWT + (size_t)unit * 16384 + dk * 64 + 8 * sch) = (v4u){hb[0] | (hb[1] << 16), hb[2] | (hb[3] << 16), hb[4] | (hb[5] << 16), hb[6] | (hb[7] << 16)};
              part = dpp_add<0xB1>(part); part = dpp_add<0x4E>(part); part = dpp_add<0x141>(part);
              if (sch == 0) a.KBAR[(size_t)unit * 256 + dk] = part;
#pragma unroll
              for (int e = 0; e < 8; ++e) hb[e] = vs[(8 * sch + e) * P2_RP + dk];
              *(v4u*)(a.VT + (size_t)unit * 16384 + dk * 64 + 8 * sch) = (v4u){hb[0] | (hb[1] << 16), hb[2] | (hb[3] << 16), hb[4] | (hb[5] << 16), hb[6] | (hb[7] << 16)}; }
          const int rb = wave >> 1, m = lane & 15, kg = lane >> 4;
#pragma unroll
          for (int cbi = 0; cbi < 2; ++cbi) { const int cb = 2 * (wave & 1) + cbi;
              f32x4 acc = (f32x4){0.f, 0.f, 0.f, 0.f};
              if (cb <= rb) {
#pragma unroll
                  for (int kk = 0; kk < 8; ++kk) { const bf16x8 af = *(const LAS bf16x8*)(ks + (16 * cb + m) * P2_RP + 32 * kk + 8 * kg), bfr = *(const LAS bf16x8*)(qs + (16 * rb + m) * P2_RP + 32 * kk + 8 * kg);
                      acc = __builtin_amdgcn_mfma_f32_16x16x32_bf16(af, bfr, acc, 0, 0, 0); } }
              const int t = 16 * rb + m, s0 = 16 * cb + 4 * kg; const float rf = a.ROWF[gi0 + t]; const f32x4 cf = *(const f32x4*)(a.COLF + gi0 + s0);
              unsigned hb[4]; float sum = 0.f;
#pragma unroll
              for (int r = 0; r < 4; ++r) { const float v = (s0 + r <= t) ? acc[r] * __expf(rf + cf[r]) : 0.f; hb[r] = f2bf(v); sum += bf1((bf16raw)hb[r]); }
              *(v2u*)(a.SP + (size_t)unit * 4096 + t * 64 + s0) = (v2u){hb[0] | (hb[1] << 16), hb[2] | (hb[3] << 16)};
              sum += __shfl_xor(sum, 16); sum += __shfl_xor(sum, 32);
              if (kg == 0) atomicAdd((float*)(dsl + t), sum); } }
        __syncthreads();
        if (tid < 64) a.DSUM[gi0 + tid] = dsl[tid];
        __syncthreads();
    }
}

constexpr int P3_CP = 264, P3_SP = 72;
constexpr int P3W = 128;
constexpr int P3_CT = 0, P3_NL = P3_CT + P3W * P3_CP * 2, P3_QN = P3_NL + 1024, P3_QS = P3_QN + 256, P3_SS = P3_QS + 64 * P3_CP * 2, P3_VS = P3_SS + 64 * P3_SP * 2, P3_GS = P3_VS + 2 * P3W * P3_SP * 2, P3_END = P3_GS + 2 * 768;
static_assert(P3_END <= LDS_MISC, "mLSTM LDS map");
struct P3Args { const bf16raw *QC, *KWT, *VT, *SP; const float *KBAR, *DSUM, *WINT, *EDEN, *DECAY; bf16raw* HR; };
typedef __amdgpu_buffer_rsrc_t rsrc_t;
__device__ __forceinline__ rsrc_t mk_rsrc(const void* p, unsigned nbytes) { return __builtin_amdgcn_make_buffer_rsrc((void*)p, (short)0, (int)nbytes, 0x00020000); }
__device__ __forceinline__ v4u bld(rsrc_t r, unsigned voff, unsigned soff) { return __builtin_bit_cast(v4u, __builtin_amdgcn_raw_buffer_load_b128(r, (int)voff, (int)soff, 0)); }
struct P3Stage { v4u q[4], s, v[2], gt; float decay, kb; };
__device__ __forceinline__ void p3_stage_load(const P3Args& a, rsrc_t rq, rsrc_t rs, rsrc_t rv, P3Stage& g, int bh, int b, int hm, int j, int c, int tid) {
    const unsigned uc = (unsigned)(bh * NCH + c), tok0 = (unsigned)(b * T + 64 * c);
#pragma unroll
    for (int k = 0; k < 4; ++k) g.q[k] = bld(rq, (unsigned)(((tid >> 5) + 16 * k) * 2048 + 512 * hm + 16 * (tid & 31)), tok0 * 2048u);
    g.s = bld(rs, (unsigned)((tid >> 3) * 128 + 16 * (tid & 7)), uc * 8192u);
#pragma unroll
    for (int k = 0; k < 2; ++k) g.v[k] = bld(rv, (unsigned)((P3W * j + (tid >> 3) + 64 * k) * 128 + 16 * (tid & 7)), uc * 32768u);
    g.decay = a.DECAY[uc]; g.kb = (tid < 256) ? a.KBAR[(size_t)uc * 256 + tid] : 0.f;
    if (tid < 48) { const long long o1 = (const char*)a.EDEN - (const char*)a.WINT, o2 = (const char*)a.DSUM - (const char*)a.WINT; const long long go = tid < 16 ? 0ll : (tid < 32 ? o1 : o2);
        g.gt = *(const v4u*)((const char*)a.WINT + go + ((size_t)bh * T + 64 * c + 4 * (tid & 15)) * 4); }
}
__device__ __forceinline__ void p3_stage_write_qs(LAS unsigned char* lds, const P3Stage& g, int tid) {
#pragma unroll
    for (int k = 0; k < 4; ++k) *(LAS v4u*)(lds + P3_QS + ((tid >> 5) + 16 * k) * (P3_CP * 2) + 16 * (tid & 31)) = g.q[k];
    *(LAS v4u*)(lds + P3_SS + (tid >> 3) * (P3_SP * 2) + 16 * (tid & 7)) = g.s;
}
__device__ __forceinline__ void p3_stage_write_v(LAS unsigned char* lds, const P3Stage& g, int buf, int tid) {
    if (tid < 48) *(LAS v4u*)(lds + P3_GS + buf * 768 + 16 * tid) = g.gt;
#pragma unroll
    for (int k = 0; k < 2; ++k) *(LAS v4u*)(lds + P3_VS + buf * (P3W * P3_SP * 2) + ((tid >> 3) + 64 * k) * (P3_SP * 2) + 16 * (tid & 7)) = g.v[k];
}
#define P3_BAR() do { asm volatile("s_waitcnt lgkmcnt(0)" ::: "memory"); __builtin_amdgcn_s_barrier(); asm volatile("" ::: "memory"); } while (0)
__device__ __forceinline__ void p3_mlstm(LAS unsigned char* lds, const P3Args& a, int vcu, int G, int wave, int lane, int tid, unsigned* chkflag = nullptr) {
    if (vcu & 3) return;
    for (int unit = vcu >> 2; unit < BATCH * MH * 2; unit += (G + 3) >> 2) {
        const int bh = unit >> 1, j = unit & 1, b = bh >> 2, hm = bh & 3;
        const int rb = wave >> 2, cg = wave & 3, m32 = lane & 31, hh = lane >> 5;
        f32x16 accC[4];
#pragma unroll
        for (int ti = 0; ti < 4; ++ti)
#pragma unroll
            for (int r = 0; r < 16; ++r) accC[ti][r] = 0.f;
        float nst = 0.f;
        const rsrc_t rq = mk_rsrc(a.QC, 0x8000000u), rs = mk_rsrc(a.SP, 0x2000000u), rv = mk_rsrc(a.VT, 0x8000000u), rk = mk_rsrc(a.KWT, 0x8000000u);
        __syncthreads();
        for (int i = tid; i < (P3_QS - P3_CT) / 4; i += NTHR) ((LAS unsigned*)(lds + P3_CT))[i] = 0u;
        P3Stage sg; p3_stage_load(a, rq, rs, rv, sg, bh, b, hm, j, 0, tid);
        p3_stage_write_qs(lds, sg, tid); p3_stage_write_v(lds, sg, 0, tid);
        float decay = sg.decay, kb = sg.kb;
        p3_stage_load(a, rq, rs, rv, sg, bh, b, hm, j, 1, tid);
        bf16x8 kA[4];
#pragma unroll
        for (int kk = 0; kk < 4; ++kk) kA[kk] = __builtin_bit_cast(bf16x8, bld(rk, (unsigned)((32 * wave + m32) * 128 + 32 * kk + 16 * hh), (unsigned)(bh * NCH) * 32768u));
        __syncthreads();
        for (int c = 0; c < NCH; ++c) {
            const int vb = c & 1; const unsigned uc = (unsigned)(bh * NCH + c); const size_t tok0 = (size_t)b * T + 64 * c, gi0 = (size_t)bh * T + 64 * c;
            { const int t = tid >> 3, part = tid & 7; float s = 0.f;
#pragma unroll
              for (int q4 = 0; q4 < 4; ++q4) { const v4u qv = *(const LAS v4u*)(lds + P3_QS + t * (P3_CP * 2) + part * 64 + 16 * q4);
                  const f32x4 n0 = *(const LAS f32x4*)(lds + P3_NL + (32 * part + 8 * q4) * 4), n1 = *(const LAS f32x4*)(lds + P3_NL + (32 * part + 8 * q4 + 4) * 4);
                  s += bflo(qv.x) * n0.x + bfhi(qv.x) * n0.y + bflo(qv.y) * n0.z + bfhi(qv.y) * n0.w + bflo(qv.z) * n1.x + bfhi(qv.z) * n1.y + bflo(qv.w) * n1.z + bfhi(qv.w) * n1.w; }
              s = dpp_add<0xB1>(s); s = dpp_add<0x4E>(s); s = dpp_add<0x141>(s);
              if (part == 0) *(LAS float*)(lds + P3_QN + 4 * t) = s; }
            f32x16 accQ, accS;
#pragma unroll
            for (int r = 0; r < 16; ++r) { accQ[r] = 0.f; accS[r] = 0.f; }
#pragma unroll
            for (int kk = 0; kk < 16; ++kk) { const bf16x8 af = *(const LAS bf16x8*)(lds + P3_QS + (32 * rb + m32) * (P3_CP * 2) + 32 * kk + 16 * hh), bf = *(const LAS bf16x8*)(lds + P3_CT + (32 * cg + m32) * (P3_CP * 2) + 32 * kk + 16 * hh);
                accQ = __builtin_amdgcn_mfma_f32_32x32x16_bf16(af, bf, accQ, 0, 0, 0); }
#pragma unroll
            for (int kk = 0; kk < 4; ++kk) { const bf16x8 af = *(const LAS bf16x8*)(lds + P3_SS + (32 * rb + m32) * (P3_SP * 2) + 32 * kk + 16 * hh), bf = *(const LAS bf16x8*)(lds + P3_VS + vb * (P3W * P3_SP * 2) + (32 * cg + m32) * (P3_SP * 2) + 32 * kk + 16 * hh);
                accS = __builtin_amdgcn_mfma_f32_32x32x16_bf16(af, bf, accS, 0, 0, 0); }
            P3_BAR();
            p3_stage_write_qs(lds, sg, tid); p3_stage_write_v(lds, sg, vb ^ 1, tid);
            const float decay_n = sg.decay, kb_n = sg.kb;
            p3_stage_load(a, rq, rs, rv, sg, bh, b, hm, j, c + 2 < NCH ? c + 2 : NCH - 1, tid);
#pragma unroll
            for (int g = 0; g < 4; ++g) { const f32x4 qn = *(const LAS f32x4*)(lds + P3_QN + (32 * rb + 8 * g + 4 * hh) * 4);
                const int ro = (32 * rb + 8 * g + 4 * hh) * 4; const f32x4 wi = *(const LAS f32x4*)(lds + P3_GS + vb * 768 + ro), ed = *(const LAS f32x4*)(lds + P3_GS + vb * 768 + 256 + ro), ds = *(const LAS f32x4*)(lds + P3_GS + vb * 768 + 512 + ro);
#pragma unroll
                for (int i = 0; i < 4; ++i) { const float den = ds[i] + wi[i] * qn[i]; const float hv = (accS[4 * g + i] + wi[i] * accQ[4 * g + i]) * __builtin_amdgcn_rcpf(fmaxf(fabsf(den), ed[i]));
                    { bf16raw* hp = a.HR + (tok0 + 32 * rb + 8 * g + 4 * hh + i) * D + 256 * hm + P3W * j + 32 * cg + m32; const bf16raw hb = (bf16raw)f2bf(hv);
                      if (chkflag) { if (*hp != hb) atomicOr(chkflag, 1u << (c & 31)); } else *hp = hb; } } }
#pragma unroll
            for (int ti = 0; ti < 4; ++ti) {
#pragma unroll
                for (int r = 0; r < 16; ++r) accC[ti][r] *= decay;
#pragma unroll
                for (int kk = 0; kk < 4; ++kk) { const bf16x8 bf = *(const LAS bf16x8*)(lds + P3_VS + vb * (P3W * P3_SP * 2) + (32 * ti + m32) * (P3_SP * 2) + 32 * kk + 16 * hh);
                    accC[ti] = __builtin_amdgcn_mfma_f32_32x32x16_bf16(kA[kk], bf, accC[ti], 0, 0, 0); }
#pragma unroll
                for (int g = 0; g < 4; ++g) *(LAS v2u*)(lds + P3_CT + (32 * ti + m32) * (P3_CP * 2) + (32 * wave + 8 * g + 4 * hh) * 2) = (v2u){pk2(accC[ti][4 * g], accC[ti][4 * g + 1]), pk2(accC[ti][4 * g + 2], accC[ti][4 * g + 3])}; }
            { const unsigned un = (unsigned)(bh * NCH + (c + 1 < NCH ? c + 1 : c));
#pragma unroll
              for (int kk = 0; kk < 4; ++kk) kA[kk] = __builtin_bit_cast(bf16x8, bld(rk, (unsigned)((32 * wave + m32) * 128 + 32 * kk + 16 * hh), un * 32768u)); }
            if (tid < 256) { nst = decay * nst + kb; *(LAS float*)(lds + P3_NL + 4 * tid) = nst; }
            decay = decay_n; kb = kb_n;
            P3_BAR();
        }
    }
}
#ifndef DBG_STAGE
#define DBG_STAGE 3
#endif
#ifndef FP8A
#define FP8A 1
#endif
#ifndef FP8B
#define FP8B 1
#endif
#ifndef FP8C
#define FP8C 1
#endif
#ifndef MK_ONE_LAUNCH
#define MK_ONE_LAUNCH 0
#endif
#ifndef PROBE_DUP
#define PROBE_DUP -1
#endif
#define NREP(k) ((PROBE_DUP == (k)) ? 2 : 1)
constexpr int NPH = 20;
struct Args { const float* in[16]; float* out; unsigned char* ws; int ph_lo, ph_hi; };
__global__ void __launch_bounds__(NTHR, 2) fwd(Args args) {
    extern __shared__ __attribute__((aligned(16))) unsigned char lds_raw[];
    LAS unsigned char* lds = (LAS unsigned char*)lds_raw;
#define PH_IDS int tid = threadIdx.x; asm volatile("" : "+v"(tid)); const int lane = tid & 63; (void)lane; const int wave = __builtin_amdgcn_readfirstlane(tid >> 6); \
    const __attribute__((address_space(4))) Args* ap_ = (const __attribute__((address_space(4))) Args*)__builtin_amdgcn_kernarg_segment_ptr(); asm volatile("" : "+s"(ap_)); \
    int G = gridDim.x; asm volatile("" : "+s"(G)); const int bx = blockIdx.x, vcu = (G % 8 == 0) ? (bx % 8) * (G / 8) + bx / 8 : bx; const int gw = vcu * NWAVES + wave, NGW = G * NWAVES; (void)gw; (void)NGW;
    if (threadIdx.x < 4) ((LAS unsigned*)(lds + LDS_MISC))[threadIdx.x] = 0u;
    __syncthreads();
#if MK_ONE_LAUNCH
    XcdBarrier bar = xcd_barrier_post((unsigned*)(args.ws + WS_CTL) + CW_BAR, (volatile LAS unsigned*)(lds + LDS_MISC));
#define GRID_BAR() xcd_barrier(bar)
#else
#define GRID_BAR() do {} while (0)
#endif
#define A_x ((const float*)ap_->in[0])
#define A_n1g ((const float*)ap_->in[1])
#define A_w_in ((const float*)ap_->in[2])
#define A_b_in ((const float*)ap_->in[3])
#define A_conv_w ((const float*)ap_->in[4])
#define A_mng ((const float*)ap_->in[5])
#define A_qng ((const float*)ap_->in[6])
#define A_kng ((const float*)ap_->in[7])
#define A_wm ((const float*)ap_->in[8])
#define A_wf ((const float*)ap_->in[9])
#define A_wo ((const float*)ap_->in[10])
#define A_n2g ((const float*)ap_->in[11])
#define A_wpq ((const float*)ap_->in[12])
#define A_skeys ((const float*)ap_->in[13])
#define A_utab ((const float*)ap_->in[14])
#define A_vtab ((const float*)ap_->in[15])
#define A_out (ap_->out)
#define RB(i) ((bf16raw*)(ap_->ws + WS_R0 + (size_t)(i) * RSZ))
#define A_O0 ((bf16raw*)ap_->out)
#define A_O1 ((bf16raw*)((unsigned char*)ap_->out + RSZ))
#define A_WinT ((bf16raw*)(ap_->ws + WS_WINT))
#define A_WinTb ((bf16raw*)(ap_->ws + 208 * MiB))
#define A_SH ((float*)(ap_->ws + WS_JLO + 65536))
#define A_SW ((float*)(ap_->ws + 13 * MiB + 163840))
#define A_SX ((float*)(ap_->ws + WS_JLO + 65536 + 262144))
#define A_SHM ((float*)(ap_->ws + WS_WGT))
#define A_XQ ((signed char*)RB(3))
#define A_XH ((unsigned char*)RB(3) + 64 * MiB)
#define A_XL ((unsigned char*)RB(3) + 96 * MiB)
#define A_SU ((const float*)((unsigned char*)A_UB + 16 * MiB))
#define A_SV ((const float*)((unsigned char*)A_VB + 16 * MiB))
#define A_W8 ((unsigned char*)A_VB + 24 * MiB)
#define A_WSC ((float*)((unsigned char*)A_VB + 40 * MiB))
#define A_WgT ((bf16raw*)(ap_->ws + WS_WGT))
#define A_WmT ((bf16raw*)(ap_->ws + WS_WMT))
#define A_WfT ((bf16raw*)(ap_->ws + WS_WFT))
#define A_WoT ((bf16raw*)(ap_->ws + WS_WOT))
#define A_WpqT ((bf16raw*)(ap_->ws + WS_WPQT))
#define A_SKB ((bf16raw*)(ap_->ws + WS_SKB))
#define A_UB ((bf16raw*)(ap_->ws + WS_UB))
#define A_VB ((bf16raw*)(ap_->ws + WS_VB))
#define A_biasP ((float*)(ap_->ws + WS_BIASP))
#define A_biasG ((float*)(ap_->ws + WS_BIASG))
#define A_Z16 ((float*)(ap_->ws + WS_Z16))
#define A_CS ((float*)(ap_->ws + WS_CS))
#define A_ROWF ((float*)(ap_->ws + WS_GROWF))
#define A_COLF ((float*)(ap_->ws + WS_GCOLF))
#define A_WINT ((float*)(ap_->ws + WS_GWINT))
#define A_EDEN ((float*)(ap_->ws + WS_GEDEN))
#define A_WSW ((float*)(ap_->ws + WS_GWSW))
#define A_DECAY ((float*)(ap_->ws + WS_GDECAY))
#define A_KBAR ((float*)(ap_->ws + WS_KBAR))
#define A_DSUM ((float*)(ap_->ws + WS_DSUM))
#define A_SP ((bf16raw*)(ap_->ws + WS_SP))
#define A_IDS ((unsigned short*)(ap_->ws + WS_IDS))
#define A_GWT ((float*)(ap_->ws + WS_GW))
#define A_JLO ((int*)(ap_->ws + WS_JLO))
#define A_DQK ((float*)(ap_->ws + 208 * MiB + 32 * MiB))
#define A_H8 ((unsigned char*)(ap_->ws + WS_IDS))
    const int lo = args.ph_lo, hi = args.ph_hi;
#define IN(k) (lo <= (k) && (k) < hi)
#define SEAM(k) do { if (IN((k) + 1)) GRID_BAR(); } while (0)
    constexpr size_t RS_E = RSZ / 2;

    if (IN(0)) { PH_IDS P0Args a{A_x, A_n1g, A_w_in, A_b_in, A_wm, A_wf, A_wo, A_wpq, A_skeys, A_utab, A_vtab, A_WinT, A_WgT, A_WmT, A_WfT, A_WoT, A_WpqT, A_SKB, A_UB, A_VB, RB(0), A_biasP, A_biasG, A_H8, A_WinTb, A_SH, (unsigned*)(ap_->ws + WS_CTL) + CW_CMAX};
        for (int rep = 0; rep < NREP(0); ++rep) { p0_prologue(lds, a, vcu, G, wave, lane, tid); __syncthreads(); } SEAM(0); }
    if (IN(1)) { PH_IDS p0b_quant_w(lds, A_w_in, A_wpq, A_wm, (signed char*)A_WinT, A_SW, (const unsigned*)(ap_->ws + WS_CTL) + CW_CMAX, gw, NGW, wave, lane); SEAM(1); }
    if (IN(2)) { PH_IDS
        { pg8::Gemm g{(const bf16raw*)A_H8, A_WinT + (size_t)12288 * D / 2, M, 256, D / 2}; pg8::StaticOrder S; S.init(M, 256, G, bx); pg8::EpiGates16I8 E{A_Z16, A_biasG, A_SW + 12288, A_SH};
          pg8::gemm_phase<pg8::EpiGates16I8, pg8::StaticOrder, false, true, 2>(lds, g, S, E); }
        SEAM(2); }
    if (IN(3)) { PH_IDS
        if (bx * NWAVES + wave < BATCH * (MH + FH)) { ScanArgs a{A_Z16, A_CS, A_ROWF, A_COLF, A_WINT, A_EDEN, A_WSW, A_DECAY}; p_scans(a, bx * NWAVES + wave, lane); }
        __syncthreads();
        { pg8::Gemm g{(const bf16raw*)A_H8, A_WinT, M, 3072, D / 2}; pg8::QueueOrder S; S.init(M, 3072, (unsigned*)(ap_->ws + WS_CTL) + CW_QM, (int)xb_xcc_id(), (LAS int*)(lds + LDS_MISC + 64)); S.prime(); __syncthreads();
          pg8::EpiI8 E{RB(1), D, A_biasP, A_SW, A_SH, RS_E};
          pg8::gemm_phase<pg8::EpiI8, pg8::QueueOrder, true, true, 2>(lds, g, S, E); }
        SEAM(3); }
    if (IN(4)) { PH_IDS
#if DBG_STAGE >= 2
        P2Args a{RB(1), RB(2), RB(3), A_conv_w, RB(4), RB(5), A_O0, A_SP, A_KBAR, A_DSUM, A_ROWF, A_COLF, A_WSW}; for (int rep = 0; rep < NREP(3); ++rep) p2_prep(lds, a, vcu, G, wave, lane, tid);
#endif
        SEAM(4); }
    if (IN(5)) { PH_IDS
#if FP8B
pg8::Gemm g{(const bf16raw*)A_H8, A_WinT + (size_t)3072 * D / 2, M, 3072, D / 2}; pg8::StaticOrder S; S.init(M, 3072, G, bx); pg8::EpiI8 E{RB(1), D, A_biasP + 3072, A_SW + 3072, A_SH, RS_E};
        pg8::gemm_phase<pg8::EpiI8, pg8::StaticOrder, true, true, 2>(lds, g, S, E);
#else
pg8::Gemm g{RB(0), A_WinTb + (size_t)3072 * D, M, 3072, D}; pg8::StaticOrder S; S.init(M, 3072, G, bx); pg8::EpiBf16<0> E{RB(1), D, A_biasP + 3072, 1024, RS_E, 1.f};
        pg8::gemm_phase<pg8::EpiBf16<0>, pg8::StaticOrder, true, true>(lds, g, S, E);
#endif
 SEAM(5); }
    if (IN(6)) { PH_IDS p2b_qknorm(RB(1), RB(2), A_qng, A_kng, A_DQK, gw, NGW, lane); SEAM(6); }
    if (IN(7)) { PH_IDS fox::jlo_table(A_CS, A_DQK, A_qng, A_kng, A_JLO, gw, NGW, lane); SEAM(7); }
    if (IN(8)) { PH_IDS
#if DBG_STAGE >= 2
        { P3Args a{RB(4), RB(5), A_O0, A_SP, A_KBAR, A_DSUM, A_WINT, A_EDEN, A_DECAY, A_O1}; { const int nrep = (PROBE_DUP == 60) ? (args.ph_hi - 18) : 1;
_Pragma("nounroll")
          for (int rep = 0; rep < nrep; ++rep) { p3_mlstm(lds, a, vcu, G, wave, lane, tid, rep ? (unsigned*)(ap_->ws + WS_CTL) + 16 : (unsigned*)nullptr); asm volatile("s_waitcnt vmcnt(0)" ::: "memory"); __syncthreads(); } } }
        __syncthreads();
#ifdef T1_BAR
        GRID_BAR();
#endif
#endif
        if (PROBE_DUP == 61) { fox::phase((char*)lds_raw, (const fox::bf16*)RB(1), (const fox::bf16*)RB(2), (const fox::bf16*)RB(3), (fox::bf16*)RB(0), A_CS, A_JLO, (unsigned*)(ap_->ws + WS_CTL) + CW_QF + 2048, (int)xb_xcc_id()); __syncthreads(); }
        fox::phase((char*)lds_raw, (const fox::bf16*)RB(1), (const fox::bf16*)RB(2), (const fox::bf16*)RB(3), (fox::bf16*)RB(1), A_CS, A_JLO, (unsigned*)(ap_->ws + WS_CTL) + CW_QF, (int)xb_xcc_id(), (unsigned*)(ap_->ws + WS_CTL) + CW_FDONE);
        __syncthreads();
        if (tid == 0) { const unsigned* fd = (const unsigned*)(ap_->ws + WS_CTL) + CW_FDONE; for (int spin = 0; spin < (1 << 22) && __hip_atomic_load(fd, __ATOMIC_RELAXED, __HIP_MEMORY_SCOPE_AGENT) < 2048u; ++spin) __builtin_amdgcn_s_sleep(16); }
        __syncthreads();
        { pg8::Gemm g{(const bf16raw*)A_H8, A_WinT + (size_t)6144 * D / 2, M, 3072, D / 2}; pg8::QueueOrder S; S.init(M, 3072, (unsigned*)(ap_->ws + WS_CTL) + CW_QG, (int)xb_xcc_id(), (LAS int*)(lds + LDS_MISC + 64)); S.prime(); __syncthreads();
          pg8::EpiQ8 E{(signed char*)RB(0), D, A_biasP + 6144, A_SW + 6144, A_SH, (size_t)64 * MiB, 3 * RSZ};
          pg8::gemm_phase<pg8::EpiQ8, pg8::QueueOrder, true, true, 2>(lds, g, S, E); }
        SEAM(8); }
    if (IN(10)) { PH_IDS
#if DBG_STAGE >= 2
        for (int rep = 0; rep < NREP(8); ++rep) p4_hmnorm(A_O1, (const signed char*)RB(0), A_mng, (signed char*)RB(2), A_SHM, gw, M, NGW, lane);
#endif
        SEAM(10); }
    if (IN(11)) { PH_IDS
        pg8::Gemm g0{RB(2), A_WinT + (size_t)11264 * D / 2, M, D, D / 2}, g1{RB(1), A_WfT, M, D, D}; pg8::StaticOrder S; S.init(M, D, G, bx);
        pg8::gemm_dual(lds, g0, g1, S, (const signed char*)RB(0) + 64 * MiB, (const signed char*)RB(3), A_SW + 11264, A_SHM, RB(5), D);
        SEAM(12); }
    if (IN(13)) { PH_IDS pg8::Gemm g{RB(5), A_WoT, M, D, D}; pg8::StaticOrder S; S.init(M, D, G, bx); pg8::EpiResB16 E{A_x, RB(0), D};
        pg8::gemm_phase<pg8::EpiResB16, pg8::StaticOrder, true, true>(lds, g, S, E); SEAM(13); }
#if DBG_STAGE >= 3
    if (IN(14)) { PH_IDS for (int rep = 0; rep < NREP(12); ++rep) rms_rows_phase_b16(RB(0), A_n2g, gw, M, NGW, lane, (unsigned char*)A_XQ, A_SX, A_XH, A_XL); SEAM(14); }
    if (IN(15)) { PH_IDS pg8::Gemm g{(const bf16raw*)A_XQ, A_WinT + (size_t)9216 * D / 2, M, 2048, D / 2}; pg8::StaticOrder S; S.init(M, 2048, G, bx); pg8::EpiI8 E{RB(1), 2048, nullptr, A_SW + 9216, A_SX, 0};
        pg8::gemm_phase<pg8::EpiI8, pg8::StaticOrder, true, true, 2>(lds, g, S, E); SEAM(15); }
    if (IN(16)) { PH_IDS P9Args a{RB(1), A_SKB, A_IDS, A_GWT}; for (int rep = 0; rep < NREP(14); ++rep) p9_topk(lds, a, vcu, G, wave, lane, tid); SEAM(16); }
    if (IN(17)) { PH_IDS if (PROBE_DUP == 15) p15_udot(A_XH, A_XL, (const unsigned char*)A_UB, A_IDS, (short*)RB(1), (unsigned*)(ap_->ws + WS_CTL) + CW_QU + 2048, (int)xb_xcc_id(), lane);
        p15_udot(A_XH, A_XL, (const unsigned char*)A_UB, A_IDS, (short*)RB(1), (unsigned*)(ap_->ws + WS_CTL) + CW_QU, (int)xb_xcc_id(), lane); SEAM(17); }
    if (IN(18)) { PH_IDS p15b_act((const short*)RB(1), A_GWT, A_W8, A_WSC, A_SX, A_SU, A_SV, A_IDS, gw, NGW, lane); SEAM(18); }
#ifndef PROBE_VMODE
#define PROBE_VMODE 0
#endif
    if (IN(19)) { PH_IDS if (PROBE_DUP == 17) p16_vsum<PROBE_VMODE>(lds, (const unsigned char*)A_VB, A_IDS, A_W8, A_WSC, RB(0), (float*)RB(2), (unsigned*)(ap_->ws + WS_CTL) + CW_QV + 2048, (int)xb_xcc_id(), wave, lane);
        p16_vsum(lds, (const unsigned char*)A_VB, A_IDS, A_W8, A_WSC, RB(0), A_out, (unsigned*)(ap_->ws + WS_CTL) + CW_QV, (int)xb_xcc_id(), wave, lane); }
#endif
#undef IN
#undef SEAM
}

extern "C" void kernel_launch(void* const* d_in, const int* in_sizes, int n_in, void* d_out, int out_size, void* d_ws, size_t ws_size, hipStream_t stream) {
    static int grid = 0;
    if (grid == 0) {
        if (n_in != 16 || out_size != M * D || ws_size < WS_END) { fprintf(stderr, "kernel_launch: unexpected shapes (n_in %d out %d ws %zu)\n", n_in, out_size, ws_size); grid = -1; return; }
        int dev = 0, cus = 0, per_cu = 0;
        if (hipGetDevice(&dev) != hipSuccess || hipDeviceGetAttribute(&cus, hipDeviceAttributeMultiprocessorCount, dev) != hipSuccess) { grid = -1; return; }
        if (hipFuncSetAttribute((const void*)fwd, hipFuncAttributeMaxDynamicSharedMemorySize, LDS_BYTES) != hipSuccess) { fprintf(stderr, "kernel_launch: hipFuncSetAttribute failed\n"); grid = -1; return; }
        if (hipOccupancyMaxActiveBlocksPerMultiprocessor(&per_cu, (const void*)fwd, NTHR, LDS_BYTES) != hipSuccess || per_cu < 1) { fprintf(stderr, "kernel_launch: occupancy query says %d\n", per_cu); grid = -1; (void)hipGetLastError(); return; }
        (void)hipGetLastError();
        grid = cus;
    }
    if (grid < 0) return;
    if (hipMemsetAsync((char*)d_ws + WS_CTL, 0, CTL_ZERO_BYTES, stream) != hipSuccess) return;
    Args a{};
    for (int i = 0; i < 16; ++i) a.in[i] = (const float*)d_in[i];
    a.out = (float*)d_out; a.ws = (unsigned char*)d_ws;
#if MK_ONE_LAUNCH
    a.ph_lo = 0; a.ph_hi = NPH;
    hipLaunchKernelGGL(fwd, dim3(grid), dim3(NTHR), LDS_BYTES, stream, a);
#else
    for (int p = 0; p < NPH; ++p) { a.ph_lo = p; a.ph_hi = p + 1; hipLaunchKernelGGL(fwd, dim3(grid), dim3(NTHR), LDS_BYTES, stream, a); }
#endif
}
```

```cpp
#include <hip/hip_runtime.h>
#include <hip/hip_bf16.h>
#include <cstdio>
#include <cstdint>
#define DBG_STAGE 3
#define MK_ONE_LAUNCH 1
namespace pg8 {
#define PG8_LAS __attribute__((address_space(3)))
typedef unsigned short bf16_t;
typedef short bf16x8 __attribute__((ext_vector_type(8)));
typedef float f32x4 __attribute__((ext_vector_type(4)));
typedef unsigned u32x4 __attribute__((ext_vector_type(4)));
constexpr int BM = 256, BK = 64, HALF = 128, HTB = HALF * BK * 2  , STAGE_BYTES = 8 * HTB, NXCD = 8, WGM = 8;

__host__ __device__ __forceinline__ int lds_byte(int r, int c) { const int st = (r >> 4) * 2 + (c >> 5), rr = r & 15, cc = c & 31, ob = rr * 64 + cc * 2; return st * 1024 + (ob ^ (((ob >> 9) & 1) << 5)); }
__host__ __device__ __forceinline__ void stage_rc(int b, int& R, int& C) { const int st = b / 1024, sb = b % 1024, swz = sb ^ (((sb >> 9) & 1) << 5); R = (st >> 1) * 16 + swz / 64; C = (st & 1) * 32 + (swz % 64) / 2; }
__host__ __device__ __forceinline__ int perm32(int rho) { const int n = rho >> 4, i = rho & 15; return 8 * (i >> 2) + 4 * n + (i & 3); }

struct Unit { int pm, pn; };
struct Gemm { const bf16_t* A; const bf16_t* Bt; int M, N, K; };

struct StaticOrder {
    int nM, nN, nwg, G, c;
    __host__ __device__ void init(int M, int N, int G_, int c_) { nM = M / BM; nN = N / BM; nwg = nM * nN; G = G_; c = c_; }
    __host__ __device__ bool next(int i, Unit& u) const {
        const long L = (long)i * G + c; if (L >= nwg) return false;
        int wgid = (int)L; { const int q = nwg / NXCD, r = nwg % NXCD, xcd = wgid % NXCD, off = wgid / NXCD; wgid = (xcd < r ? xcd * (q + 1) : r * (q + 1) + (xcd - r) * q) + off; }
        const int nig = WGM * nN, gid = wgid / nig, fm = gid * WGM, gsz = (nM - fm) < WGM ? (nM - fm) : WGM;
        u.pm = fm + ((wgid % nig) % gsz); u.pn = (wgid % nig) / gsz; return true;
    }
    __device__ __forceinline__ void a_ready(const Unit&) const {}
    __device__ __forceinline__ void done(const Unit&) const {}
};

struct QueueOrder {
    int nM, nN, per; unsigned* Q; int xcc; PG8_LAS int* slot;
    __device__ __forceinline__ void init(int M, int N, unsigned* Q_, int xcc_, PG8_LAS int* slot_) { nM = M / BM; nN = N / BM; per = nM * nN / NXCD; Q = Q_; xcc = xcc_; slot = slot_; }
    __device__ __forceinline__ int fetch() const {
        for (int s = 0; s < NXCD; ++s) { const int b = (xcc + s) & (NXCD - 1); const unsigned n = __hip_atomic_fetch_add(Q + 64 * b, 1u, __ATOMIC_RELAXED, __HIP_MEMORY_SCOPE_AGENT); if (n < (unsigned)per) return b * per + (int)n; }
        return -1; }
    __device__ __forceinline__ void prime() const { if (threadIdx.x == 0) { slot[0] = fetch(); slot[1] = fetch(); } }
    __device__ __forceinline__ bool next(int i, Unit& u) const {
        if (threadIdx.x == 0) slot[(i + 2) & 3] = fetch();
        const int wgid = __builtin_amdgcn_readfirstlane(slot[i & 3]); if (wgid < 0) return false;
        const int nig = WGM * nN, gid = wgid / nig, fm = gid * WGM, gsz = (nM - fm) < WGM ? (nM - fm) : WGM;
        u.pm = fm + ((wgid % nig) % gsz); u.pn = (wgid % nig) / gsz; return true; }
    __device__ __forceinline__ void a_ready(const Unit&) const {}
    __device__ __forceinline__ void done(const Unit&) const {}
};

struct PanelOrder {
    int pm, nN;
    __host__ __device__ bool next(int i, Unit& u) const { if (i >= nN) return false; u.pm = pm; u.pn = i; return true; }
    __device__ __forceinline__ void a_ready(const Unit&) const {}
    __device__ __forceinline__ void done(const Unit&) const {}
};
__device__ __forceinline__ unsigned cvt_pk_bf16(float lo, float hi) { unsigned r; asm volatile("v_cvt_pk_bf16_f32 %0, %1, %2" : "=v"(r) : "v"(lo), "v"(hi)); return r; }
typedef float f32x2 __attribute__((ext_vector_type(2)));
__device__ __forceinline__ f32x2 gelu_pk(f32x2 v) {
    const f32x2 av = __builtin_elementwise_abs(v), d = av * 0.2316418882f + 1.0f;
    f32x2 t; t.x = __builtin_amdgcn_rcpf(d.x); t.y = __builtin_amdgcn_rcpf(d.y);
    f32x2 q = t * 0.5307027145f + (-0.7265760135f); q = q * t + 0.7107068705f; q = q * t + (-0.142248368f); q = q * t + 0.127414796f; q = q * t;
    const f32x2 s = (v * v) * (-0.72134752044f);
    f32x2 e; e.x = __builtin_amdgcn_exp2f(s.x); e.y = __builtin_amdgcn_exp2f(s.y);
    const f32x2 m = v * (q * e), r = v - m;
    f32x2 o; o.x = v.x < 0.f ? m.x : r.x; o.y = v.y < 0.f ? m.y : r.y; return o;
}

template <int ACT  > struct EpiBf16 {
    static constexpr bool PERM = true, AFTER_DRAIN = false; static_assert(ACT == 0 || ACT == 1, "EpiBf16: ACT is 0 (none) or 1 (gelu_pk)");
    bf16_t* O; int ldc; const float* bias; int split_cols; size_t split_stride; float scale0;
    __device__ __forceinline__ void operator()(const f32x4 (&acc)[2][2][4][2], const Unit& u, int wr, int wc, int fr, int fq) const {
        const int row0 = u.pm * BM + wr * 64 + fr; int colt = u.pn * BM; bf16_t* base = O;
        float sc = 1.f; if (split_cols) { const int t = colt / split_cols; base += (size_t)t * split_stride; colt -= t * split_cols; if (t == 0) sc = scale0; }
        const int col0 = colt + wc * 32 + 8 * fq, bcol0 = u.pn * BM + wc * 32 + 8 * fq;
        f32x4 bv[2][2];
#pragma unroll
        for (int bj = 0; bj < 2; ++bj)
#pragma unroll
            for (int n = 0; n < 2; ++n) bv[bj][n] = bias ? *(const f32x4*)(bias + bcol0 + bj * HALF + 4 * n) : (f32x4){0.f, 0.f, 0.f, 0.f};
#pragma unroll
        for (int ai = 0; ai < 2; ++ai)
#pragma unroll
            for (int m = 0; m < 4; ++m) { bf16_t* rowp = base + (size_t)(row0 + ai * HALF + m * 16) * ldc + col0;
#pragma unroll
                for (int bj = 0; bj < 2; ++bj) { f32x4 v0 = acc[ai][bj][m][0] + bv[bj][0], v1 = acc[ai][bj][m][1] + bv[bj][1];
                    if (ACT == 1) { f32x2 a = gelu_pk((f32x2){v0[0], v0[1]}), b = gelu_pk((f32x2){v0[2], v0[3]}), c = gelu_pk((f32x2){v1[0], v1[1]}), d = gelu_pk((f32x2){v1[2], v1[3]});
                        v0 = (f32x4){a.x, a.y, b.x, b.y}; v1 = (f32x4){c.x, c.y, d.x, d.y}; }
                    v0 = v0 * sc; v1 = v1 * sc; u32x4 w; w.x = cvt_pk_bf16(v0[0], v0[1]); w.y = cvt_pk_bf16(v0[2], v0[3]); w.z = cvt_pk_bf16(v1[0], v1[1]); w.w = cvt_pk_bf16(v1[2], v1[3]);
                    *(u32x4*)(rowp + bj * HALF) = w; } }
    }
};

typedef int v8i_t __attribute__((ext_vector_type(8)));
typedef int v4i_t __attribute__((ext_vector_type(4)));
__device__ __forceinline__ v8i_t cat32(bf16x8 lo, bf16x8 hi) { return __builtin_shufflevector(__builtin_bit_cast(v4i_t, lo), __builtin_bit_cast(v4i_t, hi), 0, 1, 2, 3, 4, 5, 6, 7); }
template <class Epi, class Sched, bool ALIGN_EPI = false, bool SP2 = false, int MODE = 0>
__device__ __forceinline__ void gemm_phase(PG8_LAS unsigned char* lds, const Gemm g, const Sched& S, const Epi& E) {
    constexpr bool FP8 = (MODE == 1);
    int tid_ = threadIdx.x; asm volatile("" : "+v"(tid_));
    const int tid = tid_, wid = __builtin_amdgcn_readfirstlane(tid >> 6), lane = tid & 63, wr = wid >> 2, wc = wid & 3, fr = lane & 15, fq = lane >> 4;
    const int K = g.K, nt = K / BK;
    unsigned voffA[2], voffB[2];
#pragma unroll
    for (int i = 0; i < 2; ++i) { int R, C; stage_rc(tid * 16 + i * 8192, R, C); const int Rb = Epi::PERM ? ((R & ~31) + perm32(R & 31)) : R;
        voffA[i] = (unsigned)(R * K + C) * 2u; voffB[i] = (unsigned)(Rb * K + C) * 2u; }
    const size_t kstep = (size_t)(BK * 2);
    const size_t hstep = (size_t)HALF * K * 2;
    const size_t tstep = 2 * hstep;
    const unsigned ldsw = (unsigned)wid * 1024u;
    const int aoff = lds_byte(wr * 64 + fr, fq * 8), boff = lds_byte(wc * 32 + fr, fq * 8);
#define PG8_SA(b, h) (((b) * 2 + (h)) * HTB)
#define PG8_SB(b, h) ((4 + (b) * 2 + (h)) * HTB)
#define PG8_STAGE(bufoff, gbase, voff) do { _Pragma("unroll") for (int _i = 0; _i < 2; ++_i) \
        __builtin_amdgcn_global_load_lds((const unsigned*)((const char*)(gbase) + (voff)[_i]), (PG8_LAS unsigned*)(lds + (bufoff) + ldsw + _i * 8192), 16, 0, 0); } while (0)
#define PG8_LDA(dst, b, h) do { if constexpr (FP8) { _Pragma("unroll") for (int m = 0; m < 4; ++m) dst##8[m] = cat32(*(const PG8_LAS bf16x8*)(lds + PG8_SA(b, h) + aoff + m * 2048), *(const PG8_LAS bf16x8*)(lds + PG8_SA(b, h) + aoff + m * 2048 + 1024)); } \
        else { _Pragma("unroll") for (int m = 0; m < 4; ++m) _Pragma("unroll") for (int k = 0; k < 2; ++k) dst[m][k] = *(const PG8_LAS bf16x8*)(lds + PG8_SA(b, h) + aoff + m * 2048 + k * 1024); } } while (0)
#define PG8_LDB(dst, b, h) do { if constexpr (FP8) { _Pragma("unroll") for (int n = 0; n < 2; ++n) dst##8[n] = cat32(*(const PG8_LAS bf16x8*)(lds + PG8_SB(b, h) + boff + n * 2048), *(const PG8_LAS bf16x8*)(lds + PG8_SB(b, h) + boff + n * 2048 + 1024)); } \
        else { _Pragma("unroll") for (int n = 0; n < 2; ++n) _Pragma("unroll") for (int k = 0; k < 2; ++k) dst[n][k] = *(const PG8_LAS bf16x8*)(lds + PG8_SB(b, h) + boff + n * 2048 + k * 1024); } } while (0)
#define PG8_MMA(ai, bj, At, Bt) do { __builtin_amdgcn_s_setprio(1); _Pragma("unroll") for (int m = 0; m < 4; ++m) _Pragma("unroll") for (int n = 0; n < 2; ++n) { \
        if constexpr (FP8) acc[ai][bj][m][n] = __builtin_amdgcn_mfma_scale_f32_16x16x128_f8f6f4(Bt##8[n], At##8[m], acc[ai][bj][m][n], 0, 0, 0, 0x7F7F7F7F, 0, 0x7F7F7F7F); \
        else if constexpr (MODE == 2) { _Pragma("unroll") for (int k = 0; k < 2; ++k) acc[ai][bj][m][n] = __builtin_bit_cast(f32x4, __builtin_amdgcn_mfma_i32_16x16x64_i8(__builtin_bit_cast(v4i_t, Bt[n][k]), __builtin_bit_cast(v4i_t, At[m][k]), __builtin_bit_cast(v4i_t, acc[ai][bj][m][n]), 0, 0, 0)); } \
        else { _Pragma("unroll") for (int k = 0; k < 2; ++k) acc[ai][bj][m][n] = __builtin_amdgcn_mfma_f32_16x16x32_bf16(Bt[n][k], At[m][k], acc[ai][bj][m][n], 0, 0, 0); } } __builtin_amdgcn_s_setprio(0); } while (0)
#define PG8_WAIT_V(n) asm volatile("s_waitcnt vmcnt(" #n ")" ::: "memory")
#define PG8_WAIT_L(n) asm volatile("s_waitcnt lgkmcnt(" #n ")" ::: "memory")
#define PG8_BAR __builtin_amdgcn_s_barrier()
#define PG8_SCHED __builtin_amdgcn_sched_barrier(0)
    Unit cur, nxt; int ui = 0;
    if (!S.next(0, cur)) return;
    f32x4 acc[2][2][4][2];
#pragma unroll
    for (int a = 0; a < 2; ++a)
#pragma unroll
        for (int b = 0; b < 2; ++b)
#pragma unroll
            for (int m = 0; m < 4; ++m)
#pragma unroll
                for (int n = 0; n < 2; ++n) acc[a][b][m][n] = (f32x4){0.f, 0.f, 0.f, 0.f};
    bf16x8 At[4][2], B0[2][2], B1[2][2]; v8i_t At8[4], B08[2], B18[2];
    const char* cA = (const char*)g.A + (size_t)cur.pm * tstep; const char* cB = (const char*)g.Bt + (size_t)cur.pn * tstep;
    S.a_ready(cur);
    if constexpr (SP2) {
        PG8_STAGE(PG8_SB(0, 0), cB, voffB); PG8_STAGE(PG8_SB(0, 1), cB + hstep, voffB); PG8_STAGE(PG8_SA(0, 0), cA, voffA); PG8_STAGE(PG8_SA(0, 1), cA + hstep, voffA);
        if (wr == 1) PG8_BAR;
        PG8_WAIT_V(2); PG8_BAR;
        PG8_STAGE(PG8_SB(1, 0), cB + kstep, voffB); PG8_STAGE(PG8_SA(1, 0), cA + kstep, voffA); PG8_STAGE(PG8_SB(1, 1), cB + hstep + kstep, voffB);
        PG8_WAIT_V(6); PG8_BAR;
    } else {
        PG8_STAGE(PG8_SB(0, 0), cB, voffB); PG8_STAGE(PG8_SA(0, 0), cA, voffA); PG8_STAGE(PG8_SB(0, 1), cB + hstep, voffB); PG8_STAGE(PG8_SA(0, 1), cA + hstep, voffA);
        if (wr == 1) PG8_BAR;
        PG8_WAIT_V(4); PG8_BAR;
        PG8_STAGE(PG8_SB(1, 0), cB + kstep, voffB); PG8_STAGE(PG8_SA(1, 0), cA + kstep, voffA); PG8_STAGE(PG8_SB(1, 1), cB + hstep + kstep, voffB);
        PG8_WAIT_V(6); PG8_BAR;
    }
    for (;;) {
        const bool has_next = S.next(ui + 1, nxt);
        const char* nA = has_next ? (const char*)g.A + (size_t)nxt.pm * tstep : cA; const char* nB = has_next ? (const char*)g.Bt + (size_t)nxt.pn * tstep : cB;
_Pragma("nounroll")
        for (int t = 0; t < nt; t += 2) {
            const bool last = (t == nt - 2);
            const char* a1 = cA + (size_t)(t + 1) * kstep;
            const char* a2 = last ? nA : cA + (size_t)(t + 2) * kstep; const char* b2 = last ? nB : cB + (size_t)(t + 2) * kstep;
            const char* a3 = a2 + kstep; const char* b3 = b2 + kstep;
            if (last && has_next) S.a_ready(nxt);
            if constexpr (SP2) {
            PG8_LDB(B0, 0, 0); PG8_LDB(B1, 0, 1); PG8_SCHED; PG8_LDA(At, 0, 0); PG8_STAGE(PG8_SA(1, 1), a1 + hstep, voffA);
            PG8_WAIT_V(8); PG8_WAIT_L(0); PG8_BAR; PG8_MMA(0, 0, At, B0); PG8_MMA(0, 1, At, B1); PG8_BAR; PG8_SCHED;
            PG8_LDA(At, 0, 1); PG8_STAGE(PG8_SB(0, 0), b2, voffB); PG8_STAGE(PG8_SB(0, 1), b2 + hstep, voffB); PG8_STAGE(PG8_SA(0, 0), a2, voffA);
            PG8_WAIT_V(8); PG8_WAIT_L(0); PG8_BAR; PG8_MMA(1, 0, At, B0); PG8_MMA(1, 1, At, B1); PG8_BAR; PG8_SCHED;
            PG8_LDB(B0, 1, 0); PG8_LDB(B1, 1, 1); PG8_SCHED; PG8_LDA(At, 1, 0); PG8_STAGE(PG8_SA(0, 1), a2 + hstep, voffA);
            PG8_WAIT_V(8); PG8_WAIT_L(0); PG8_BAR; PG8_MMA(0, 0, At, B0); PG8_MMA(0, 1, At, B1); PG8_BAR; PG8_SCHED;
            PG8_LDA(At, 1, 1); PG8_STAGE(PG8_SB(1, 0), b3, voffB); PG8_STAGE(PG8_SB(1, 1), b3 + hstep, voffB); PG8_STAGE(PG8_SA(1, 0), a3, voffA);
            PG8_WAIT_V(8); PG8_WAIT_L(0); PG8_BAR; PG8_MMA(1, 0, At, B0); PG8_MMA(1, 1, At, B1); PG8_BAR; PG8_SCHED;
            } else {
            PG8_LDB(B0, 0, 0); PG8_SCHED; PG8_LDA(At, 0, 0); PG8_STAGE(PG8_SA(1, 1), a1 + hstep, voffA);
            PG8_WAIT_L(8); PG8_BAR; PG8_WAIT_L(0); PG8_MMA(0, 0, At, B0); PG8_BAR; PG8_SCHED;
            PG8_LDB(B1, 0, 1); PG8_STAGE(PG8_SB(0, 0), b2, voffB);
            PG8_BAR; PG8_WAIT_L(0); PG8_MMA(0, 1, At, B1); PG8_BAR;
            PG8_LDA(At, 0, 1); PG8_STAGE(PG8_SA(0, 0), a2, voffA);
            PG8_BAR; PG8_WAIT_L(0); PG8_MMA(1, 0, At, B0); PG8_BAR; PG8_SCHED;
            PG8_STAGE(PG8_SB(0, 1), b2 + hstep, voffB);
            PG8_WAIT_V(6); PG8_BAR; PG8_MMA(1, 1, At, B1); PG8_BAR;
            PG8_LDB(B0, 1, 0); PG8_SCHED; PG8_LDA(At, 1, 0); PG8_STAGE(PG8_SA(0, 1), a2 + hstep, voffA);
            PG8_WAIT_L(8); PG8_BAR; PG8_WAIT_L(0); PG8_MMA(0, 0, At, B0); PG8_BAR; PG8_SCHED;
            PG8_LDB(B1, 1, 1); PG8_STAGE(PG8_SB(1, 0), b3, voffB);
            PG8_BAR; PG8_WAIT_L(0); PG8_MMA(0, 1, At, B1); PG8_BAR;
            PG8_LDA(At, 1, 1); PG8_STAGE(PG8_SA(1, 0), a3, voffA);
            PG8_BAR; PG8_WAIT_L(0); PG8_MMA(1, 0, At, B0); PG8_BAR; PG8_SCHED;
            PG8_STAGE(PG8_SB(1, 1), b3 + hstep, voffB);
            PG8_WAIT_V(6); PG8_BAR; PG8_MMA(1, 1, At, B1); PG8_BAR;
            }
        }
        if constexpr (ALIGN_EPI) { if (wr == 0) PG8_BAR; }
        if constexpr (!Epi::AFTER_DRAIN) { E(acc, cur, wr, wc, fr, fq); S.done(cur); }
        if (!has_next) break;
#pragma unroll
        for (int a = 0; a < 2; ++a)
#pragma unroll
            for (int b = 0; b < 2; ++b)
#pragma unroll
                for (int m = 0; m < 4; ++m)
#pragma unroll
                    for (int n = 0; n < 2; ++n) acc[a][b][m][n] = (f32x4){0.f, 0.f, 0.f, 0.f};
        cur = nxt; cA = nA; cB = nB; ++ui;
        if constexpr (ALIGN_EPI) { if (wr == 1) PG8_BAR; }
    }
    PG8_WAIT_V(0);
    if constexpr (!ALIGN_EPI) { if (wr == 0) PG8_BAR; }
    PG8_BAR;
    if constexpr (Epi::AFTER_DRAIN) { E.fused(acc, cur, wr, wc, fr, fq, lds, wid, lane); S.done(cur); }
#undef PG8_SA
#undef PG8_SB
#undef PG8_STAGE
#undef PG8_LDA
#undef PG8_LDB
#undef PG8_MMA
#undef PG8_WAIT_V
#undef PG8_WAIT_L
#undef PG8_BAR
#undef PG8_SCHED
}
}
#define PG8_SP2 true
#define GAS __attribute__((address_space(1)))
#define LAS __attribute__((address_space(3)))
typedef unsigned short bf16raw;
typedef unsigned v4u __attribute__((ext_vector_type(4)));
typedef unsigned v2u __attribute__((ext_vector_type(2)));
typedef float f32x4 __attribute__((ext_vector_type(4)));
typedef float f32x2 __attribute__((ext_vector_type(2)));
typedef float f32x16 __attribute__((ext_vector_type(16)));
typedef short bf16x8 __attribute__((ext_vector_type(8)));
typedef GAS unsigned gu32;
#define RLX_AGENT __ATOMIC_RELAXED, __HIP_MEMORY_SCOPE_AGENT
constexpr int NWAVES = 8, NTHR = 512;
constexpr int BATCH = 8, T = 8192, D = 1024, M = BATCH * T;
constexpr int MH = 4, MD = 256, FH = 8, FD = 128, LCH = 64, NCH = T / LCH;
constexpr int DIN = 9232;
constexpr int PH = 8, PKEYS = 128, PTOP = 16, HK = PH * PTOP, NEXP = 16384;
constexpr float EPS = 1e-6f;
__device__ __forceinline__ unsigned f2bf(float f) { unsigned u = __builtin_bit_cast(unsigned, f); return (u + 0x7fffu + ((u >> 16) & 1u)) >> 16; }
typedef __bf16 bf16x2_t __attribute__((ext_vector_type(2)));
__device__ __forceinline__ unsigned pk2(float lo, float hi) { return __builtin_bit_cast(unsigned, __builtin_convertvector((f32x2){lo, hi}, bf16x2_t)); }
__device__ __forceinline__ float bflo(unsigned w) { return __builtin_bit_cast(float, w << 16); }
__device__ __forceinline__ float bfhi(unsigned w) { return __builtin_bit_cast(float, w & 0xffff0000u); }
__device__ __forceinline__ float bf1(bf16raw h) { return __builtin_bit_cast(float, (unsigned)h << 16); }
template <int CTRL> __device__ __forceinline__ float dppf(float v) { return __builtin_bit_cast(float, __builtin_amdgcn_update_dpp(0, __builtin_bit_cast(int, v), CTRL, 0xf, 0xf, false)); }
__device__ __forceinline__ float row8_sum(float v) { v += dppf<0xB1>(v); v += dppf<0x4E>(v); v += dppf<0x141>(v); return v; }
__device__ __forceinline__ float row16_sum(float v) { v = row8_sum(v); v += dppf<0x140>(v); return v; }
__device__ __forceinline__ float row16_max(float v) { v = fmaxf(v, dppf<0xB1>(v)); v = fmaxf(v, dppf<0x4E>(v)); v = fmaxf(v, dppf<0x141>(v)); v = fmaxf(v, dppf<0x140>(v)); return v; }
__device__ __forceinline__ float rdl(float v, int l) { return __builtin_bit_cast(float, __builtin_amdgcn_readlane(__builtin_bit_cast(int, v), l)); }
__device__ __forceinline__ float wave_sum_dpp(float v) { v = row16_sum(v); return (rdl(v, 0) + rdl(v, 16)) + (rdl(v, 32) + rdl(v, 48)); }
__device__ __forceinline__ float wave_max_dpp(float v) { v = row16_max(v); return fmaxf(fmaxf(rdl(v, 0), rdl(v, 16)), fmaxf(rdl(v, 32), rdl(v, 48))); }
__device__ __forceinline__ float wave_sum(float v) {
#pragma unroll
    for (int o = 1; o < 64; o <<= 1) v += __shfl_xor(v, o);
    return v;
}
__device__ __forceinline__ float sigmoidf_(float x) { return __builtin_amdgcn_rcpf(1.0f + __builtin_amdgcn_exp2f(x * -1.4426950408889634f)); }
__device__ __forceinline__ unsigned q8x4_pack(float a, float b, float c, float d, float inv) {
    const unsigned ua = __builtin_bit_cast(unsigned, __builtin_fmaf(a, inv, 12582912.f)), ub = __builtin_bit_cast(unsigned, __builtin_fmaf(b, inv, 12582912.f));
    const unsigned uc = __builtin_bit_cast(unsigned, __builtin_fmaf(c, inv, 12582912.f)), ud = __builtin_bit_cast(unsigned, __builtin_fmaf(d, inv, 12582912.f));
    return __builtin_amdgcn_perm(ub, ua, 0x0c0c0400u) | __builtin_amdgcn_perm(ud, uc, 0x04000c0cu);
}
__device__ __forceinline__ unsigned nib4(unsigned w) { w = (w | (w >> 4)) & 0x00FF00FFu; return (w | (w >> 8)) & 0xFFFFu; }
__device__ __forceinline__ float logsigf_(float x) { return fminf(x, 0.f) - log1pf(__expf(-fabsf(x))); }
__device__ __forceinline__ float gelu_erf(float v) {
    const float av = fabsf(v), t = __builtin_amdgcn_rcpf(av * 0.2316418882f + 1.0f);
    float q = t * 0.5307027145f + (-0.7265760135f); q = q * t + 0.7107068705f; q = q * t + (-0.142248368f); q = q * t + 0.127414796f; q = q * t;
    const float e = __builtin_amdgcn_exp2f((v * v) * (-0.72134752044f));
    const float m = v * (q * e);
    return v < 0.f ? m : v - m;
}
constexpr size_t MiB = 1u << 20;
constexpr size_t WS_CTL = 0, CTL_ZERO_BYTES = 1 * MiB;
constexpr size_t WS_Z16 = 2 * MiB;
constexpr size_t WS_CS = 6 * MiB;
constexpr size_t WS_GROWF = 8 * MiB, WS_GCOLF = 9 * MiB, WS_GWINT = 10 * MiB, WS_GEDEN = 11 * MiB, WS_GWSW = 12 * MiB;
constexpr size_t WS_JLO = 13 * MiB + 262144;
constexpr size_t WS_GDECAY = 13 * MiB, WS_BIASP = 13 * MiB + 65536, WS_BIASG = 13 * MiB + 131072;
constexpr size_t WS_KBAR = 14 * MiB, WS_DSUM = 18 * MiB;
constexpr size_t WS_SKB = 19 * MiB, WS_WGT = 19 * MiB + 524288;
constexpr size_t WS_WINT = 20 * MiB, WS_WMT = 38 * MiB, WS_WFT = 40 * MiB, WS_WOT = 42 * MiB, WS_WPQT = 44 * MiB;
constexpr size_t WS_SP = 48 * MiB, WS_IDS = 80 * MiB, WS_GW = 112 * MiB, WS_UB = 144 * MiB, WS_VB = 176 * MiB;
constexpr size_t WS_R0 = 256 * MiB, RSZ = 128 * MiB;
constexpr size_t WS_END = 1024 * MiB;
constexpr int CW_TMO = 0, CW_BAR = 4096, CW_QU = 8192, CW_QV = 8192 + 512, CW_QF = 8192 + 1024, CW_CMAX = 16384, CW_QG = 9728  , CW_FDONE = 12288  , CW_QM = 10240  ;
constexpr int LDS_BYTES = 163840;
constexpr int LDS_MISC = 160 * 1024 - 256;
#define XB_TMO      128
#define XB_XCNT(j)  (256  + 64 * (j))
#define XB_XSUB(j)  (1280 + 64 * (j))
#define XB_XGEN(j)  (2304 + 64 * (j))
#define XB_TOP      3328
#define XB_TOPGEN   3392
#define XCD_BAR_WORDS 3456
#define XB_SPIN_CAP (1u << 18)

__device__ __forceinline__ unsigned xb_ld(unsigned* p)              { return __hip_atomic_load(p, __ATOMIC_RELAXED, __HIP_MEMORY_SCOPE_AGENT); }
__device__ __forceinline__ unsigned xb_add(unsigned* p, unsigned v) { return __hip_atomic_fetch_add(p, v, __ATOMIC_RELAXED, __HIP_MEMORY_SCOPE_AGENT); }
__device__ __forceinline__ unsigned xb_xcc_id() { return (unsigned)__builtin_amdgcn_s_getreg((3 << 11) | 20) & 0xFu; }
#define XB_SPIN(cond, bar) do { unsigned _sp = 0; while (cond) { __builtin_amdgcn_s_sleep(1); \
    if ((++_sp & 255u) == 0u) { if (xb_ld(&(bar)[XB_TMO])) break; if (_sp > XB_SPIN_CAP) { atomicAdd(&(bar)[XB_TMO], 1u); break; } } } } while (0)

struct XcdBarrier {
    unsigned* bar; unsigned x;
    volatile LAS unsigned* st;
};

__device__ __forceinline__ XcdBarrier xcd_barrier_post(unsigned* bar, volatile LAS unsigned* st) {
    XcdBarrier b; b.bar = bar; b.x = xb_xcc_id(); b.st = st;
    if (threadIdx.x == 0) (void)xb_add(&bar[XB_XCNT(b.x)], 1u);
    return b;
}
__device__ __forceinline__ void xcd_barrier_complete(unsigned* bar, unsigned x, unsigned& nloc, unsigned& nx) {
    const unsigned G = gridDim.x * gridDim.y * gridDim.z;
    unsigned sum, cnt, mine, sp = 0u;
    for (;;) {
        sum = 0u; cnt = 0u; mine = 0u;
#pragma unroll
        for (unsigned j = 0; j < 16; ++j) { const unsigned c = xb_ld(&bar[XB_XCNT(j)]); sum += c; cnt += (c > 0u) ? 1u : 0u; mine = (j == x) ? c : mine; }
        if (sum == G) break;
        __builtin_amdgcn_s_sleep(1);
        if ((++sp & 255u) == 0u) { if (xb_ld(&bar[XB_TMO])) break; if (sp > XB_SPIN_CAP) { atomicAdd(&bar[XB_TMO], 1u); break; } }
    }
    nloc = mine > 0u ? mine : 1u; nx = cnt > 0u ? cnt : 1u;
}

__device__ __forceinline__ void xcd_barrier(const XcdBarrier& b) {
    asm volatile("s_waitcnt vmcnt(0)" ::: "memory");
    __syncthreads();
    if (threadIdx.x == 0) {
        unsigned* bar = b.bar;
        __builtin_amdgcn_s_waitcnt(0);
        unsigned nloc = b.st[0], nx = b.st[1];
        if (nloc == 0u) { xcd_barrier_complete(bar, b.x, nloc, nx); b.st[0] = nloc; b.st[1] = nx; }
        const unsigned old = xb_add(&bar[XB_XSUB(b.x)], 1u);
        const unsigned gen = old / nloc;
        if (old + 1u == (gen + 1u) * nloc) {
            __builtin_amdgcn_fence(__ATOMIC_RELEASE, "agent");
            asm volatile("s_waitcnt vmcnt(0)" ::: "memory");
            const unsigned og = xb_add(&bar[XB_TOP], 1u);
            const unsigned tg = og / nx;
            if (og + 1u == (tg + 1u) * nx) xb_add(&bar[XB_TOPGEN], 1u);
            else XB_SPIN(xb_ld(&bar[XB_TOPGEN]) == tg, bar);
            __builtin_amdgcn_fence(__ATOMIC_ACQUIRE, "agent");
            xb_add(&bar[XB_XGEN(b.x)], 1u);
            asm volatile("s_waitcnt vmcnt(0)" ::: "memory");
        } else {
            XB_SPIN(xb_ld(&bar[XB_XGEN(b.x)]) == gen, bar);
            __builtin_amdgcn_fence(__ATOMIC_ACQUIRE, "agent");
            asm volatile("s_waitcnt vmcnt(0)" ::: "memory");
        }
    }
    __syncthreads();
}
namespace pg8 {
__device__ __forceinline__ float q8f(unsigned w, int k) { return (float)(int)(signed char)(w >> (8 * k)) * (1.f / 16.f); }
struct EpiGate {
    static constexpr bool PERM = true, AFTER_DRAIN = false;
    bf16_t* O; const signed char* Gt; const bf16_t* Add; int ldc;
    __device__ __forceinline__ void operator()(const f32x4 (&acc)[2][2][4][2], const Unit& u, int wr, int wc, int fr, int fq) const {
        const int row0 = u.pm * BM + wr * 64 + fr, col0 = u.pn * BM + wc * 32 + 8 * fq;
        unsigned long long g[2][4][2]; u32x4 ad[2][4][2];
#pragma unroll
        for (int ai = 0; ai < 2; ++ai)
#pragma unroll
            for (int m = 0; m < 4; ++m) { const size_t ro = (size_t)(row0 + ai * HALF + m * 16) * ldc + col0;
#pragma unroll
                for (int bj = 0; bj < 2; ++bj) { g[ai][m][bj] = *(const unsigned long long*)(Gt + ro + bj * HALF); ad[ai][m][bj] = (u32x4){0u, 0u, 0u, 0u}; if (Add && ai == 0) ad[ai][m][bj] = *(const u32x4*)(Add + ro + bj * HALF); } }
#pragma unroll
        for (int ai = 0; ai < 2; ++ai)
#pragma unroll
            for (int m = 0; m < 4; ++m) { const size_t ro = (size_t)(row0 + ai * HALF + m * 16) * ldc + col0;
#pragma unroll
                for (int bj = 0; bj < 2; ++bj) {
                    if (Add && ai == 0 && m > 0) ad[1][m - 1][bj] = *(const u32x4*)(Add + ro + (size_t)(HALF - 16) * ldc + bj * HALF);
                    if (Add && ai == 1 && m == 0) ad[1][3][bj] = *(const u32x4*)(Add + ro + (size_t)48 * ldc + bj * HALF);
                    const f32x4 v0 = acc[ai][bj][m][0], v1 = acc[ai][bj][m][1];
                    const unsigned gw[2] = {(unsigned)g[ai][m][bj], (unsigned)(g[ai][m][bj] >> 32)}, aw[4] = {ad[ai][m][bj].x, ad[ai][m][bj].y, ad[ai][m][bj].z, ad[ai][m][bj].w}; const float vv[8] = {v0[0], v0[1], v0[2], v0[3], v1[0], v1[1], v1[2], v1[3]};
                    unsigned o[4];
#pragma unroll
                    for (int i = 0; i < 4; ++i) { const float a = vv[2 * i] * sigmoidf_(q8f(gw[i >> 1], 2 * (i & 1))) + bflo(aw[i]), b = vv[2 * i + 1] * sigmoidf_(q8f(gw[i >> 1], 2 * (i & 1) + 1)) + bfhi(aw[i]); o[i] = cvt_pk_bf16(a, b); }
                    *(u32x4*)(O + ro + bj * HALF) = (u32x4){o[0], o[1], o[2], o[3]}; } }
    }
};
struct EpiBf16S {
    static constexpr bool PERM = false, AFTER_DRAIN = false;
    bf16_t* O; int ldc; const float* bias; size_t split_stride; float sc;
    __device__ __forceinline__ void operator()(const f32x4 (&acc)[2][2][4][2], const Unit& u, int wr, int wc, int fr, int fq) const {
        typedef unsigned u32x2 __attribute__((ext_vector_type(2)));
        { int t_ = threadIdx.x; asm volatile("" : "+v"(t_)); fr = t_ & 15; fq = (t_ >> 4) & 3; }
        const int row0 = u.pm * BM + wr * 64 + fr; int colt = u.pn * BM; const int t = colt >> 10; bf16_t* base = O + (size_t)t * split_stride; colt -= t << 10;
        const int col0 = colt + wc * 32 + 4 * fq, bcol0 = u.pn * BM + wc * 32 + 4 * fq;
#pragma unroll
        for (int bj = 0; bj < 2; ++bj)
#pragma unroll
            for (int n = 0; n < 2; ++n) { const f32x4 bv = *(const f32x4*)(bias + bcol0 + bj * HALF + 16 * n);
#pragma unroll
                for (int ai = 0; ai < 2; ++ai)
#pragma unroll
                    for (int m = 0; m < 4; ++m) { const f32x4 v = acc[ai][bj][m][n] * sc + bv; u32x2 w; w.x = cvt_pk_bf16(v[0], v[1]); w.y = cvt_pk_bf16(v[2], v[3]);
                        *(u32x2*)(base + (size_t)(row0 + ai * HALF + m * 16) * ldc + col0 + bj * HALF + 16 * n) = w; } }
    }
};
struct EpiQ8 {
    static constexpr bool PERM = true, AFTER_DRAIN = false;
    signed char* O; int ldc; const float* bias; const float* sw; const float* sh; size_t off1, off2;
    __device__ __forceinline__ void operator()(const f32x4 (&acc)[2][2][4][2], const Unit& u, int wr, int wc, int fr, int fq) const {
        typedef int i32x4 __attribute__((ext_vector_type(4)));
        { int t_ = threadIdx.x; asm volatile("" : "+v"(t_)); fr = t_ & 15; fq = (t_ >> 4) & 3; }
        const int row0 = u.pm * BM + wr * 64 + fr; int colt = u.pn * BM; const int t = colt >> 10; signed char* base = O + (t == 0 ? (size_t)0 : t == 1 ? off1 : off2); colt -= t << 10;
        const int col0 = colt + wc * 32 + 8 * fq, bcol0 = u.pn * BM + wc * 32 + 8 * fq;
        float rs[2][4];
#pragma unroll
        for (int ai = 0; ai < 2; ++ai)
#pragma unroll
            for (int m = 0; m < 4; ++m) rs[ai][m] = sh[row0 + ai * HALF + m * 16];
        f32x4 bv_[2][2], cs_[2][2];
#pragma unroll
        for (int bj = 0; bj < 2; ++bj)
#pragma unroll
            for (int n = 0; n < 2; ++n) { bv_[bj][n] = bias ? *(const f32x4*)(bias + bcol0 + bj * HALF + 4 * n) : (f32x4){0.f, 0.f, 0.f, 0.f}; cs_[bj][n] = *(const f32x4*)(sw + bcol0 + bj * HALF + 4 * n); }
#pragma unroll
        for (int bj = 0; bj < 2; ++bj) { const f32x4 (&bv)[2] = bv_[bj]; const f32x4 (&cs)[2] = cs_[bj];
#pragma unroll
            for (int ai = 0; ai < 2; ++ai)
#pragma unroll
                for (int m = 0; m < 4; ++m) { unsigned w2[2];
#pragma unroll
                    for (int n = 0; n < 2; ++n) { const i32x4 iv = __builtin_bit_cast(i32x4, acc[ai][bj][m][n]);
                        const f32x4 v = ((f32x4){(float)iv[0], (float)iv[1], (float)iv[2], (float)iv[3]} * cs[n] * rs[ai][m] + bv[n]) * 16.f;
                        w2[n] = q8x4_pack(__builtin_amdgcn_fmed3f(v[0], -127.f, 127.f), __builtin_amdgcn_fmed3f(v[1], -127.f, 127.f), __builtin_amdgcn_fmed3f(v[2], -127.f, 127.f), __builtin_amdgcn_fmed3f(v[3], -127.f, 127.f), 1.f); }
                    *(unsigned long long*)(base + (size_t)(row0 + ai * HALF + m * 16) * ldc + col0 + bj * HALF) = (unsigned long long)w2[0] | ((unsigned long long)w2[1] << 32); } }
    }
};
struct EpiI8 {
    static constexpr bool PERM = true, AFTER_DRAIN = false;
    bf16_t* O; int ldc; const float* bias; const float* sw; const float* sh; size_t split_stride;
    __device__ __forceinline__ void operator()(const f32x4 (&acc)[2][2][4][2], const Unit& u, int wr, int wc, int fr, int fq) const {
        typedef int i32x4 __attribute__((ext_vector_type(4)));
        { int t_ = threadIdx.x; asm volatile("" : "+v"(t_)); fr = t_ & 15; fq = (t_ >> 4) & 3; }
        const int row0 = u.pm * BM + wr * 64 + fr; int colt = u.pn * BM; const int t = split_stride ? (colt >> 10) : 0; bf16_t* base = O + (size_t)t * split_stride; colt -= t << 10;
        const int col0 = colt + wc * 32 + 8 * fq, bcol0 = u.pn * BM + wc * 32 + 8 * fq;
        float rs[2][4];
#pragma unroll
        for (int ai = 0; ai < 2; ++ai)
#pragma unroll
            for (int m = 0; m < 4; ++m) rs[ai][m] = sh[row0 + ai * HALF + m * 16];
        f32x4 bv_[2][2], cs_[2][2];
#pragma unroll
        for (int bj = 0; bj < 2; ++bj)
#pragma unroll
            for (int n = 0; n < 2; ++n) { bv_[bj][n] = bias ? *(const f32x4*)(bias + bcol0 + bj * HALF + 4 * n) : (f32x4){0.f, 0.f, 0.f, 0.f}; cs_[bj][n] = *(const f32x4*)(sw + bcol0 + bj * HALF + 4 * n); }
#pragma unroll
        for (int bj = 0; bj < 2; ++bj) { const f32x4 (&bv)[2] = bv_[bj]; const f32x4 (&cs)[2] = cs_[bj];
#pragma unroll
            for (int ai = 0; ai < 2; ++ai)
#pragma unroll
                for (int m = 0; m < 4; ++m) { u32x4 w;
#pragma unroll
                    for (int n = 0; n < 2; ++n) { const i32x4 iv = __builtin_bit_cast(i32x4, acc[ai][bj][m][n]);
                        const f32x4 v = (f32x4){(float)iv[0], (float)iv[1], (float)iv[2], (float)iv[3]} * cs[n] * rs[ai][m] + bv[n];
                        if (n == 0) { w.x = cvt_pk_bf16(v[0], v[1]); w.y = cvt_pk_bf16(v[2], v[3]); } else { w.z = cvt_pk_bf16(v[0], v[1]); w.w = cvt_pk_bf16(v[2], v[3]); } }
                    *(u32x4*)(base + (size_t)(row0 + ai * HALF + m * 16) * ldc + col0 + bj * HALF) = w; } }
    }
};
struct EpiRes {
    static constexpr bool PERM = true, AFTER_DRAIN = false;
    const float* X; float* O; int ldc;
    __device__ __forceinline__ void operator()(const f32x4 (&acc)[2][2][4][2], const Unit& u, int wr, int wc, int fr, int fq) const {
        const int row0 = u.pm * BM + wr * 64 + fr, col0 = u.pn * BM + wc * 32 + 8 * fq;
#pragma unroll
        for (int ai = 0; ai < 2; ++ai)
#pragma unroll
            for (int m = 0; m < 4; ++m) { const size_t ro = (size_t)(row0 + ai * HALF + m * 16) * ldc + col0;
#pragma unroll
                for (int bj = 0; bj < 2; ++bj)
#pragma unroll
                    for (int n = 0; n < 2; ++n) { const size_t off = ro + bj * HALF + n * 4; *(f32x4*)(O + off) = *(const f32x4*)(X + off) + acc[ai][bj][m][n]; } }
    }
};
struct EpiGateI8 {
    static constexpr bool PERM = true, AFTER_DRAIN = false;
    bf16_t* O; const signed char* Gt; const bf16_t* Add; int ldc; const float* sw; const float* sh;
    __device__ __forceinline__ void operator()(const f32x4 (&acc)[2][2][4][2], const Unit& u, int wr, int wc, int fr, int fq) const {
        typedef int i32x4 __attribute__((ext_vector_type(4)));
        const int row0 = u.pm * BM + wr * 64 + fr, col0 = u.pn * BM + wc * 32 + 8 * fq;
        f32x4 c0[2], c1[2]; float rs[2][4]; unsigned long long g[2][4][2]; u32x4 ad[2][4][2];
#pragma unroll
        for (int bj = 0; bj < 2; ++bj) { c0[bj] = *(const f32x4*)(sw + col0 + bj * HALF); c1[bj] = *(const f32x4*)(sw + col0 + bj * HALF + 4); }
#pragma unroll
        for (int ai = 0; ai < 2; ++ai)
#pragma unroll
            for (int m = 0; m < 4; ++m) { const int row = row0 + ai * HALF + m * 16; rs[ai][m] = sh[row];
#pragma unroll
                for (int bj = 0; bj < 2; ++bj) { const size_t ro = (size_t)row * ldc + col0 + bj * HALF; g[ai][m][bj] = *(const unsigned long long*)(Gt + ro); ad[ai][m][bj] = (u32x4){0u, 0u, 0u, 0u}; if (Add) ad[ai][m][bj] = *(const u32x4*)(Add + ro); } }
#pragma unroll
        for (int ai = 0; ai < 2; ++ai)
#pragma unroll
            for (int m = 0; m < 4; ++m) { const int row = row0 + ai * HALF + m * 16;
#pragma unroll
                for (int bj = 0; bj < 2; ++bj) { const size_t ro = (size_t)row * ldc + col0 + bj * HALF;
                    const i32x4 i0 = __builtin_bit_cast(i32x4, acc[ai][bj][m][0]), i1 = __builtin_bit_cast(i32x4, acc[ai][bj][m][1]);
                    const f32x4 v0 = (f32x4){(float)i0[0], (float)i0[1], (float)i0[2], (float)i0[3]} * c0[bj] * rs[ai][m], v1 = (f32x4){(float)i1[0], (float)i1[1], (float)i1[2], (float)i1[3]} * c1[bj] * rs[ai][m];
                    const unsigned gw[2] = {(unsigned)g[ai][m][bj], (unsigned)(g[ai][m][bj] >> 32)}, aw[4] = {ad[ai][m][bj].x, ad[ai][m][bj].y, ad[ai][m][bj].z, ad[ai][m][bj].w}; const float vv[8] = {v0[0], v0[1], v0[2], v0[3], v1[0], v1[1], v1[2], v1[3]};
                    unsigned o[4];
#pragma unroll
                    for (int i = 0; i < 4; ++i) { const float a = vv[2 * i] * sigmoidf_(q8f(gw[i >> 1], 2 * (i & 1))) + bflo(aw[i]), b = vv[2 * i + 1] * sigmoidf_(q8f(gw[i >> 1], 2 * (i & 1) + 1)) + bfhi(aw[i]); o[i] = cvt_pk_bf16(a, b); }
                    *(u32x4*)(O + ro) = (u32x4){o[0], o[1], o[2], o[3]}; } }
    }
};
struct EpiGates16I8 {
    static constexpr bool PERM = false, AFTER_DRAIN = false;
    float* Z; const float* bias; const float* sw; const float* sh;
    __device__ __forceinline__ void operator()(const f32x4 (&acc)[2][2][4][2], const Unit& u, int wr, int wc, int fr, int fq) const {
        typedef int i32x4 __attribute__((ext_vector_type(4)));
        if (wc != 0) return;
        const f32x4 bv = *(const f32x4*)(bias + 4 * fq), cs = *(const f32x4*)(sw + 4 * fq); const int row0 = u.pm * BM + wr * 64 + fr;
#pragma unroll
        for (int ai = 0; ai < 2; ++ai)
#pragma unroll
            for (int m = 0; m < 4; ++m) { const int row = row0 + ai * HALF + m * 16; const i32x4 iv = __builtin_bit_cast(i32x4, acc[ai][0][m][0]);
                *(f32x4*)(Z + (size_t)row * 16 + 4 * fq) = (f32x4){(float)iv[0], (float)iv[1], (float)iv[2], (float)iv[3]} * cs * sh[row] + bv; }
    }
};
struct EpiResB16 {
    static constexpr bool PERM = true, AFTER_DRAIN = false;
    const float* X; bf16_t* O; int ldc;
    __device__ __forceinline__ void operator()(const f32x4 (&acc)[2][2][4][2], const Unit& u, int wr, int wc, int fr, int fq) const {
        const int row0 = u.pm * BM + wr * 64 + fr, col0 = u.pn * BM + wc * 32 + 8 * fq;
        f32x4 x0[2][4][2], x1[2][4][2];
#pragma unroll
        for (int m = 0; m < 4; ++m) { const size_t ro = (size_t)(row0 + m * 16) * ldc + col0;
#pragma unroll
            for (int bj = 0; bj < 2; ++bj) { x0[0][m][bj] = *(const f32x4*)(X + ro + bj * HALF); x1[0][m][bj] = *(const f32x4*)(X + ro + bj * HALF + 4); } }
#pragma unroll
        for (int ai = 0; ai < 2; ++ai)
#pragma unroll
            for (int m = 0; m < 4; ++m) { const size_t ro = (size_t)(row0 + ai * HALF + m * 16) * ldc + col0, rn = ro + (size_t)HALF * ldc;
#pragma unroll
                for (int bj = 0; bj < 2; ++bj) { const f32x4 v0 = x0[ai][m][bj] + acc[ai][bj][m][0], v1 = x1[ai][m][bj] + acc[ai][bj][m][1];
                    u32x4 w; w.x = cvt_pk_bf16(v0[0], v0[1]); w.y = cvt_pk_bf16(v0[2], v0[3]); w.z = cvt_pk_bf16(v1[0], v1[1]); w.w = cvt_pk_bf16(v1[2], v1[3]);
                    *(u32x4*)(O + ro + bj * HALF) = w;
                    if (ai == 0) { x0[1][m][bj] = *(const f32x4*)(X + rn + bj * HALF); x1[1][m][bj] = *(const f32x4*)(X + rn + bj * HALF + 4); } } }
    }
};
struct EpiGates16 {
    static constexpr bool PERM = false, AFTER_DRAIN = false;
    float* Z; const float* bias;
    __device__ __forceinline__ void operator()(const f32x4 (&acc)[2][2][4][2], const Unit& u, int wr, int wc, int fr, int fq) const {
        if (wc != 0) return;
        const f32x4 bv = *(const f32x4*)(bias + 4 * fq); const int row0 = u.pm * BM + wr * 64 + fr;
#pragma unroll
        for (int ai = 0; ai < 2; ++ai)
#pragma unroll
            for (int m = 0; m < 4; ++m) *(f32x4*)(Z + (size_t)(row0 + ai * HALF + m * 16) * 16 + 4 * fq) = acc[ai][0][m][0] + bv;
    }
};
template <class Sched>
__device__ __forceinline__ void gemm_dual(PG8_LAS unsigned char* lds, const Gemm g0, const Gemm g1, const Sched& S, const signed char* Gm, const signed char* Gf, const float* sw, const float* sh, bf16_t* O, int ldc) {
    int tid_ = threadIdx.x; asm volatile("" : "+v"(tid_));
    const int tid = tid_, wid = __builtin_amdgcn_readfirstlane(tid >> 6), lane = tid & 63, wr = wid >> 2, wc = wid & 3, fr = lane & 15, fq = lane >> 4;
    const int K0 = g0.K, K1 = g1.K, nt0 = K0 / BK, nt1 = K1 / BK;
    unsigned vA0, vB0, vA1, vB1;
    { int R, C; stage_rc(tid * 16, R, C); const int Rb = (R & ~31) + perm32(R & 31);
      vA0 = (unsigned)(R * K0 + C) * 2u; vB0 = (unsigned)(Rb * K0 + C) * 2u; vA1 = (unsigned)(R * K1 + C) * 2u; vB1 = (unsigned)(Rb * K1 + C) * 2u; }
    const size_t kstep = (size_t)(BK * 2), hs0 = (size_t)HALF * K0 * 2, hs1 = (size_t)HALF * K1 * 2, ts0 = 2 * hs0, ts1 = 2 * hs1;
    const unsigned ldsw = (unsigned)wid * 1024u;
    const int aoff = lds_byte(wr * 64 + fr, fq * 8), boff = lds_byte(wc * 32 + fr, fq * 8);
#define PG8_SA(b, h) (((b) * 2 + (h)) * HTB)
#define PG8_SB(b, h) ((4 + (b) * 2 + (h)) * HTB)
#define PG8_STAGE(bufoff, gbase, voff, hstp) do { _Pragma("unroll") for (int _i = 0; _i < 2; ++_i) \
        __builtin_amdgcn_global_load_lds((const unsigned*)((const char*)(gbase) + (size_t)_i * ((hstp) >> 1) + (voff)), (PG8_LAS unsigned*)(lds + (bufoff) + ldsw + _i * 8192), 16, 0, 0); } while (0)
#define PG8_LDA(dst, b, h) do { _Pragma("unroll") for (int m = 0; m < 4; ++m) _Pragma("unroll") for (int k = 0; k < 2; ++k) dst[m][k] = *(const PG8_LAS bf16x8*)(lds + PG8_SA(b, h) + aoff + m * 2048 + k * 1024); } while (0)
#define PG8_LDB(dst, b, h) do { _Pragma("unroll") for (int n = 0; n < 2; ++n) _Pragma("unroll") for (int k = 0; k < 2; ++k) dst[n][k] = *(const PG8_LAS bf16x8*)(lds + PG8_SB(b, h) + boff + n * 2048 + k * 1024); } while (0)
#define PG8_MMA(md, ai, bj, At, Bt) do { __builtin_amdgcn_s_setprio(1); _Pragma("unroll") for (int m = 0; m < 4; ++m) _Pragma("unroll") for (int n = 0; n < 2; ++n) { \
        if constexpr ((md) == 2) { _Pragma("unroll") for (int k = 0; k < 2; ++k) acc[ai][bj][m][n] = __builtin_bit_cast(f32x4, __builtin_amdgcn_mfma_i32_16x16x64_i8(__builtin_bit_cast(v4i_t, Bt[n][k]), __builtin_bit_cast(v4i_t, At[m][k]), __builtin_bit_cast(v4i_t, acc[ai][bj][m][n]), 0, 0, 0)); } \
        else { _Pragma("unroll") for (int k = 0; k < 2; ++k) acc[ai][bj][m][n] = __builtin_amdgcn_mfma_f32_16x16x32_bf16(Bt[n][k], At[m][k], acc[ai][bj][m][n], 0, 0, 0); } } __builtin_amdgcn_s_setprio(0); } while (0)
#define PG8_WAIT_V(n) asm volatile("s_waitcnt vmcnt(" #n ")" ::: "memory")
#define PG8_WAIT_L(n) asm volatile("s_waitcnt lgkmcnt(" #n ")" ::: "memory")
#define PG8_BAR __builtin_amdgcn_s_barrier()
#define PG8_SCHED __builtin_amdgcn_sched_barrier(0)
#define PG8_KLOOP(md, nt, cA, cB, vA, vB, hs, nA, nB, nvA, nvB, nhs) do { _Pragma("nounroll") for (int t = 0; t < (nt); t += 2) { \
        const bool last = (t == (nt) - 2); \
        const char* a1 = (cA) + (size_t)(t + 1) * kstep; \
        const char* a2 = last ? (nA) : (cA) + (size_t)(t + 2) * kstep; const char* b2 = last ? (nB) : (cB) + (size_t)(t + 2) * kstep; \
        const char* a3 = a2 + kstep; const char* b3 = b2 + kstep; \
        const unsigned xA = last ? (nvA) : (vA), xB = last ? (nvB) : (vB); const size_t xh = last ? (nhs) : (hs); \
        PG8_LDB(B0, 0, 0); PG8_LDB(B1, 0, 1); PG8_SCHED; PG8_LDA(At, 0, 0); PG8_STAGE(PG8_SA(1, 1), a1 + (hs), vA, hs); \
        PG8_WAIT_V(8); PG8_WAIT_L(0); PG8_BAR; PG8_MMA(md, 0, 0, At, B0); PG8_MMA(md, 0, 1, At, B1); PG8_BAR; PG8_SCHED; \
        PG8_LDA(At, 0, 1); PG8_STAGE(PG8_SB(0, 0), b2, xB, xh); PG8_STAGE(PG8_SB(0, 1), b2 + xh, xB, xh); PG8_STAGE(PG8_SA(0, 0), a2, xA, xh); \
        PG8_WAIT_V(8); PG8_WAIT_L(0); PG8_BAR; PG8_MMA(md, 1, 0, At, B0); PG8_MMA(md, 1, 1, At, B1); PG8_BAR; PG8_SCHED; \
        PG8_LDB(B0, 1, 0); PG8_LDB(B1, 1, 1); PG8_SCHED; PG8_LDA(At, 1, 0); PG8_STAGE(PG8_SA(0, 1), a2 + xh, xA, xh); \
        PG8_WAIT_V(8); PG8_WAIT_L(0); PG8_BAR; PG8_MMA(md, 0, 0, At, B0); PG8_MMA(md, 0, 1, At, B1); PG8_BAR; PG8_SCHED; \
        PG8_LDA(At, 1, 1); PG8_STAGE(PG8_SB(1, 0), b3, xB, xh); PG8_STAGE(PG8_SB(1, 1), b3 + xh, xB, xh); PG8_STAGE(PG8_SA(1, 0), a3, xA, xh); \
        PG8_WAIT_V(8); PG8_WAIT_L(0); PG8_BAR; PG8_MMA(md, 1, 0, At, B0); PG8_MMA(md, 1, 1, At, B1); PG8_BAR; PG8_SCHED; } } while (0)
    Unit cur, nxt; int ui = 0;
    if (!S.next(0, cur)) return;
    f32x4 acc[2][2][4][2];
#pragma unroll
    for (int a = 0; a < 2; ++a)
#pragma unroll
        for (int b = 0; b < 2; ++b)
#pragma unroll
            for (int m = 0; m < 4; ++m)
#pragma unroll
                for (int n = 0; n < 2; ++n) acc[a][b][m][n] = (f32x4){0.f, 0.f, 0.f, 0.f};
    bf16x8 At[4][2], B0[2][2], B1[2][2];
    const char* cA0 = (const char*)g0.A + (size_t)cur.pm * ts0; const char* cB0 = (const char*)g0.Bt + (size_t)cur.pn * ts0;
    const char* cA1 = (const char*)g1.A + (size_t)cur.pm * ts1; const char* cB1 = (const char*)g1.Bt + (size_t)cur.pn * ts1;
    PG8_STAGE(PG8_SB(0, 0), cB0, vB0, hs0); PG8_STAGE(PG8_SB(0, 1), cB0 + hs0, vB0, hs0); PG8_STAGE(PG8_SA(0, 0), cA0, vA0, hs0); PG8_STAGE(PG8_SA(0, 1), cA0 + hs0, vA0, hs0);
    if (wr == 1) PG8_BAR;
    PG8_WAIT_V(2); PG8_BAR;
    PG8_STAGE(PG8_SB(1, 0), cB0 + kstep, vB0, hs0); PG8_STAGE(PG8_SA(1, 0), cA0 + kstep, vA0, hs0); PG8_STAGE(PG8_SB(1, 1), cB0 + hs0 + kstep, vB0, hs0);
    PG8_WAIT_V(6); PG8_BAR;
    typedef int i32x4 __attribute__((ext_vector_type(4)));
    for (;;) {
        const bool has_next = S.next(ui + 1, nxt);
        PG8_KLOOP(2, nt0, cA0, cB0, vA0, vB0, hs0, cA1, cB1, vA1, vB1, hs1);
        if (wr == 0) PG8_BAR;
        {
            int t_ = threadIdx.x; asm volatile("" : "+v"(t_));
            const int row0 = cur.pm * BM + wr * 64 + (t_ & 15), col0 = cur.pn * BM + wc * 32 + 8 * ((t_ >> 4) & 3);
            f32x4 c0[2], c1[2];
#pragma unroll
            for (int bj = 0; bj < 2; ++bj) { c0[bj] = *(const f32x4*)(sw + col0 + bj * HALF); c1[bj] = *(const f32x4*)(sw + col0 + bj * HALF + 4); }
#pragma unroll
            for (int ai = 0; ai < 2; ++ai) { float rs[4]; unsigned long long gm[4][2], gf[4][2];
#pragma unroll
                for (int m = 0; m < 4; ++m) { const int row = row0 + ai * HALF + m * 16; rs[m] = sh[row];
#pragma unroll
                    for (int bj = 0; bj < 2; ++bj) { const size_t ro = (size_t)row * ldc + col0 + bj * HALF; gm[m][bj] = *(const unsigned long long*)(Gm + ro); gf[m][bj] = *(const unsigned long long*)(Gf + ro); } }
#pragma unroll
                for (int m = 0; m < 4; ++m)
#pragma unroll
                    for (int bj = 0; bj < 2; ++bj) {
                        const unsigned mw[2] = {(unsigned)gm[m][bj], (unsigned)(gm[m][bj] >> 32)}, fw[2] = {(unsigned)gf[m][bj], (unsigned)(gf[m][bj] >> 32)};
#pragma unroll
                        for (int n = 0; n < 2; ++n) { const i32x4 iv = __builtin_bit_cast(i32x4, acc[ai][bj][m][n]); const f32x4 cs = n ? c1[bj] : c0[bj]; f32x4 v;
#pragma unroll
                            for (int i = 0; i < 4; ++i) { const float ea = __builtin_amdgcn_exp2f(q8f(mw[n], i) * -1.4426950408889634f), eb = __builtin_amdgcn_exp2f(q8f(fw[n], i) * -1.4426950408889634f);
                                v[i] = (float)iv[i] * cs[i] * rs[m] * ((1.f + eb) * __builtin_amdgcn_rcpf(1.f + ea)); }
                            acc[ai][bj][m][n] = v; } } }
        }
        if (wr == 1) PG8_BAR;
        const char* nA = has_next ? (const char*)g0.A + (size_t)nxt.pm * ts0 : cA0; const char* nB = has_next ? (const char*)g0.Bt + (size_t)nxt.pn * ts0 : cB0;
        PG8_KLOOP(0, nt1, cA1, cB1, vA1, vB1, hs1, nA, nB, vA0, vB0, hs0);
        if (wr == 0) PG8_BAR;
        {
            int t_ = threadIdx.x; asm volatile("" : "+v"(t_));
            const int row0 = cur.pm * BM + wr * 64 + (t_ & 15), col0 = cur.pn * BM + wc * 32 + 8 * ((t_ >> 4) & 3);
            unsigned long long gf[2][4][2];
#pragma unroll
            for (int ai = 0; ai < 2; ++ai)
#pragma unroll
                for (int m = 0; m < 4; ++m)
#pragma unroll
                    for (int bj = 0; bj < 2; ++bj) gf[ai][m][bj] = *(const unsigned long long*)(Gf + (size_t)(row0 + ai * HALF + m * 16) * ldc + col0 + bj * HALF);
#pragma unroll
            for (int ai = 0; ai < 2; ++ai)
#pragma unroll
                for (int m = 0; m < 4; ++m)
#pragma unroll
                    for (int bj = 0; bj < 2; ++bj) { const unsigned fw[2] = {(unsigned)gf[ai][m][bj], (unsigned)(gf[ai][m][bj] >> 32)}; const f32x4 v0 = acc[ai][bj][m][0], v1 = acc[ai][bj][m][1]; u32x4 w;
                        w.x = cvt_pk_bf16(v0[0] * sigmoidf_(q8f(fw[0], 0)), v0[1] * sigmoidf_(q8f(fw[0], 1))); w.y = cvt_pk_bf16(v0[2] * sigmoidf_(q8f(fw[0], 2)), v0[3] * sigmoidf_(q8f(fw[0], 3)));
                        w.z = cvt_pk_bf16(v1[0] * sigmoidf_(q8f(fw[1], 0)), v1[1] * sigmoidf_(q8f(fw[1], 1))); w.w = cvt_pk_bf16(v1[2] * sigmoidf_(q8f(fw[1], 2)), v1[3] * sigmoidf_(q8f(fw[1], 3)));
                        *(u32x4*)(O + (size_t)(row0 + ai * HALF + m * 16) * ldc + col0 + bj * HALF) = w; }
        }
        if (!has_next) break;
#pragma unroll
        for (int a = 0; a < 2; ++a)
#pragma unroll
            for (int b = 0; b < 2; ++b)
#pragma unroll
                for (int m = 0; m < 4; ++m)
#pragma unroll
                    for (int n = 0; n < 2; ++n) acc[a][b][m][n] = (f32x4){0.f, 0.f, 0.f, 0.f};
        cur = nxt; cA0 = nA; cB0 = nB; cA1 = (const char*)g1.A + (size_t)cur.pm * ts1; cB1 = (const char*)g1.Bt + (size_t)cur.pn * ts1; ++ui;
        if (wr == 1) PG8_BAR;
    }
    PG8_WAIT_V(0);
    PG8_BAR;
#undef PG8_SA
#undef PG8_SB
#undef PG8_STAGE
#undef PG8_LDA
#undef PG8_LDB
#undef PG8_MMA
#undef PG8_WAIT_V
#undef PG8_WAIT_L
#undef PG8_BAR
#undef PG8_SCHED
#undef PG8_KLOOP
}
}
namespace fox {
using bf16 = __hip_bfloat16;
constexpr int D = 128, SQ = 8192, SKV = 8192, QOFF = 0, WINDOW = SKV, PITCH = 1024;
constexpr float THR = 8.f; constexpr bool WSKIP = false;
constexpr float SCALE = 0.08838834764831845f;
constexpr int NW = 8, QBLK = 32, KVBLK = 64, QB = NW * QBLK;
constexpr int SHM_V = KVBLK * D * 2, SHM_K = KVBLK * D * 2;
constexpr int LDS_CS = 2 * SHM_V + 2 * SHM_K + NW * 64 * 4; constexpr int LDS_BYTES = LDS_CS + 2 * 64 * 4;

typedef short bf16x8 __attribute__((ext_vector_type(8)));
typedef short s16x4 __attribute__((ext_vector_type(4)));
typedef float f32x16 __attribute__((ext_vector_type(16)));
typedef float f32x4 __attribute__((ext_vector_type(4)));
typedef unsigned u32x4 __attribute__((ext_vector_type(4)));
template <class A, class Bt> struct same_t { static constexpr bool v = false; };
template <class A> struct same_t<A, A> { static constexpr bool v = true; };

#define KSWZ(row, colB) ((row) * 256 + ((colB) ^ (((row) & 7) << 4)))
#define SBAR() __builtin_amdgcn_sched_barrier(0)
__device__ __forceinline__ int v_st(int k, int c) { const int kk = (k & ~0xC) | ((k & 4) << 1) | ((k & 8) >> 1); return ((kk >> 3) * 4 + (c >> 5)) * 512 + ((kk & 7) * 32 + (c & 31)) * 2; }
__device__ __forceinline__ int v_rd_base(int lane) { return ((lane & 3) << 3) | (((lane >> 2) & 3) << 6) | (((lane >> 4) & 1) << 5) | (((lane >> 5) & 1) << 8); }
constexpr int v_rd_off(int d0, int ks, int half) { return d0 * 512 + ks * 4096 + half * 2048; }
__device__ __forceinline__ int crow(int r, int hi) { return (r & 3) + 8 * (r >> 2) + 4 * hi; }
__device__ __forceinline__ unsigned cvtpk(float lo, float hi) {
    unsigned r; asm volatile("v_cvt_pk_bf16_f32 %0, %1, %2" : "=v"(r) : "v"(lo), "v"(hi)); return r;
}
__device__ __forceinline__ bf16x8 pack8(f32x4 a, f32x4 b) {
    u32x4 w = {cvtpk(a[0], a[1]), cvtpk(a[2], a[3]), cvtpk(b[0], b[1]), cvtpk(b[2], b[3])};
    return *reinterpret_cast<bf16x8*>(&w);
}
template <class T> __device__ __forceinline__ bf16x8 load8(const T* p) {
    if constexpr (same_t<T, float>::v) { return pack8(*(const f32x4*)p, *(const f32x4*)(p + 4)); }
    else { return *reinterpret_cast<const bf16x8*>(p); }
}
__device__ __forceinline__ void mask_tile(f32x16& p0, f32x16& p1, int dq, unsigned W) {
    const float NEG = -__builtin_inff();
#pragma unroll
    for (int r = 0; r < 16; ++r) {
        const int c = (r & 3) + 8 * (r >> 2);
        if ((unsigned)(dq - c) >= W) p0[r] = NEG;
        if ((unsigned)(dq - c - 32) >= W) p1[r] = NEG;
    }
}
__device__ __forceinline__ void partialSM(f32x16& p0, f32x16& p1, float& m_reg, float& mn, float& alpha) {
    float pmax = p0[0]; for (int r = 1; r < 16; ++r) pmax = fmaxf(pmax, p0[r]); for (int r = 0; r < 16; ++r) pmax = fmaxf(pmax, p1[r]);
    { auto rr = __builtin_amdgcn_permlane32_swap(__float_as_uint(pmax), __float_as_uint(pmax), false, false);
      pmax = fmaxf(__uint_as_float(rr[0]), __uint_as_float(rr[1])); }
    constexpr float C2 = 1.4426950408889634f * SCALE;
    if (__builtin_expect(__all((pmax - m_reg) * SCALE <= THR), 1)) { mn = m_reg; alpha = 1.f; }
    else { mn = fmaxf(m_reg, pmax); alpha = __builtin_amdgcn_exp2f((m_reg - mn) * C2); m_reg = mn; }
    const float mnL = -mn * C2;
    for (int r = 0; r < 16; ++r) p0[r] = fmaf(p0[r], C2, mnL); for (int r = 0; r < 16; ++r) p1[r] = fmaf(p1[r], C2, mnL);
    for (int r = 0; r < 16; ++r) p0[r] = __builtin_amdgcn_exp2f(p0[r]);
}
__device__ __forceinline__ void finishSM(f32x16& p0, f32x16& p1, float alpha, float& l_reg, bf16x8& pa0, bf16x8& pa1, bf16x8& pa2, bf16x8& pa3) {
    for (int r = 0; r < 16; ++r) p1[r] = __builtin_amdgcn_exp2f(p1[r]);
    float ps = 0; for (int r = 0; r < 16; ++r) ps += p0[r]; for (int r = 0; r < 16; ++r) ps += p1[r];
    { auto rr = __builtin_amdgcn_permlane32_swap(__float_as_uint(ps), __float_as_uint(ps), false, false);
      ps = __uint_as_float(rr[0]) + __uint_as_float(rr[1]); }
    l_reg = l_reg * alpha + ps;
#define PK4(P, B_, OUT) do { unsigned a0 = cvtpk(P[B_+0], P[B_+1]), a1 = cvtpk(P[B_+2], P[B_+3]);                          \
        unsigned b0 = cvtpk(P[B_+4], P[B_+5]), b1 = cvtpk(P[B_+6], P[B_+7]);                                             \
        auto r0 = __builtin_amdgcn_permlane32_swap(a0, b0, false, false); auto r1 = __builtin_amdgcn_permlane32_swap(a1, b1, false, false); \
        u32x4 w = {r0[0], r1[0], r0[1], r1[1]}; OUT = *reinterpret_cast<bf16x8*>(&w); } while (0)
    PK4(p0, 0, pa0); PK4(p0, 8, pa1); PK4(p1, 0, pa2); PK4(p1, 8, pa3);
#undef PK4
}
template <int KB, bool SK>
__device__ __forceinline__ void qkt(f32x16& p0, f32x16& p1, const char* K_lds, int r32, int hi, const bf16x8* qr, bool act, const float* cs_lds) {
    if (SK && !act) { const float NEG = -__builtin_inff();
#pragma unroll
        for (int r = 0; r < 16; ++r) { p0[r] = NEG; p1[r] = NEG; } return; }
    { const float* ck_ = cs_lds + KB * 64 + 4 * hi;
#pragma unroll
      for (int g_ = 0; g_ < 4; ++g_) { const f32x4 c0_ = *(const f32x4*)(ck_ + 8 * g_), c1_ = *(const f32x4*)(ck_ + 32 + 8 * g_);
#pragma unroll
          for (int i_ = 0; i_ < 4; ++i_) { p0[4 * g_ + i_] = c0_[i_]; p1[4 * g_ + i_] = c1_[i_]; } } }
    const char* kb[4];
#pragma unroll
    for (int dd = 0; dd < 4; ++dd) kb[dd] = K_lds + KB * SHM_K + KSWZ(r32, (dd * 16 + hi * 8) * 2);
#pragma unroll
    for (int d0 = 0; d0 < 8; ++d0) { const char* a = kb[d0 & 3] + (d0 >> 2) * 128;
        bf16x8 b0 = *reinterpret_cast<const bf16x8*>(a);
        bf16x8 b1 = *reinterpret_cast<const bf16x8*>(a + 32 * 256);
        p0 = __builtin_amdgcn_mfma_f32_32x32x16_bf16(b0, qr[d0], p0, 0, 0, 0);
        p1 = __builtin_amdgcn_mfma_f32_32x32x16_bf16(b1, qr[d0], p1, 0, 0, 0); }
}
template <int VB, bool SK>
__device__ __forceinline__ void pv_tile(f32x16* o, int vb0, bf16x8 pa0, bf16x8 pa1, bf16x8 pa2, bf16x8 pa3, bool act) {
    if (SK && !act) return;
#define TRRD(dst, off) asm volatile("ds_read_b64_tr_b16 %0, %1 offset:%2" : "=&v"(dst) : "v"(vb0), "i"(off) : "memory")
#define PV_D0(d0) do { s16x4 l0, l1, l2, l3, h0, h1, h2, h3; constexpr int b_ = VB * SHM_V + v_rd_off(d0, 0, 0);     \
        TRRD(l0, b_); TRRD(h0, b_ + 2048); TRRD(l1, b_ + 4096); TRRD(h1, b_ + 6144); TRRD(l2, b_ + 8192); TRRD(h2, b_ + 10240); TRRD(l3, b_ + 12288); TRRD(h3, b_ + 14336); \
        asm volatile("s_waitcnt lgkmcnt(0)" ::: "memory"); SBAR();                 \
        o[d0] = __builtin_amdgcn_mfma_f32_32x32x16_bf16(pa0, (bf16x8){l0[0], l0[1], l0[2], l0[3], h0[0], h0[1], h0[2], h0[3]}, o[d0], 0, 0, 0);   \
        o[d0] = __builtin_amdgcn_mfma_f32_32x32x16_bf16(pa1, (bf16x8){l1[0], l1[1], l1[2], l1[3], h1[0], h1[1], h1[2], h1[3]}, o[d0], 0, 0, 0);   \
        o[d0] = __builtin_amdgcn_mfma_f32_32x32x16_bf16(pa2, (bf16x8){l2[0], l2[1], l2[2], l2[3], h2[0], h2[1], h2[2], h2[3]}, o[d0], 0, 0, 0);   \
        o[d0] = __builtin_amdgcn_mfma_f32_32x32x16_bf16(pa3, (bf16x8){l3[0], l3[1], l3[2], l3[3], h3[0], h3[1], h3[2], h3[3]}, o[d0], 0, 0, 0); } while (0)
    PV_D0(0); PV_D0(1); PV_D0(2); PV_D0(3);
#undef PV_D0
#undef TRRD
}

template <class TIn> struct FoxBases { const TIn* K; const TIn* V; const float* CS; };
template <class TIn, class TOut> struct BlockRef { const TIn* Q; unsigned kv; unsigned cs; int P0; int jlo; };
template <class TIn> struct Seam {
    bf16x8 qr[8];
    bf16x8 st_v0, st_v1, st_k0, st_k1; float st_c; f32x4 sf0, sf1, sf2, sf3;
    f32x4 tq[16];
};
__device__ __forceinline__ int swa_jlo(int P0, int W) { const int lowk = P0 - W + 1; return lowk > 0 ? lowk / KVBLK : 0; }
#define ROW(p, k0, rr) ((p) + (size_t)(k0) * PITCH + (((rr) == sr) ? ro0 : ro1))
#define VMW() asm volatile("s_waitcnt vmcnt(0)" ::: "memory")
#define VMWN(n) asm volatile("s_waitcnt vmcnt(%0)" :: "i"(n) : "memory")
#define SLOAD_H(Kp, Vp, Cp, k0) do { if (tid < 64) S.st_c = (Cp)[(k0) + tid]; S.st_v0 = load8<TIn>(ROW(Vp, k0, sr)); S.st_v1 = load8<TIn>(ROW(Vp, k0, 32 + sr));              \
                         S.st_k0 = load8<TIn>(ROW(Kp, k0, sr)); S.st_k1 = load8<TIn>(ROW(Kp, k0, 32 + sr)); } while (0)
#define SWRITE_HK(bf) do { if (tid < 64) cs_lds[(bf) * 64 + tid] = S.st_c; *(bf16x8*)(K_lds + (bf) * SHM_K + kws) = S.st_k0; *(bf16x8*)(K_lds + (bf) * SHM_K + kws + 32 * 256) = S.st_k1; } while (0)
#define SWRITE_HV(bf) do { *(bf16x8*)(V_lds + (bf) * SHM_V + vst0) = S.st_v0; *(bf16x8*)(V_lds + (bf) * SHM_V + vst1) = S.st_v1; } while (0)
#define SWRITE_H(bf) do { SWRITE_HV(bf); SWRITE_HK(bf); } while (0)
#define SLOAD_F(p, k0) do { S.sf0 = *(const f32x4*)ROW(p, k0, sr); S.sf1 = *(const f32x4*)(ROW(p, k0, sr) + 4);                \
                            S.sf2 = *(const f32x4*)ROW(p, k0, 32 + sr); S.sf3 = *(const f32x4*)(ROW(p, k0, 32 + sr) + 4); } while (0)
#define SWRITE_KF(bf) do { *(bf16x8*)(K_lds + (bf) * SHM_K + kws) = pack8(S.sf0, S.sf1); *(bf16x8*)(K_lds + (bf) * SHM_K + kws + 32 * 256) = pack8(S.sf2, S.sf3); } while (0)
#define SWRITE_VF(bf) do { *(bf16x8*)(V_lds + (bf) * SHM_V + vst0) = pack8(S.sf0, S.sf1); *(bf16x8*)(V_lds + (bf) * SHM_V + vst1) = pack8(S.sf2, S.sf3); } while (0)
template <class TIn, class TOut>
__device__ __forceinline__ void causal_swa_prime(const FoxBases<TIn>& FB, const BlockRef<TIn, TOut>& cur, int W, char* lds, Seam<TIn>& S) {
    constexpr bool F32 = same_t<TIn, float>::v;
    const int tid = threadIdx.x, wid = __builtin_amdgcn_readfirstlane(tid >> 6), lane = tid & 63, r32 = lane & 31, hi = lane >> 5;
    const int sr = tid >> 4, sc = (tid & 15) * 8, kws = KSWZ(sr, sc * 2); const unsigned ro0 = (unsigned)(sr * PITCH + sc), ro1 = ro0 + 32u * PITCH; char* K_lds = lds + 2 * SHM_V; float* cs_lds = (float*)(lds + LDS_CS);
    const int kb0 = cur.P0 + QB - KVBLK;
    for (int d0 = 0; d0 < 8; ++d0) S.qr[d0] = load8<TIn>(cur.Q + (unsigned)((wid * QBLK + r32) * PITCH) + d0 * 16 + hi * 8);
    if constexpr (F32) { SLOAD_F((const float*)(FB.K + cur.kv), kb0); VMW(); SWRITE_KF(0); SBAR(); SLOAD_F((const float*)(FB.V + cur.kv), kb0); }
    else { SLOAD_H(FB.K + cur.kv, FB.V + cur.kv, FB.CS + cur.cs, kb0); VMW(); SWRITE_HK(0); }
    __syncthreads();
}
template <class TIn, class TOut>
__device__ __forceinline__ void causal_swa_block(const FoxBases<TIn>& FB, const BlockRef<TIn, TOut>& cur, const BlockRef<TIn, TOut>& nxt, int skv, int W, char* lds, Seam<TIn>& S) {
    constexpr bool F32 = same_t<TIn, float>::v;
    const int tid = threadIdx.x, wid = __builtin_amdgcn_readfirstlane(tid >> 6), lane = tid & 63, r32 = lane & 31, hi = lane >> 5;
    const int j_lo = cur.jlo;
    int j_hi = (cur.P0 + QB - 1) / KVBLK + 1; if (j_hi > skv / KVBLK) j_hi = skv / KVBLK;
    const int NT = j_hi - j_lo;
    const int kbn = nxt.P0 + QB - KVBLK;
    const int qlo = cur.P0 + wid * QBLK, qm = qlo + r32 - 4 * hi;
    char* V_lds = lds; char* K_lds = lds + 2 * SHM_V; float* cs_lds = (float*)(lds + LDS_CS);
    float* ws = (float*)(lds + 2 * SHM_V + 2 * SHM_K) + wid * 64; float* li_l = ws, * al_l = ws + 32;
    float m_reg = -1e30f, l_reg = 0; f32x16 o[4] = {};
    const int sr = tid >> 4, sc = (tid & 15) * 8, vst0 = v_st(sr, sc), vst1 = v_st(32 + sr, sc), kws = KSWZ(sr, sc * 2); const unsigned ro0 = (unsigned)(sr * PITCH + sc), ro1 = ro0 + 32u * PITCH;
    const int vb0 = (int)(uintptr_t)V_lds + v_rd_base(lane);
    const TIn* Kh = FB.K + cur.kv; const TIn* Vh = FB.V + cur.kv; const float* Ch = FB.CS + cur.cs;
#define RESC(a) do { if (__any((a) < 1.f)) { if (hi == 0) al_l[r32] = (a); asm volatile("s_waitcnt lgkmcnt(0)" ::: "memory");              \
                     for (int d_ = 0; d_ < 4; ++d_) for (int r = 0; r < 16; ++r) o[d_][r] *= al_l[crow(r, hi)]; } } while (0)
#define KBASE(t) ((j_hi - 1 - (t)) * KVBLK)
#define ACT(t) (KBASE(t) <= qlo + QBLK - 1 && KBASE(t) + KVBLK - 1 >= qlo - W + 1)
#define MASKT(P0_, P1_, t) do { const int kb_ = KBASE(t); if ((!SK || ACT(t)) && (kb_ + KVBLK - 1 > qlo || kb_ <= qlo + QBLK - 1 - W)) mask_tile(P0_, P1_, qm - kb_, (unsigned)W); } while (0)
    constexpr int NQL = F32 ? 16 : 8;
    constexpr bool SK = WSKIP && !F32;
#define SEAM_K0() do { VMWN(NQL); if constexpr (F32) { SWRITE_KF(0); SBAR(); SLOAD_F((const float*)(FB.V + nxt.kv), kbn); } else { SWRITE_HK(0); } SBAR(); } while (0)
    f32x16 pA0, pA1, pB0, pB1; float mnA, mnB, alA, alB; bf16x8 pa0, pa1, pa2, pa3;
    if constexpr (F32) { VMW(); SWRITE_VF(0); SBAR(); } else { SWRITE_HV(0); SBAR(); }
    if (NT > 1) { if constexpr (F32) SLOAD_F((const float*)Kh, KBASE(1)); else SLOAD_H(Kh, Vh, Ch, KBASE(1)); }
    SBAR(); qkt<0, SK>(pA0, pA1, K_lds, r32, hi, S.qr, ACT(0), cs_lds);
    if constexpr (F32) { if (NT > 1) { VMW(); SWRITE_KF(1); SBAR(); SLOAD_F((const float*)Vh, KBASE(1)); } }
    MASKT(pA0, pA1, 0); partialSM(pA0, pA1, m_reg, mnA, alA);
    if (NT > 1) { VMW(); if constexpr (F32) { SWRITE_VF(1); SBAR(); if (NT > 2) SLOAD_F((const float*)Kh, KBASE(2)); } else SWRITE_H(1); }
    __syncthreads();
#define HALF_STEP(PX0, PX1, mnX, alX, PY0, PY1, alY, t, KB, VB, SB) do {                                                      \
        SBAR(); qkt<KB, SK>(PX0, PX1, K_lds, r32, hi, S.qr, ACT(t), cs_lds);                                             \
        finishSM(PY0, PY1, alY, l_reg, pa0, pa1, pa2, pa3); SBAR();                                                           \
        if ((t) + 1 < NT) { if constexpr (F32) { VMW(); SWRITE_KF(SB); SBAR(); SLOAD_F((const float*)Vh, KBASE((t) + 1)); }  \
                            else { SLOAD_H(Kh, Vh, Ch, KBASE((t) + 1)); } SBAR(); }                                               \
        pv_tile<VB, SK>(o, vb0, pa0, pa1, pa2, pa3, ACT((t) - 1)); MASKT(PX0, PX1, (t)); partialSM(PX0, PX1, m_reg, mnX, alX);                                        \
        __syncthreads();                                                                                                      \
        if ((t) + 1 < NT) { VMW(); if constexpr (F32) { SWRITE_VF(SB); SBAR(); if ((t) + 2 < NT) SLOAD_F((const float*)Kh, KBASE((t) + 2)); } \
                            else { SWRITE_H(SB); } }                                                                          \
        RESC(alX); __syncthreads(); } while (0)
    for (int t = 1; t + 1 < NT; t += 2) {
        HALF_STEP(pB0, pB1, mnB, alB, pA0, pA1, alA, t, 1, 0, 0);
        HALF_STEP(pA0, pA1, mnA, alA, pB0, pB1, alB, t + 1, 0, 1, 1);
    }
    const bool even = (NT & 1) == 0;
    if (even) { SBAR(); qkt<1, SK>(pB0, pB1, K_lds, r32, hi, S.qr, ACT(NT - 1), cs_lds); SBAR(); }
#define QROW(e) (nxt.Q + (unsigned)((wid * QBLK + r32) * PITCH) + ((e) >> 1) * 16 + hi * 8 + ((e) & 1) * 4)
    if constexpr (F32) { SLOAD_F((const float*)(FB.K + nxt.kv), kbn); SBAR();
#pragma unroll
        for (int e = 0; e < 8; ++e) S.tq[e] = *(const f32x4*)QROW(e); }
    else { SLOAD_H(FB.K + nxt.kv, FB.V + nxt.kv, FB.CS + nxt.cs, kbn); SBAR();
#pragma unroll
        for (int d0 = 0; d0 < 8; ++d0) S.qr[d0] = load8<TIn>(nxt.Q + (unsigned)((wid * QBLK + r32) * PITCH) + d0 * 16 + hi * 8); }
    SBAR();
    finishSM(pA0, pA1, alA, l_reg, pa0, pa1, pa2, pa3); SBAR();
    if constexpr (F32) {
#pragma unroll
        for (int e = 8; e < 16; ++e) S.tq[e] = *(const f32x4*)QROW(e); SBAR(); }
#undef QROW
    pv_tile<0, SK>(o, vb0, pa0, pa1, pa2, pa3, ACT(even ? NT - 2 : NT - 1));
    if (even) { MASKT(pB0, pB1, NT - 1); partialSM(pB0, pB1, m_reg, mnB, alB); __syncthreads(); RESC(alB);
        finishSM(pB0, pB1, alB, l_reg, pa0, pa1, pa2, pa3); SBAR(); pv_tile<1, SK>(o, vb0, pa0, pa1, pa2, pa3, ACT(NT - 1)); }
    SBAR(); SEAM_K0();
    if (hi == 0) li_l[r32] = l_reg; asm volatile("s_waitcnt lgkmcnt(0)" ::: "memory");
    float rli[16];
#pragma unroll
    for (int r = 0; r < 16; ++r) rli[r] = __builtin_amdgcn_rcpf(li_l[crow(r, hi)]);
    TOut* Ow = (TOut*)cur.Q + (unsigned)((wid * QBLK) * PITCH);
#pragma unroll
    for (int r = 0; r < 16; ++r) { const int orow = crow(r, hi);
#pragma unroll
        for (int d0 = 0; d0 < 4; ++d0) { const float v = o[d0][r] * rli[r];
            if constexpr (same_t<TOut, float>::v) { Ow[(unsigned)(orow * PITCH) + d0 * 32 + r32] = v; }
            else { const float vn = __shfl_xor(v, 1);
                   if ((r32 & 1) == 0) *(unsigned*)(Ow + (unsigned)(orow * PITCH) + d0 * 32 + r32) = cvtpk(v, vn); } } }
    if constexpr (F32) {
#pragma unroll
        for (int d0 = 0; d0 < 8; ++d0) S.qr[d0] = pack8(S.tq[2 * d0], S.tq[2 * d0 + 1]); }
    __syncthreads();
#undef RESC
#undef KBASE
#undef ACT
#undef MASKT
#undef SEAM_K0
#undef HALF_STEP
}
#undef ROW
#undef VMW
#undef VMWN
#undef SLOAD_H
#undef SWRITE_HK
#undef SWRITE_HV
#undef SWRITE_H
#undef SLOAD_F
#undef SWRITE_KF
#undef SWRITE_VF

}
namespace fox {
constexpr float SKIP_LOG = 12.f;
__device__ __forceinline__ BlockRef<bf16, bf16> mkref(int b, int n, const bf16* Q, const int* JLO) {
    const int h = 7 - (n >> 5), qb = 31 - (n & 31), bh = b * 8 + h; const unsigned base = (unsigned)b * SKV * PITCH + (unsigned)h * D;
    BlockRef<bf16, bf16> r; r.Q = Q + base + (size_t)qb * QB * PITCH; r.kv = base; r.cs = (unsigned)bh * SKV; r.P0 = qb * QB;
    r.jlo = JLO[bh * 32 + qb];
    return r;
}
__device__ __forceinline__ void jlo_table(const float* CS, const float* DQK, const float* qg, const float* kg, int* JLO, int gw, int NGW, int lane) {
    float gq = fmaxf(fabsf(qg[lane]), fabsf(qg[64 + lane])), gk = fmaxf(fabsf(kg[lane]), fabsf(kg[64 + lane]));
#pragma unroll
    for (int o = 1; o < 64; o <<= 1) { gq = fmaxf(gq, __shfl_xor(gq, o)); gk = fmaxf(gk, __shfl_xor(gk, o)); }
    const float qkmax = 128.f * gq * gk;
    for (int i = gw; i < 64 * 32; i += NGW) { const int bh = i >> 5, qb = i & 31, b = bh >> 3, h = bh & 7; const float* cs = CS + (size_t)bh * SKV;
        float dmin = 3.4e38f;
#pragma unroll
        for (int r = 0; r < 4; ++r) dmin = fminf(dmin, DQK[((size_t)b * SKV + qb * QB + 64 * r + lane) * 8 + h]);
#pragma unroll
        for (int o = 1; o < 64; o <<= 1) dmin = fminf(dmin, __shfl_xor(dmin, o));
        dmin = fmaxf(dmin - 0.01f * fabsf(dmin) - 0.01f, -qkmax);
        const float thr = cs[qb * QB] - qkmax + dmin - SKIP_LOG * 11.313708498984761f; const int nt = 4 * qb;
        const bool c0 = lane < nt && cs[64 * lane + 63] < thr, c1 = lane + 64 < nt && cs[64 * (lane + 64) + 63] < thr;
        const int j = __popcll(__ballot(c0)) + __popcll(__ballot(c1));
        if (lane == 0) JLO[i] = j; }
}
__device__ __forceinline__ int fetch_ticket(unsigned* Qw, int xcc) {
    for (int s = 0; s < 8; ++s) { const int b = (xcc + s) & 7; const unsigned n = __hip_atomic_fetch_add(Qw + 64 * b, 1u, __ATOMIC_RELAXED, __HIP_MEMORY_SCOPE_AGENT); if (n < 256u) return b * 256 + (int)n; }
    return 1 << 20;
}
__device__ __forceinline__ void phase(char* lds, const bf16* Q, const bf16* K, const bf16* V, bf16* O, const float* CS, const int* JLO, unsigned* Qw, int xcc, unsigned* done = nullptr) {
    const int tid = threadIdx.x; const FoxBases<bf16> FB{K, V, CS}; (void)O;
    volatile int* tk = (volatile int*)(lds + LDS_BYTES);
    __syncthreads();
    if (tid == 0) { tk[0] = fetch_ticket(Qw, xcc); tk[1] = fetch_ticket(Qw, xcc); }
    __syncthreads();
    int n0 = __builtin_amdgcn_readfirstlane(tk[0]), n1 = __builtin_amdgcn_readfirstlane(tk[1]);
    if (n0 >= 2048) return;
    BlockRef<bf16, bf16> cur = mkref(n0 >> 8, n0 & 255, Q, JLO);
    Seam<bf16> S;
    causal_swa_prime<bf16, bf16>(FB, cur, WINDOW, lds, S);
    for (;;) {
        const bool last = n1 >= 2048;
        const BlockRef<bf16, bf16> nxt = last ? cur : mkref(n1 >> 8, n1 & 255, Q, JLO);
        if (tid == 0 && !last) tk[0] = fetch_ticket(Qw, xcc);
        causal_swa_block<bf16, bf16>(FB, cur, nxt, SKV, WINDOW, lds, S);
        if (done && tid == 0) __hip_atomic_fetch_add(done, 1u, __ATOMIC_RELAXED, __HIP_MEMORY_SCOPE_AGENT);
        if (last) break;
        cur = nxt; n1 = __builtin_amdgcn_readfirstlane(tk[0]);
        __syncthreads();
    }
}
}
__device__ __forceinline__ int sortable(float f) { int i = __builtin_bit_cast(int, f); return i ^ ((i >> 31) & 0x7fffffff); }
__device__ __forceinline__ float unsortable(int i) { return __builtin_bit_cast(float, i ^ ((i >> 31) & 0x7fffffff)); }
__device__ __forceinline__ int med3i(int a, int b, int c) { int r; asm("v_med3_i32 %0, %1, %2, %3" : "=v"(r) : "v"(a), "v"(b), "v"(c)); return r; }
__device__ __forceinline__ void ins16(int (&t)[16], int x) {
#pragma unroll
    for (int i = 15; i >= 1; --i) t[i] = med3i(t[i - 1], t[i], x);
    t[0] = t[0] > x ? t[0] : x;
}
struct P9Args { const bf16raw* QH; const bf16raw* SKB; unsigned short* IDS; float* GW; };
constexpr int P9_KP = 136;
__device__ __forceinline__ void p9_half(const P9Args& a, const LAS bf16raw* SK, size_t tok, int h, int c, int m32, int hh, int (&t)[16]) {
    bf16x8 bq[8];
#pragma unroll
    for (int kk = 0; kk < 8; ++kk) bq[kk] = *(const bf16x8*)(a.QH + tok * 2048 + h * 256 + c * 128 + 16 * kk + 8 * hh);
#pragma unroll
    for (int i = 0; i < 16; ++i) t[i] = (int)0x80000000;
#pragma unroll
    for (int kt = 0; kt < 4; ++kt) {
        f32x16 acc;
#pragma unroll
        for (int r = 0; r < 16; ++r) acc[r] = 0.f;
#pragma unroll
        for (int kk = 0; kk < 8; ++kk) { const bf16x8 af = *(const LAS bf16x8*)(SK + (32 * kt + m32) * P9_KP + 16 * kk + 8 * hh);
            acc = __builtin_amdgcn_mfma_f32_32x32x16_bf16(af, bq[kk], acc, 0, 0, 0); }
#pragma unroll
        for (int r = 0; r < 16; ++r) { const int kidx = 32 * kt + (r & 3) + 8 * (r >> 2) + 4 * hh; ins16(t, (sortable(acc[r]) & ~127) | (127 - kidx)); }
    }
    int p[16];
#pragma unroll
    for (int i = 0; i < 16; ++i) { auto rr = __builtin_amdgcn_permlane32_swap((unsigned)t[i], (unsigned)t[i], false, false); p[i] = (int)(hh ? rr[0] : rr[1]); }
#pragma unroll
    for (int i = 0; i < 16; ++i) t[i] = t[i] > p[15 - i] ? t[i] : p[15 - i];
#pragma unroll
    for (int d = 8; d >= 1; d >>= 1)
#pragma unroll
        for (int i = 0; i < 16; ++i) if ((i & d) == 0) { const int hi_ = t[i] > t[i + d] ? t[i] : t[i + d], lo_ = t[i] > t[i + d] ? t[i + d] : t[i]; t[i] = hi_; t[i + d] = lo_; }
}
__device__ __forceinline__ void p9_stage(const bf16raw* SKB, LAS unsigned char* lds, int buf, int hc, int tid) {
#pragma unroll
    for (int k = 0; k < 4; ++k) { const int i = tid + 512 * k, row = i >> 4, ch = i & 15;
        *(LAS v4u*)(lds + buf * (128 * P9_KP * 2) + row * (P9_KP * 2) + 16 * ch) = *(const v4u*)(SKB + ((size_t)hc * 128 + row) * 128 + 8 * ch); }
}
__device__ __forceinline__ int pick8(unsigned long long lo, unsigned long long hi, int i) { const unsigned long long w = (i & 8) ? hi : lo; return (int)((w >> (8 * (i & 7))) & 255ull); }
__device__ __forceinline__ void p9_topk(LAS unsigned char* lds, const P9Args& a, int wg0, int nwg, int wave, int lane, int tid) {
    const int m32 = lane & 31, hh = lane >> 5;
    for (int tw = wg0; tw < M / 256; tw += nwg) {
        const size_t tok = (size_t)tw * 256 + 32 * wave + m32;
        __syncthreads();
        p9_stage(a.SKB, lds, 0, 0, tid);
        __syncthreads();
        for (int h = 0; h < PH; ++h) {
            int L0[16], L1[16];
            p9_stage(a.SKB, lds, 1, 2 * h + 1, tid);
            p9_half(a, (const LAS bf16raw*)(lds), tok, h, 0, m32, hh, L0);
            __syncthreads();
            if (h + 1 < PH) p9_stage(a.SKB, lds, 0, 2 * h + 2, tid);
            p9_half(a, (const LAS bf16raw*)(lds + 128 * P9_KP * 2), tok, h, 1, m32, hh, L1);
            float v0[16], v1[16]; unsigned long long P0l = 0, P0h = 0, P1l = 0, P1h = 0;
#pragma unroll
            for (int i = 0; i < 16; ++i) { v0[i] = unsortable(L0[i] & ~127); v1[i] = unsortable(L1[i] & ~127);
                if (i < 8) { P0l |= (unsigned long long)(127 - (L0[i] & 127)) << (8 * (i & 7)); P1l |= (unsigned long long)(127 - (L1[i] & 127)) << (8 * (i & 7)); }
                else { P0h |= (unsigned long long)(127 - (L0[i] & 127)) << (8 * (i & 7)); P1h |= (unsigned long long)(127 - (L1[i] & 127)) << (8 * (i & 7)); } }
            int t2[16];
#pragma unroll
            for (int i = 0; i < 16; ++i) t2[i] = (int)0x80000000;
#pragma unroll
            for (int i = 0; i < 16; ++i)
#pragma unroll
                for (int j = 0; j < 16; ++j) if ((i + 1) * (j + 1) <= 16) ins16(t2, (sortable(v0[i] + v1[j]) & ~255) | (255 - (16 * i + j)));
            const float ts0 = unsortable(t2[0] & ~255); float ex[16]; int ids[16]; float sum = 0.f;
#pragma unroll
            for (int k = 0; k < 16; ++k) { ex[k] = __expf(unsortable(t2[k] & ~255) - ts0); sum += ex[k];
                const int ci = 255 - (t2[k] & 255), i = ci >> 4, j = ci & 15;
                ids[k] = pick8(P0l, P0h, i) * 128 + pick8(P1l, P1h, j); }
            const float inv = __builtin_amdgcn_rcpf(sum);
            if (hh == 0) {
#pragma unroll
                for (int q = 0; q < 2; ++q) *(v4u*)(a.IDS + tok * HK + h * 16 + 8 * q) = (v4u){(unsigned)ids[8 * q] | ((unsigned)ids[8 * q + 1] << 16), (unsigned)ids[8 * q + 2] | ((unsigned)ids[8 * q + 3] << 16), (unsigned)ids[8 * q + 4] | ((unsigned)ids[8 * q + 5] << 16), (unsigned)ids[8 * q + 6] | ((unsigned)ids[8 * q + 7] << 16)};
            } else {
#pragma unroll
                for (int q = 0; q < 4; ++q) *(f32x4*)(a.GW + tok * HK + h * 16 + 4 * q) = (f32x4){ex[4 * q] * inv, ex[4 * q + 1] * inv, ex[4 * q + 2] * inv, ex[4 * q + 3] * inv};
            }
            __syncthreads();
        }
    }
}

constexpr float U_SCALE = 256.f, V_SCALE = 16.f, U4_STEP = 0.345f, X7_RESCALE = 127.f / 63.f;
constexpr size_t SLICE_BYTES = (size_t)NEXP * 128;
__device__ __forceinline__ void cvt16p(const v4u r, f32x2 (&f)[8]) {
    const unsigned w[4] = {r.x, r.y, r.z, r.w};
#pragma unroll
    for (int i = 0; i < 4; ++i) { f[2 * i] = __builtin_amdgcn_cvt_pk_f32_fp8((int)w[i], false); f[2 * i + 1] = __builtin_amdgcn_cvt_pk_f32_fp8((int)w[i], true); }
}
__device__ __forceinline__ unsigned e2m1_code(float x) {
    const float m = fabsf(x);
    const unsigned c = (unsigned)(m > 0.25f) + (unsigned)(m >= 0.75f) + (unsigned)(m > 1.25f) + (unsigned)(m >= 1.75f) + (unsigned)(m > 2.5f) + (unsigned)(m >= 3.5f) + (unsigned)(m > 5.f);
    return c | (x < 0.f ? 8u : 0u);
}
__device__ __forceinline__ float e2m1_val(unsigned c) { const unsigned m = c & 7u; const float v = m < 4u ? 0.5f * (float)m : m == 4u ? 2.f : m == 5u ? 3.f : m == 6u ? 4.f : 6.f; return (c & 8u) ? -v : v; }
typedef __amdgpu_buffer_rsrc_t prsrc_t;
__device__ __forceinline__ v4u pbld16(prsrc_t r, unsigned voff) { return __builtin_bit_cast(v4u, __builtin_amdgcn_raw_buffer_load_b128(r, (int)voff, 0, 0)); }
template <int CTRL> __device__ __forceinline__ float dpp_add(float v) { return v + __builtin_bit_cast(float, __builtin_amdgcn_update_dpp(0, __builtin_bit_cast(int, v), CTRL, 0xf, 0xf, false)); }
template <int CTRL> __device__ __forceinline__ int dpp_addi(int v) { return v + __builtin_amdgcn_update_dpp(0, v, CTRL, 0xf, 0xf, false); }
__device__ __forceinline__ void p15_udot(const unsigned char* XH, const unsigned char* XL, const unsigned char* U4S, const unsigned short* IDS, short* PA, unsigned* Q, int xcc, int lane) {
    const int sub = lane & 7, tk = lane >> 3;
    for (int sidx = 0; sidx < 4; ++sidx) { const int s = (xcc + sidx) & 3; const prsrc_t tab = __builtin_amdgcn_make_buffer_rsrc((void*)(U4S + (size_t)s * SLICE_BYTES), (short)0, (int)SLICE_BYTES, 0x00020000);
        for (;;) {
            unsigned t0 = 0; if (lane == 0) t0 = __hip_atomic_fetch_add(Q + 64 * s, 16u, __ATOMIC_RELAXED, __HIP_MEMORY_SCOPE_AGENT);
            t0 = (unsigned)__builtin_amdgcn_readfirstlane((int)t0);
            if (t0 >= (unsigned)M) break;
            for (int it = 0; it < 2; ++it) { const size_t t = (size_t)t0 + 8 * it + tk;
                const v4u xh = *(const v4u*)(XH + t * 512 + 128 * s + 16 * sub), xl = *(const v4u*)(XL + t * 512 + 128 * s + 16 * sub);
                int res[16];
#pragma unroll
                for (int b8 = 0; b8 < 8; ++b8) { const int i0 = 16 * b8;
                    int id[16];
#pragma unroll
                    for (int q = 0; q < 2; ++q) { const v4u v = *(const v4u*)(IDS + t * HK + i0 + 8 * q); id[8 * q] = v.x & 0xffffu; id[8 * q + 1] = v.x >> 16; id[8 * q + 2] = v.y & 0xffffu; id[8 * q + 3] = v.y >> 16; id[8 * q + 4] = v.z & 0xffffu; id[8 * q + 5] = v.z >> 16; id[8 * q + 6] = v.w & 0xffffu; id[8 * q + 7] = v.w >> 16; }
                    v4u row[16];
#pragma unroll
                    for (int i = 0; i < 16; ++i) row[i] = pbld16(tab, (unsigned)id[i] * 128u + 16u * sub);
                    int r0 = 0, r1 = 0;
#pragma unroll
                    for (int i = 0; i < 16; ++i) { int ph = __builtin_amdgcn_sdot8((int)xh.x, (int)row[i].x, 0, false); ph = __builtin_amdgcn_sdot8((int)xh.y, (int)row[i].y, ph, false);
                        ph = __builtin_amdgcn_sdot8((int)xh.z, (int)row[i].z, ph, false); ph = __builtin_amdgcn_sdot8((int)xh.w, (int)row[i].w, ph, false);
                        int p = __builtin_amdgcn_sdot8((int)xl.x, (int)row[i].x, ph << 3, false); p = __builtin_amdgcn_sdot8((int)xl.y, (int)row[i].y, p, false);
                        p = __builtin_amdgcn_sdot8((int)xl.z, (int)row[i].z, p, false); p = __builtin_amdgcn_sdot8((int)xl.w, (int)row[i].w, p, false);
                        p = dpp_addi<0xB1>(p); p = dpp_addi<0x4E>(p); p = dpp_addi<0x141>(p);
                        if (sub == (i & 7)) { if (i < 8) r0 = p; else r1 = p; } }
                    res[2 * b8] = r0; res[2 * b8 + 1] = r1; }
#pragma unroll
                for (int q = 0; q < 2; ++q) { unsigned w[4];
#pragma unroll
                    for (int z = 0; z < 4; ++z) { const int lo = min(max(res[8 * q + 2 * z], -32767), 32767), hi = min(max(res[8 * q + 2 * z + 1], -32767), 32767); w[z] = ((unsigned)lo & 0xffffu) | ((unsigned)hi << 16); }
                    *(v4u*)(PA + ((size_t)s * M + t) * HK + q * 64 + sub * 8) = (v4u){w[0], w[1], w[2], w[3]}; }
            }
        }
    }
}
struct ActL1 { short pa[2][4]; unsigned short id[2]; float gw[2]; float sx; };
struct ActL2 { float su[2], sv[2]; };
__device__ __forceinline__ void act_l1(const short* PA, const float* GW, const float* SX, const unsigned short* IDS, int t, int lane, ActL1& r) {
    r.sx = SX[t];
#pragma unroll
    for (int h = 0; h < 2; ++h) { const int e = lane + 64 * h, pos = (e >> 6) * 64 + (e & 7) * 8 + ((e >> 3) & 7);
#pragma unroll
        for (int s = 0; s < 4; ++s) r.pa[h][s] = PA[((size_t)s * M + t) * HK + pos];
        r.id[h] = IDS[(size_t)t * HK + e]; r.gw[h] = GW[(size_t)t * HK + e]; }
}
__device__ __forceinline__ void p15b_act(const short* PA, const float* GW, unsigned char* W4, float* WSC, const float* SX, const float* SU, const float* SV, const unsigned short* IDS, int gw, int NGW, int lane) {
    if (gw >= M) return;
    ActL1 a0, a1, a2; ActL2 b0, b1;
    act_l1(PA, GW, SX, IDS, gw, lane, a0); act_l1(PA, GW, SX, IDS, gw + NGW < M ? gw + NGW : gw, lane, a1);
#pragma unroll
    for (int h = 0; h < 2; ++h) { b0.su[h] = SU[a0.id[h]]; b0.sv[h] = SV[a0.id[h]]; }
    for (int t = gw; t < M; t += NGW) { const int t2 = t + 2 * NGW; act_l1(PA, GW, SX, IDS, t2 < M ? t2 : t, lane, a2);
#pragma unroll
        for (int h = 0; h < 2; ++h) { b1.su[h] = SU[a1.id[h]]; b1.sv[h] = SV[a1.id[h]]; }
        float w[2]; const float sx = a0.sx * X7_RESCALE;
#pragma unroll
        for (int h = 0; h < 2; ++h) { const int a = (int)a0.pa[h][0] + (int)a0.pa[h][1] + (int)a0.pa[h][2] + (int)a0.pa[h][3]; w[h] = a0.gw[h] * gelu_erf((float)a * sx * b0.su[h]) * b0.sv[h]; }
        float mx = fmaxf(fabsf(w[0]), fabsf(w[1]));
#pragma unroll
        for (int o = 1; o < 64; o <<= 1) mx = fmaxf(mx, __shfl_xor(mx, o));
        mx = fmaxf(mx, 1e-30f); const float sc = 6.f / mx; if (lane == 0) WSC[t] = mx * (1.f / 6.f);
#pragma unroll
        for (int h = 0; h < 2; ++h) { float x = w[h] * sc;
#pragma unroll
            for (int r = 0; r < 4; ++r) { const unsigned c = e2m1_code(fminf(fmaxf(x, -6.f), 6.f)); x = (x - e2m1_val(c)) * 4.f;
                const unsigned oc = (unsigned)__shfl_xor((int)c, 1);
                if (!(lane & 1)) W4[(size_t)t * 256 + r * 64 + 32 * h + (lane >> 1)] = (unsigned char)(c | (oc << 4)); } }
        a0 = a1; a1 = a2; b0 = b1; }
}
typedef int pv2i __attribute__((ext_vector_type(2)));
typedef int pv8i __attribute__((ext_vector_type(8)));
struct VsRows { v4u row[16]; };
#define VS_GAS __attribute__((address_space(1)))
template <class T> __device__ __forceinline__ VS_GAS T* vs_uni(T* p) {
    const unsigned long long v = (unsigned long long)p; const unsigned lo = (unsigned)__builtin_amdgcn_readfirstlane((int)(unsigned)v), hi = (unsigned)__builtin_amdgcn_readfirstlane((int)(unsigned)(v >> 32));
    return (VS_GAS T*)(((unsigned long long)hi << 32) | lo);
}
__device__ __forceinline__ void vs_ids(const unsigned short* IDS, size_t t, int r, int (&id)[16]) {
    const VS_GAS unsigned short* ip = vs_uni(IDS + t * HK) + 16 * r;
#pragma unroll
    for (int q = 0; q < 2; ++q) { const v4u v = *(const VS_GAS v4u*)(ip + 8 * q); id[8 * q] = v.x & 0xffffu; id[8 * q + 1] = v.x >> 16; id[8 * q + 2] = v.y & 0xffffu; id[8 * q + 3] = v.y >> 16; id[8 * q + 4] = v.z & 0xffffu; id[8 * q + 5] = v.z >> 16; id[8 * q + 6] = v.w & 0xffffu; id[8 * q + 7] = v.w >> 16; }
}
__device__ __forceinline__ void vs_gather(prsrc_t tab, const int (&id)[16], int sub, VsRows& R) {
#pragma unroll
    for (int n = 0; n < 16; ++n) R.row[n] = pbld16(tab, (unsigned)id[n] * 128u + 16u * sub);
}
struct VsSmall { v4u a; float xi[4]; float isc; };
__device__ __forceinline__ void vs_small(const unsigned char* W4, const float* WSC, const bf16raw* X1B, size_t t, int s, int lane, VsSmall& S) {
    const int j = lane & 15, kg = lane >> 4;
    S.a = *(const VS_GAS v4u*)(vs_uni(W4 + t * 256) + (j & 3) * 64 + 16 * kg);
    const VS_GAS bf16raw* xb = vs_uni(X1B + t * D + 256 * s);
    S.isc = *vs_uni(WSC + t);
#pragma unroll
    for (int G = 0; G < 4; ++G) S.xi[G] = __builtin_bit_cast(float, (unsigned)xb[64 * G + lane] << 16);
}
template <bool PF1, bool PF2, int MODE = 0>
__device__ __forceinline__ void vs_unit(float& keep, LAS unsigned char* wl, prsrc_t tab, const unsigned short* IDS, const unsigned char* W4, const float* WSC, const bf16raw* X1B, float* OUT, size_t t, size_t t1, size_t t2, int s, int lane, VsRows& cur, VsRows& nxt, int (&idg)[16], int (&idl)[16], VsSmall& sc, VsSmall& sn) {
    const int sub = lane & 7, r = lane >> 3, j = lane & 15, kg = lane >> 4;
    if (PF1) vs_small(W4, WSC, X1B, t1, s, lane, sn);
    if (PF2) vs_ids(IDS, t2, r, idl);
    asm volatile("" ::: "memory");
    if (PF1) {
#pragma unroll
        for (int k = 0; k < 16; ++k) asm volatile("" : "+v"(idg[k]));
        vs_gather(tab, idg, sub, nxt); }
    asm volatile("" ::: "memory");
#pragma unroll
    for (int n = 0; n < 16; ++n) { const int e = 16 * r + n; *(LAS v4u*)(wl + e * 128 + ((sub ^ ((e >> 1) & 7)) << 4)) = cur.row[n]; }
    asm volatile("" ::: "memory");
    const int row0 = 32 * kg + j, row1 = row0 + 16, f0 = (row0 >> 1) & 7, f1 = (row1 >> 1) & 7;
    const v4u a0 = sc.a;
    float o[4];
#pragma unroll
    for (int G = 0; G < 4; ++G) { f32x4 acc = (f32x4){0.f, 0.f, 0.f, 0.f};
#pragma unroll
        for (int q = 0; q < 4; ++q) { const int g = 4 * G + q, c = g >> 1, hf = 8 * (g & 1);
            const pv2i b0 = __builtin_amdgcn_ds_read_tr4_b64_v2i32((LAS pv2i*)(wl + row0 * 128 + ((c ^ f0) << 4) + hf));
            const pv2i b1 = __builtin_amdgcn_ds_read_tr4_b64_v2i32((LAS pv2i*)(wl + row1 * 128 + ((c ^ f1) << 4) + hf));
            const bool mine = (j >> 2) == q;
            const pv8i A = (pv8i){mine ? (int)a0.x : 0, mine ? (int)a0.y : 0, mine ? (int)a0.z : 0, mine ? (int)a0.w : 0, 0, 0, 0, 0};
            const pv8i B = (pv8i){b0.x, b0.y, b1.x, b1.y, 0, 0, 0, 0};
            acc = __builtin_amdgcn_mfma_scale_f32_16x16x128_f8f6f4(A, B, acc, 4, 4, 0, 0x7F7F7F7F, 0, 0x7F7F7F7F); }
        o[G] = ((acc[0] + acc[1] * 0.25f) + (acc[2] * (1.f / 16.f) + acc[3] * (1.f / 64.f))) * sc.isc; }
    asm volatile("" ::: "memory");
    VS_GAS float* ob = vs_uni(OUT + t * D + 256 * s);
#pragma unroll
    for (int G = 0; G < 4; ++G) { if (MODE == 0) ob[64 * G + lane] = sc.xi[G] + o[G]; else keep += sc.xi[G] + o[G]; }
}
__device__ __forceinline__ unsigned vs_ticket(unsigned* q, int lane) { unsigned t0 = 0; if (lane == 0) t0 = __hip_atomic_fetch_add(q, 16u, __ATOMIC_RELAXED, __HIP_MEMORY_SCOPE_AGENT); return t0; }
template <int MODE = 0>
__device__ __forceinline__ void p16_vsum(LAS unsigned char* lds, const unsigned char* V4S, const unsigned short* IDS, const unsigned char* W4, const float* WSC, const bf16raw* X1B, float* OUT, unsigned* Q, int xcc, int wave, int lane) {
    LAS unsigned char* wl = lds + wave * 16384; float keep = 0.f;
    const int sub = lane & 7, r = lane >> 3;
    for (int sidx = 0; sidx < 4; ++sidx) { const int s = (xcc + sidx) & 3; const prsrc_t tab = __builtin_amdgcn_make_buffer_rsrc((void*)(V4S + (size_t)s * SLICE_BYTES), (short)0, (int)SLICE_BYTES, 0x00020000);
        unsigned tkc = (unsigned)__builtin_amdgcn_readfirstlane((int)vs_ticket(Q + 64 * s, lane));
        if (tkc >= (unsigned)M) continue;
        VsRows ra, rb; int idA[16], idB[16]; VsSmall sa, sb;
        vs_ids(IDS, (size_t)tkc, r, idA); vs_gather(tab, idA, sub, ra); vs_ids(IDS, (size_t)tkc + 1, r, idB); vs_small(W4, WSC, X1B, (size_t)tkc, s, lane, sa);
        for (;;) {
            const unsigned tkn_raw = vs_ticket(Q + 64 * s, lane);
#pragma unroll
            for (int u = 0; u < 14; u += 2) { unsigned tu = tkc + u; asm volatile("" : "+s"(tu));
                vs_unit<true, true, MODE>(keep, wl, tab, IDS, W4, WSC, X1B, OUT, (size_t)tu, (size_t)tu + 1, (size_t)tu + 2, s, lane, ra, rb, idB, idA, sa, sb);
                vs_unit<true, true, MODE>(keep, wl, tab, IDS, W4, WSC, X1B, OUT, (size_t)tu + 1, (size_t)tu + 2, (size_t)tu + 3, s, lane, rb, ra, idA, idB, sb, sa); }
            const unsigned tkn = (unsigned)__builtin_amdgcn_readfirstlane((int)tkn_raw);
            if (tkn < (unsigned)M) { vs_unit<true, true, MODE>(keep, wl, tab, IDS, W4, WSC, X1B, OUT, (size_t)tkc + 14, (size_t)tkc + 15, (size_t)tkn, s, lane, ra, rb, idB, idA, sa, sb);
                                     vs_unit<true, true, MODE>(keep, wl, tab, IDS, W4, WSC, X1B, OUT, (size_t)tkc + 15, (size_t)tkn, (size_t)tkn + 1, s, lane, rb, ra, idA, idB, sb, sa); tkc = tkn; }
            else { vs_unit<true, false, MODE>(keep, wl, tab, IDS, W4, WSC, X1B, OUT, (size_t)tkc + 14, (size_t)tkc + 15, 0, s, lane, ra, rb, idB, idA, sa, sb);
                   vs_unit<false, false, MODE>(keep, wl, tab, IDS, W4, WSC, X1B, OUT, (size_t)tkc + 15, 0, 0, s, lane, rb, ra, idA, idB, sb, sa); break; }
        }
    }
    if (MODE != 0 && keep == 123.456f) OUT[lane] = keep;
}
__device__ __forceinline__ void quant_u_i4_sliced(const float* src, unsigned char* dst, float* su, int gw, int NGW, int lane) {
    for (int e = gw; e < NEXP; e += NGW) { const int c0 = 16 * lane; f32x4 v[4]; float ss = 0.f;
#pragma unroll
        for (int q = 0; q < 4; ++q) { v[q] = *(const f32x4*)(src + (size_t)e * D + c0 + 4 * q); ss += (v[q].x * v[q].x + v[q].y * v[q].y) + (v[q].z * v[q].z + v[q].w * v[q].w); }
#pragma unroll
        for (int o = 1; o < 64; o <<= 1) ss += __shfl_xor(ss, o);
        const float sc = fmaxf(sqrtf(ss * (1.f / 1024.f)) * U4_STEP, 1e-30f), inv = 1.f / sc; if (lane == 0) su[e] = sc;
        unsigned o2[2];
#pragma unroll
        for (int h = 0; h < 2; ++h) { unsigned w = 0u;
#pragma unroll
            for (int q = 0; q < 2; ++q)
#pragma unroll
                for (int z = 0; z < 4; ++z) { const int qi = (int)fminf(fmaxf(__builtin_rintf(v[2 * h + q][z] * inv), -7.f), 7.f); w |= (unsigned)(qi & 15) << (16 * q + 4 * z); }
            o2[h] = w; }
        *(unsigned long long*)(dst + (size_t)(c0 >> 8) * SLICE_BYTES + (size_t)e * 128 + ((c0 & 255) >> 1)) = (unsigned long long)o2[0] | ((unsigned long long)o2[1] << 32); }
}
__device__ __forceinline__ void cvt_fp4_sliced(const float* src, unsigned char* dst, float* SV, size_t gtid, size_t gthreads) {
    for (size_t i = gtid; i < (size_t)NEXP * 64; i += gthreads) { const size_t e = i >> 6; const int m_ = (int)(i & 63);
        f32x4 v[4]; float mx = 0.f;
#pragma unroll
        for (int q = 0; q < 4; ++q) { v[q] = *(const f32x4*)(src + e * D + 16 * m_ + 4 * q); mx = fmaxf(fmaxf(mx, fmaxf(fabsf(v[q].x), fabsf(v[q].y))), fmaxf(fabsf(v[q].z), fabsf(v[q].w))); }
#pragma unroll
        for (int o = 1; o < 64; o <<= 1) mx = fmaxf(mx, __shfl_xor(mx, o));
        const float sc = fmaxf(mx, 1e-30f) * (1.f / 6.f), inv = 1.f / sc; if (m_ == 0) SV[e] = sc;
        unsigned w0 = 0u, w1 = 0u;
#pragma unroll
        for (int q = 0; q < 2; ++q)
#pragma unroll
            for (int z = 0; z < 4; ++z) { w0 |= e2m1_code(v[q][z] * inv) << (16 * q + 4 * z); w1 |= e2m1_code(v[2 + q][z] * inv) << (16 * q + 4 * z); }
        *(unsigned long long*)(dst + (size_t)(m_ >> 4) * SLICE_BYTES + e * 128 + 8 * (m_ & 15)) = (unsigned long long)w0 | ((unsigned long long)w1 << 32);
    }
}
__device__ __forceinline__ void transpose_item(const float* W, int ldw, int col0, int K, bf16raw* WT, int row_off, LAS float* scr, int kb, int nb, int lane) {
    const int k0 = 64 * kb, n0 = 32 * nb;
#pragma unroll 8
    for (int i = 0; i < 32; ++i) { const int kk = 2 * i + (lane >> 5); scr[kk * 33 + (lane & 31)] = W[(size_t)(k0 + kk) * ldw + col0 + n0 + (lane & 31)]; }
    asm volatile("s_waitcnt lgkmcnt(0)" ::: "memory");
    const int c = lane & 7;
#pragma unroll
    for (int j = 0; j < 4; ++j) { const int n = (lane >> 3) + 8 * j; const LAS float* s = scr + (8 * c) * 33 + n;
        v4u o; o.x = pk2(s[0 * 33], s[1 * 33]); o.y = pk2(s[2 * 33], s[3 * 33]); o.z = pk2(s[4 * 33], s[5 * 33]); o.w = pk2(s[6 * 33], s[7 * 33]);
        *(v4u*)(WT + (size_t)(row_off + n0 + n) * K + k0 + 8 * c) = o; }
    asm volatile("s_waitcnt lgkmcnt(0)" ::: "memory");
}
__device__ __forceinline__ unsigned pk4_fp8(float a, float b, float c, float d) { int w = 0; w = __builtin_amdgcn_cvt_pk_fp8_f32(fminf(fmaxf(a, -448.f), 448.f), fminf(fmaxf(b, -448.f), 448.f), w, false);
    w = __builtin_amdgcn_cvt_pk_fp8_f32(fminf(fmaxf(c, -448.f), 448.f), fminf(fmaxf(d, -448.f), 448.f), w, true); return (unsigned)w; }
__device__ __forceinline__ void transpose_item_fp8(const float* W, int ldw, int col0, int K, unsigned char* WT, int row_off, LAS float* scr, int kb, int nb, int lane, float scale) {
    const int k0 = 64 * kb, n0 = 32 * nb;
#pragma unroll 8
    for (int i = 0; i < 32; ++i) { const int kk = 2 * i + (lane >> 5); scr[kk * 33 + (lane & 31)] = W[(size_t)(k0 + kk) * ldw + col0 + n0 + (lane & 31)]; }
    asm volatile("s_waitcnt lgkmcnt(0)" ::: "memory");
    const int c = lane & 7;
#pragma unroll
    for (int j = 0; j < 4; ++j) { const int n = (lane >> 3) + 8 * j; const LAS float* s = scr + (8 * c) * 33 + n;
        v2u o; o.x = pk4_fp8(s[0 * 33] * scale, s[1 * 33] * scale, s[2 * 33] * scale, s[3 * 33] * scale); o.y = pk4_fp8(s[4 * 33] * scale, s[5 * 33] * scale, s[6 * 33] * scale, s[7 * 33] * scale);
        *(v2u*)(WT + (size_t)(row_off + n0 + n) * K + k0 + 8 * c) = o; }
    asm volatile("s_waitcnt lgkmcnt(0)" ::: "memory");
}
__device__ __forceinline__ int win_src_col(int g);
__device__ __forceinline__ int gate_src_col(int n);
__device__ __forceinline__ void colmax_item(const float* W, int ldw, int col0, unsigned* cmax, int row_off, int nb, int kq, int lane) {
    const int n0 = 32 * nb; float mx = 0.f;
#pragma unroll 8
    for (int i = 0; i < 64; ++i) { const int kk = 128 * kq + 2 * i + (lane >> 5); mx = fmaxf(mx, fabsf(W[(size_t)kk * ldw + col0 + n0 + (lane & 31)])); }
    mx = fmaxf(mx, __shfl_xor(mx, 32));
    if (lane < 32) atomicMax(cmax + row_off + n0 + lane, __builtin_bit_cast(unsigned, mx));
}
__device__ __forceinline__ void quant_item_i8(const float* W, int ldw, int col0, signed char* WT, const unsigned* cmax, float* sw, int row_off, LAS float* scr, int kb, int nb, int lane) {
    const int k0 = 64 * kb, n0 = 32 * nb;
    const float sc = fmaxf(__builtin_bit_cast(float, cmax[row_off + n0 + (lane & 31)]), 1e-30f) * (1.f / 127.f), inv = 1.f / sc;
    if (kb == 0 && lane < 32) sw[row_off + n0 + lane] = sc;
#pragma unroll 8
    for (int i = 0; i < 32; ++i) { const int kk = 2 * i + (lane >> 5); scr[kk * 33 + (lane & 31)] = W[(size_t)(k0 + kk) * ldw + col0 + n0 + (lane & 31)] * inv; }
    asm volatile("s_waitcnt lgkmcnt(0)" ::: "memory");
    const int c = lane & 7;
#pragma unroll
    for (int j = 0; j < 4; ++j) { const int n = (lane >> 3) + 8 * j; const LAS float* s = scr + (8 * c) * 33 + n; int q[8];
#pragma unroll
        for (int e2 = 0; e2 < 8; ++e2) q[e2] = (int)__builtin_rintf(s[e2 * 33]);
        v2u o; o.x = (unsigned)(q[0] & 255) | ((unsigned)(q[1] & 255) << 8) | ((unsigned)(q[2] & 255) << 16) | ((unsigned)(q[3] & 255) << 24);
        o.y = (unsigned)(q[4] & 255) | ((unsigned)(q[5] & 255) << 8) | ((unsigned)(q[6] & 255) << 16) | ((unsigned)(q[7] & 255) << 24);
        *(v2u*)(WT + (size_t)(row_off + n0 + n) * 1024 + k0 + 8 * c) = o; }
    asm volatile("s_waitcnt lgkmcnt(0)" ::: "memory");
}
__device__ __forceinline__ void p0b_quant_w(LAS unsigned char* lds, const float* w_in, const float* wpq, const float* wm, signed char* WT, float* sw, const unsigned* cmax, int gw, int NGW, int wave, int lane) {
    LAS float* scr = (LAS float*)(lds + wave * 16384);
    for (int it = gw; it < 9 * 512 + 1024 + 512; it += NGW) {
        if (it < 9 * 512) { const int g = it / 512, q = it % 512; quant_item_i8(w_in, DIN, win_src_col(g), WT, cmax, sw, 1024 * g, scr, q / 32, q % 32, lane); }
        else if (it < 9 * 512 + 1024) { const int q = it - 9 * 512; quant_item_i8(wpq, 2048, 0, WT, cmax, sw, 9216, scr, q / 64, q % 64, lane); }
        else { const int q = it - 9 * 512 - 1024; quant_item_i8(wm, 1024, 0, WT, cmax, sw, 11264, scr, q / 32, q % 32, lane); } }
    for (int i = gw * 64 + lane; i < 256 * 1024; i += NGW * 64) { const int n = i >> 10, k = i & 1023; signed char qv = 0;
        if (n < 16) { const float sc = fmaxf(__builtin_bit_cast(float, cmax[12288 + n]), 1e-30f) * (1.f / 127.f); qv = (signed char)(int)__builtin_rintf(w_in[(size_t)k * DIN + gate_src_col(n)] / sc); if (k == 0) sw[12288 + n] = sc; }
        WT[(size_t)(12288 + n) * 1024 + k] = qv; }
}
__device__ __forceinline__ void cvt_bf16_stream(const float* src, bf16raw* dst, size_t n, size_t gtid, size_t gthreads) {
    for (size_t i = gtid * 8; i < n; i += gthreads * 8) { const f32x4 a = *(const f32x4*)(src + i), b = *(const f32x4*)(src + i + 4);
        v4u o; o.x = pk2(a.x, a.y); o.y = pk2(a.z, a.w); o.z = pk2(b.x, b.y); o.w = pk2(b.z, b.w); *(v4u*)(dst + i) = o; }
}
constexpr float H8_SCALE = 16.f, W8_SCALE = 256.f;
__device__ __forceinline__ void rms_row_load(const float* xrow, int lane, f32x4 (&v)[4]) {
    const f32x4* xr = (const f32x4*)xrow + lane;
#pragma unroll
    for (int j = 0; j < 4; ++j) v[j] = xr[64 * j];
}
__device__ __forceinline__ void rms_row_load_b16(const bf16raw* xrow, int lane, f32x4 (&v)[4]) {
#pragma unroll
    for (int j = 0; j < 4; ++j) { const v2u w = *(const v2u*)(xrow + 256 * j + 4 * lane); v[j] = (f32x4){bflo(w.x), bfhi(w.x), bflo(w.y), bfhi(w.y)}; }
}
__device__ __forceinline__ void rms_gain_load(const float* gain, int lane, f32x4 (&gr)[4]) {
#pragma unroll
    for (int j = 0; j < 4; ++j) gr[j] = ((const f32x4*)gain + lane)[64 * j];
}
__device__ __forceinline__ void rms_row_to_bf16(const f32x4 (&v)[4], const f32x4 (&gr)[4], bf16raw* orow, int lane, unsigned char* o8row = nullptr, float* shrow = nullptr, unsigned char* xhrow = nullptr, unsigned char* xlrow = nullptr) {
    float s = 0.f;
#pragma unroll
    for (int j = 0; j < 4; ++j) { s += (v[j].x * v[j].x + v[j].y * v[j].y) + (v[j].z * v[j].z + v[j].w * v[j].w); }
    const float rstd = __builtin_amdgcn_rsqf(wave_sum_dpp(s) * (1.f / 1024.f) + EPS);
    unsigned long long* o8 = (unsigned long long*)orow + lane;
    f32x4 hh[4]; float mx = 0.f;
#pragma unroll
    for (int j = 0; j < 4; ++j) { const f32x4 g = gr[j]; hh[j] = (f32x4){v[j].x * rstd * g.x, v[j].y * rstd * g.y, v[j].z * rstd * g.z, v[j].w * rstd * g.w};
        if (orow) o8[64 * j] = (unsigned long long)pk2(hh[j].x, hh[j].y) | ((unsigned long long)pk2(hh[j].z, hh[j].w) << 32);
        mx = fmaxf(fmaxf(mx, fmaxf(fabsf(hh[j].x), fabsf(hh[j].y))), fmaxf(fabsf(hh[j].z), fabsf(hh[j].w))); }
    if (o8row) {
        mx = wave_max_dpp(mx);
        const float sc = fmaxf(mx, 1e-30f) * (1.f / 127.f), inv = __builtin_amdgcn_rcpf(sc);
        if (lane == 0) *shrow = sc;
#pragma unroll
        for (int j = 0; j < 4; ++j) ((unsigned*)o8row)[64 * j + lane] = q8x4_pack(hh[j].x, hh[j].y, hh[j].z, hh[j].w, inv);
        if (xhrow) { const float inv7 = inv * (63.f / 127.f);
#pragma unroll
            for (int j = 0; j < 4; ++j) { const unsigned p7 = q8x4_pack(hh[j].x, hh[j].y, hh[j].z, hh[j].w, inv7);
                ((unsigned short*)xhrow)[64 * j + lane] = (unsigned short)nib4((p7 >> 3) & 0x0F0F0F0Fu);
                ((unsigned short*)xlrow)[64 * j + lane] = (unsigned short)nib4(p7 & 0x07070707u); } } }
}
template <class R, class LD, class PR>
__device__ __forceinline__ void rows_pipe3(int m0, int m1, int mstep, const LD& LOAD, const PR& PROC) {
    if (m0 >= m1) return;
    R r0, r1, r2; LOAD(m0, r0); LOAD(m0 + mstep < m1 ? m0 + mstep : m0, r1);
    for (int m = m0; m < m1; m += 3 * mstep) { const int ma = m + mstep, mb = ma + mstep, mc = mb + mstep, md = mc + mstep;
        LOAD(mb < m1 ? mb : m0, r2); PROC(m, r0); if (ma >= m1) break;
        LOAD(mc < m1 ? mc : m0, r0); PROC(ma, r1); if (mb >= m1) break;
        LOAD(md < m1 ? md : m0, r1); PROC(mb, r2); }
}
struct RowF32 { f32x4 v[4]; };
struct RowB16 { v2u w[4]; };
__device__ __forceinline__ void rms_rows_phase(const float* X, const float* gain, bf16raw* O, int m0, int m1, int mstep, int lane, unsigned char* O8 = nullptr, float* SH = nullptr, unsigned char* XH = nullptr, unsigned char* XL = nullptr) {
    f32x4 gr[4]; rms_gain_load(gain, lane, gr);
    rows_pipe3<RowF32>(m0, m1, mstep, [&](int m, RowF32& r) { rms_row_load(X + (size_t)m * D, lane, r.v); },
        [&](int m, const RowF32& r) { rms_row_to_bf16(r.v, gr, O ? O + (size_t)m * D : nullptr, lane, O8 ? O8 + (size_t)m * D : nullptr, SH ? SH + m : nullptr, XH ? XH + (size_t)m * 512 : nullptr, XL ? XL + (size_t)m * 512 : nullptr); });
}
__device__ __forceinline__ void rms_row_load_raw16(const bf16raw* xrow, int lane, v2u (&w)[4]) {
#pragma unroll
    for (int j = 0; j < 4; ++j) w[j] = *(const v2u*)(xrow + 256 * j + 4 * lane);
}
__device__ __forceinline__ void rms_rows_phase_b16(const bf16raw* X, const float* gain, int m0, int m1, int mstep, int lane, unsigned char* O8, float* SH, unsigned char* XH = nullptr, unsigned char* XL = nullptr) {
    f32x4 gr[4]; rms_gain_load(gain, lane, gr);
    rows_pipe3<RowB16>(m0, m1, mstep, [&](int m, RowB16& r) { rms_row_load_raw16(X + (size_t)m * D, lane, r.w); },
        [&](int m, const RowB16& r) { f32x4 v[4];
#pragma unroll
            for (int j = 0; j < 4; ++j) v[j] = (f32x4){bflo(r.w[j].x), bfhi(r.w[j].x), bflo(r.w[j].y), bfhi(r.w[j].y)};
            rms_row_to_bf16(v, gr, nullptr, lane, O8 + (size_t)m * D, SH + m, XH ? XH + (size_t)m * 512 : nullptr, XL ? XL + (size_t)m * 512 : nullptr); });
}
__device__ __forceinline__ int win_src_col(int g) { return g == 0 ? 0 : g == 1 ? 1024 : g == 2 ? 2048 : g == 3 ? 4104 : g == 4 ? 5128 : g == 5 ? 6152 : g == 6 ? 3072 : g == 7 ? 7184 : 8208; }
__device__ __forceinline__ int gate_src_col(int n) { return n < 8 ? 4096 + n : 7176 + (n - 8); }
struct P0Args { const float *x, *n1g, *w_in, *b_in, *wm, *wf, *wo, *wpq, *sk, *ut, *vt; bf16raw *WinT, *WgT, *WmT, *WfT, *WoT, *WpqT, *SKB, *UB, *VB, *H; float *biasP, *biasG; unsigned char* H8; bf16raw* WinTb; float* SH; unsigned* CMAX; };
__device__ __forceinline__ void p0_prologue(LAS unsigned char* lds, const P0Args& a, int vcu, int G, int wave, int lane, int tid) {
    LAS float* scr = (LAS float*)(lds + wave * 16384);
    const int gw = vcu * NWAVES + wave, NGW = G * NWAVES;
    constexpr int NI_G = 16 * 32;
    constexpr int NITEMS = 9 * NI_G + 3 * NI_G + 2 * NI_G;
    for (int it = gw; it < NITEMS; it += NGW) {
        int r = it;
        if (r < 9 * NI_G) { if (r < 288 * 8) { const int g = r / 256, nb = (r % 256) / 8, kq = r % 8; colmax_item(a.w_in, DIN, win_src_col(g), a.CMAX, 1024 * g, nb, kq, lane); }
            else if (r < 288 * 8 + 64 * 8) { const int q = r - 288 * 8; colmax_item(a.wpq, 2048, 0, a.CMAX, 9216, q / 8, q % 8, lane); }
            else if (r < 288 * 8 + 64 * 8 + 32 * 8) { const int q = r - 288 * 8 - 64 * 8; colmax_item(a.wm, 1024, 0, a.CMAX, 11264, q / 8, q % 8, lane); }
            else if (r == 288 * 8 + 64 * 8 + 32 * 8) { float mx = 0.f; const int col = gate_src_col(lane & 15);
                for (int k = (lane >> 4) * 256; k < (lane >> 4) * 256 + 256; ++k) mx = fmaxf(mx, fabsf(a.w_in[(size_t)k * DIN + col]));
                mx = fmaxf(mx, __shfl_xor(mx, 16)); mx = fmaxf(mx, __shfl_xor(mx, 32)); if (lane < 16) atomicMax(a.CMAX + 12288 + lane, __builtin_bit_cast(unsigned, mx)); }
            continue; } r -= 9 * NI_G;
        if (r < NI_G) { continue; } r -= NI_G;
        if (r < NI_G) { transpose_item(a.wf, D, 0, D, a.WfT, 0, scr, r / 32, r % 32, lane); continue; } r -= NI_G;
        if (r < NI_G) { transpose_item(a.wo, D, 0, D, a.WoT, 0, scr, r / 32, r % 32, lane); continue; } r -= NI_G;
        (void)0;
    }
    const size_t gtid = (size_t)vcu * NTHR + tid, gthreads = (size_t)G * NTHR;
    for (size_t i = gtid; i < 9216; i += gthreads) a.biasP[i] = a.b_in[win_src_col((int)(i >> 10)) + (int)(i & 1023)];
    for (size_t i = gtid; i < 16; i += gthreads) a.biasG[i] = a.b_in[gate_src_col((int)i)];
    cvt_bf16_stream(a.sk, a.SKB, (size_t)PH * 2 * 128 * 128, gtid, gthreads);
    quant_u_i4_sliced(a.ut, (unsigned char*)a.UB, (float*)((unsigned char*)a.UB + 16 * MiB), gw, NGW, lane);
    cvt_fp4_sliced(a.vt, (unsigned char*)a.VB, (float*)((unsigned char*)a.VB + 16 * MiB), gtid, gthreads);
    rms_rows_phase(a.x, a.n1g, nullptr, gw, M, NGW, lane, a.H8, a.SH);
}

__device__ __forceinline__ float wave_incl_sum(float v, int lane) {
#pragma unroll
    for (int o = 1; o < 64; o <<= 1) { const float t = __shfl_up(v, o); if (lane >= o) v += t; }
    return v;
}
__device__ __forceinline__ float wave_incl_max(float v, int lane) {
#pragma unroll
    for (int o = 1; o < 64; o <<= 1) { const float t = __shfl_up(v, o); if (lane >= o) v = fmaxf(v, t); }
    return v;
}
struct ScanArgs { const float* Z16; float *CS, *ROWF, *COLF, *WINT, *EDEN, *WSW, *DECAY; };
__device__ __forceinline__ void p_scans(const ScanArgs& a, int gwave, int lane) {
    if (gwave < BATCH * MH) {
        const int bh = gwave, b = bh >> 2, hm = bh & 3; float m_prev = -1e30f;
        const float* zp = a.Z16 + ((size_t)b * T + lane) * 16; float ipn[4], fpn[4];
#pragma unroll
        for (int u = 0; u < 4; ++u) { ipn[u] = zp[(size_t)(64 * u) * 16 + hm]; fpn[u] = zp[(size_t)(64 * u) * 16 + 4 + hm]; }
        for (int c0 = 0; c0 < NCH; c0 += 4) {
            float ipc[4], fpc[4];
#pragma unroll
            for (int u = 0; u < 4; ++u) { ipc[u] = ipn[u]; fpc[u] = fpn[u]; }
            if (c0 + 4 < NCH) {
#pragma unroll
                for (int u = 0; u < 4; ++u) { ipn[u] = zp[(size_t)(64 * (c0 + 4 + u)) * 16 + hm]; fpn[u] = zp[(size_t)(64 * (c0 + 4 + u)) * 16 + 4 + hm]; } }
#pragma unroll
            for (int u = 0; u < 4; ++u) { const int c = c0 + u; const size_t gi = (size_t)bh * T + 64 * c + lane;
                const float ip = ipc[u], fp = fpc[u];
                const float bt = wave_incl_sum(logsigf_(fp), lane), g = __shfl(bt, 63);
                const float at = ip - bt, pm = wave_incl_max(at, lane), amax = __shfl(pm, 63);
                const float mt = fmaxf(bt + pm, bt + m_prev), m_new = fmaxf(g + m_prev, g + amax);
                a.ROWF[gi] = bt - mt; a.COLF[gi] = at; a.WINT[gi] = __expf(bt - mt + m_prev); a.EDEN[gi] = __expf(-mt); a.WSW[gi] = __expf(at + g - m_new);
                if (lane == 0) a.DECAY[bh * NCH + c] = __expf(g + m_prev - m_new);
                m_prev = m_new; }
        }
    } else if (gwave < BATCH * MH + BATCH * FH) {
        const int bh = gwave - BATCH * MH, b = bh >> 3, hf = bh & 7; float carry = 0.f;
        const float* zp = a.Z16 + ((size_t)b * T + lane) * 16 + 8 + hf; float fn[4];
#pragma unroll
        for (int u = 0; u < 4; ++u) fn[u] = zp[(size_t)(64 * u) * 16];
        for (int c0 = 0; c0 < NCH; c0 += 4) {
            float fc[4];
#pragma unroll
            for (int u = 0; u < 4; ++u) fc[u] = fn[u];
            if (c0 + 4 < NCH) {
#pragma unroll
                for (int u = 0; u < 4; ++u) fn[u] = zp[(size_t)(64 * (c0 + 4 + u)) * 16]; }
#pragma unroll
            for (int u = 0; u < 4; ++u) { const int c = c0 + u;
                const float s = wave_incl_sum(logsigf_(fc[u]), lane) + carry;
                a.CS[(size_t)bh * T + 64 * c + lane] = -s * 11.313708498984761f;
                carry = __shfl(s, 63); }
        }
    }
}

__device__ __forceinline__ void qknorm_vals(const v4u a, const v4u b, bf16raw* row, const f32x4 (&g)[4], int lane, float (&v)[16]) {
    v4u* p = (v4u*)(row + 16 * lane);
    const unsigned w[8] = {a.x, a.y, a.z, a.w, b.x, b.y, b.z, b.w};
    float s = 0.f;
#pragma unroll
    for (int i = 0; i < 8; ++i) { v[2 * i] = bflo(w[i]); v[2 * i + 1] = bfhi(w[i]); s += v[2 * i] * v[2 * i] + v[2 * i + 1] * v[2 * i + 1]; }
    s = row8_sum(s);
    const float rstd = __builtin_amdgcn_rsqf(s * (1.f / 128.f) + EPS);
    unsigned o[8];
#pragma unroll
    for (int i = 0; i < 4; ++i) { const f32x4 gg = g[i]; o[2 * i] = pk2(v[4 * i] * rstd * gg.x, v[4 * i + 1] * rstd * gg.y); o[2 * i + 1] = pk2(v[4 * i + 2] * rstd * gg.z, v[4 * i + 3] * rstd * gg.w); }
#pragma unroll
    for (int i = 0; i < 8; ++i) { v[2 * i] = bflo(o[i]); v[2 * i + 1] = bfhi(o[i]); }
    p[0] = (v4u){o[0], o[1], o[2], o[3]}; p[1] = (v4u){o[4], o[5], o[6], o[7]};
}
struct QkRow { v4u qa, qb, ka, kb; };
__device__ __forceinline__ void qk_load(const bf16raw* FQ, const bf16raw* FK, int m, int lane, QkRow& r) {
    const v4u* pq = (const v4u*)(FQ + (size_t)m * D + 16 * lane); const v4u* pk = (const v4u*)(FK + (size_t)m * D + 16 * lane); r.qa = pq[0]; r.qb = pq[1]; r.ka = pk[0]; r.kb = pk[1];
}
__device__ __forceinline__ void p2b_qknorm(bf16raw* FQ, bf16raw* FK, const float* qg, const float* kg, float* DQK, int gw, int NGW, int lane) {
    f32x4 gq[4], gk[4];
#pragma unroll
    for (int i = 0; i < 4; ++i) { gq[i] = ((const f32x4*)(qg + 16 * (lane & 7)))[i]; gk[i] = ((const f32x4*)(kg + 16 * (lane & 7)))[i]; }
    rows_pipe3<QkRow>(gw, M, NGW, [&](int m, QkRow& r) { qk_load(FQ, FK, m, lane, r); },
        [&](int m, const QkRow& c0) { float vq[16], vk[16];
            qknorm_vals(c0.qa, c0.qb, FQ + (size_t)m * D, gq, lane, vq); qknorm_vals(c0.ka, c0.kb, FK + (size_t)m * D, gk, lane, vk);
            float d = 0.f;
#pragma unroll
            for (int i = 0; i < 16; ++i) d += vq[i] * vk[i];
            d = row8_sum(d);
            if ((lane & 7) == 0) DQK[(size_t)m * 8 + (lane >> 3)] = d; });
}

struct HmRow { v4u a, b, ma; };
__device__ __forceinline__ void p4_hmnorm(const bf16raw* HR, const signed char* MO, const float* gain, signed char* HM8, float* SHM, int m0, int m1, int mstep, int lane) {
    f32x4 g[4];
#pragma unroll
    for (int i = 0; i < 4; ++i) g[i] = ((const f32x4*)(gain + 16 * lane))[i];
    rows_pipe3<HmRow>(m0, m1, mstep, [&](int m, HmRow& r) { const v4u* p = (const v4u*)(HR + (size_t)m * D + 16 * lane); r.a = p[0]; r.b = p[1]; r.ma = *(const v4u*)(MO + (size_t)m * D + 16 * lane); },
        [&](int m, const HmRow& r) {
        const unsigned w[8] = {r.a.x, r.a.y, r.a.z, r.a.w, r.b.x, r.b.y, r.b.z, r.b.w}, mw[4] = {r.ma.x, r.ma.y, r.ma.z, r.ma.w};
        float v[16]; float s = 0.f;
#pragma unroll
        for (int i = 0; i < 8; ++i) { v[2 * i] = bflo(w[i]); v[2 * i + 1] = bfhi(w[i]); s += v[2 * i] * v[2 * i] + v[2 * i + 1] * v[2 * i + 1]; }
        s = row16_sum(s);
        const float rstd = __builtin_amdgcn_rsqf(s * (1.f / 256.f) + EPS);
        float mx = 0.f;
#pragma unroll
        for (int i = 0; i < 4; ++i) { const f32x4 gg = g[i];
            v[4 * i] *= rstd * gg.x * sigmoidf_(pg8::q8f(mw[i], 0)); v[4 * i + 1] *= rstd * gg.y * sigmoidf_(pg8::q8f(mw[i], 1)); v[4 * i + 2] *= rstd * gg.z * sigmoidf_(pg8::q8f(mw[i], 2)); v[4 * i + 3] *= rstd * gg.w * sigmoidf_(pg8::q8f(mw[i], 3));
            mx = fmaxf(fmaxf(mx, fmaxf(fabsf(v[4 * i]), fabsf(v[4 * i + 1]))), fmaxf(fabsf(v[4 * i + 2]), fabsf(v[4 * i + 3]))); }
        mx = wave_max_dpp(mx);
        const float sc = fmaxf(mx, 1e-30f) * (1.f / 127.f), inv = __builtin_amdgcn_rcpf(sc); if (lane == 0) SHM[m] = sc;
        unsigned o4[4];
#pragma unroll
        for (int i = 0; i < 4; ++i) o4[i] = q8x4_pack(v[4 * i], v[4 * i + 1], v[4 * i + 2], v[4 * i + 3], inv);
        *(v4u*)(HM8 + (size_t)m * D + 16 * lane) = (v4u){o4[0], o4[1], o4[2], o4[3]}; });
}
constexpr int P2_RP = 264;
constexpr int P2_QS = 0, P2_KS = 33792, P2_VS = 67584, P2_DSL = 101376, P2_KB = P2_DSL + 256;
struct P2Args { const bf16raw *MQ, *MK, *MV; const float* conv_w; bf16raw *QC, *KWT, *VT, *SP; float *KBAR, *DSUM; const float *ROWF, *COLF, *WSW; };
struct P2Raw { v4u q[7], k[7], v[4]; };
__device__ __forceinline__ void p2_load(const P2Args& a, P2Raw& r, int unit, int rg, int cc) {
    const int bh = unit / NCH, c = unit % NCH, b = bh >> 2, hm = bh & 3; const size_t col = (size_t)256 * hm + 8 * cc;
#pragma unroll
    for (int i = 0; i < 7; ++i) { const int tm = 64 * c + 4 * rg - 3 + i; const size_t o = ((size_t)b * T + (tm < 0 ? 0 : tm)) * D + col;
        const v4u z = (v4u){0u, 0u, 0u, 0u}; const v4u qv = *(const v4u*)(a.MQ + o), kv = *(const v4u*)(a.MK + o); r.q[i] = tm < 0 ? z : qv; r.k[i] = tm < 0 ? z : kv; }
#pragma unroll
    for (int i = 0; i < 4; ++i) r.v[i] = *(const v4u*)(a.MV + ((size_t)b * T + 64 * c + 4 * rg + i) * D + col);
}
__device__ __forceinline__ void p2_conv_row(const v4u (&x)[7], int i, const float (&w)[4][8], float (&o)[8]) {
#pragma unroll
    for (int e = 0; e < 8; ++e) o[e] = 0.f;
#pragma unroll
    for (int j = 0; j < 4; ++j) { const v4u xv = x[i + j];
        o[0] += w[j][0] * bflo(xv.x); o[1] += w[j][1] * bfhi(xv.x); o[2] += w[j][2] * bflo(xv.y); o[3] += w[j][3] * bfhi(xv.y);
        o[4] += w[j][4] * bflo(xv.z); o[5] += w[j][5] * bfhi(xv.z); o[6] += w[j][6] * bflo(xv.w); o[7] += w[j][7] * bfhi(xv.w); }
#pragma unroll
    for (int e = 0; e < 8; ++e) o[e] = o[e] * sigmoidf_(o[e]);
}
__device__ __forceinline__ void p2_prep(LAS unsigned char* lds, const P2Args& a, int vcu, int G, int wave, int lane, int tid) {
    LAS bf16raw* qs = (LAS bf16raw*)(lds + P2_QS); LAS bf16raw* ks = (LAS bf16raw*)(lds + P2_KS); LAS bf16raw* vs = (LAS bf16raw*)(lds + P2_VS);
    LAS float* dsl = (LAS float*)(lds + P2_DSL); LAS float* kbp = (LAS float*)(lds + P2_KB);
    const int rg = tid >> 5, cc = tid & 31;
    int unit = vcu; if (unit >= BATCH * MH * NCH) return;
    P2Raw raw; p2_load(a, raw, unit, rg, cc);
    for (; unit < BATCH * MH * NCH; unit += G) {
        const int bh = unit / NCH, c = unit % NCH, b = bh >> 2, hm = bh & 3, ch0 = 256 * hm; const size_t tok0 = (size_t)b * T + 64 * c, gi0 = (size_t)bh * T + 64 * c;
        float wq[4][8], wk[4][8];
#pragma unroll
        for (int j = 0; j < 4; ++j) { const f32x4 a0 = *(const f32x4*)(a.conv_w + j * 2048 + ch0 + 8 * cc), a1 = *(const f32x4*)(a.conv_w + j * 2048 + ch0 + 8 * cc + 4), b0 = *(const f32x4*)(a.conv_w + j * 2048 + 1024 + ch0 + 8 * cc), b1 = *(const f32x4*)(a.conv_w + j * 2048 + 1024 + ch0 + 8 * cc + 4);
            wq[j][0] = a0.x; wq[j][1] = a0.y; wq[j][2] = a0.z; wq[j][3] = a0.w; wq[j][4] = a1.x; wq[j][5] = a1.y; wq[j][6] = a1.z; wq[j][7] = a1.w;
            wk[j][0] = b0.x; wk[j][1] = b0.y; wk[j][2] = b0.z; wk[j][3] = b0.w; wk[j][4] = b1.x; wk[j][5] = b1.y; wk[j][6] = b1.z; wk[j][7] = b1.w; }
        if (tid < 64) dsl[tid] = 0.f;
#pragma unroll
        for (int i = 0; i < 4; ++i) { const int r = 4 * rg + i; float o[8];
            p2_conv_row(raw.q, i, wq, o);
            const v4u pq = (v4u){pk2(o[0] * 0.0625f, o[1] * 0.0625f), pk2(o[2] * 0.0625f, o[3] * 0.0625f), pk2(o[4] * 0.0625f, o[5] * 0.0625f), pk2(o[6] * 0.0625f, o[7] * 0.0625f)};
            *(LAS v4u*)(qs + r * P2_RP + 8 * cc) = pq; *(v4u*)(a.QC + (tok0 + r) * D + ch0 + 8 * cc) = pq;
            p2_conv_row(raw.k, i, wk, o);
            *(LAS v4u*)(ks + r * P2_RP + 8 * cc) = (v4u){pk2(o[0], o[1]), pk2(o[2], o[3]), pk2(o[4], o[5]), pk2(o[6], o[7])};
            *(LAS v4u*)(vs + r * P2_RP + 8 * cc) = raw.v[i]; }
        if (unit + G < BATCH * MH * NCH) p2_load(a, raw, unit + G, rg, cc);
        __syncthreads();
        { const int sch = tid & 7; const f32x4 w0 = *(const f32x4*)(a.WSW + gi0 + 8 * sch), w1 = *(const f32x4*)(a.WSW + gi0 + 8 * sch + 4);
          const float ww[8] = {w0.x, w0.y, w0.z, w0.w, w1.x, w1.y, w1.z, w1.w};
#pragma unroll
          for (int q = 0; q < 4; ++q) { const int dk = (tid >> 3) + 64 * q; unsigned hb[8]; float part = 0.f;
#pragma unroll
              for (int e = 0; e < 8; ++e) { const float kv = bf1(ks[(8 * sch + e) * P2_RP + dk]) * ww[e]; hb[e] = f2bf(kv); part += bf1((bf16raw)hb[e]); }
              *(v4u*)(a.KWT + (size_t)unit * 16384 + dk * 64 + 8 * sch) = (v4u){hb[0] | (hb[1] << 16), hb[2] | (hb[3] << 16), hb[4] | (hb[5] << 16), hb[6] | (hb[7] << 16)};
              part = dpp_add<0xB1>(part); part = dpp_add<0x4E>(part); part = dpp_add<0x141>(part);
              if (sch == 0) a.KBAR[(size_t)unit * 256 + dk] = part;
#pragma unroll
              for (int e = 0; e < 8; ++e) hb[e] = vs[(8 * sch + e) * P2_RP + dk];
              *(v4u*)(a.VT + (size_t)unit * 16384 + dk * 64 + 8 * sch) = (v4u){hb[0] | (hb[1] << 16), hb[2] | (hb[3] << 16), hb[4] | (hb[5] << 16), hb[6] | (hb[7] << 16)}; }
          const int rb = wave >> 1, m = lane & 15, kg = lane >> 4;
#pragma unroll
          for (int cbi = 0; cbi < 2; ++cbi) { const int cb = 2 * (wave & 1) + cbi;
              f32x4 acc = (f32x4){0.f, 0.f, 0.f, 0.f};
              if (cb <= rb) {
#pragma unroll
                  for (int kk = 0; kk < 8; ++kk) { const bf16x8 af = *(const LAS bf16x8*)(ks + (16 * cb + m) * P2_RP + 32 * kk + 8 * kg), bfr = *(const LAS bf16x8*)(qs + (16 * rb + m) * P2_RP + 32 * kk + 8 * kg);
                      acc = __builtin_amdgcn_mfma_f32_16x16x32_bf16(af, bfr, acc, 0, 0, 0); } }
              const int t = 16 * rb + m, s0 = 16 * cb + 4 * kg; const float rf = a.ROWF[gi0 + t]; const f32x4 cf = *(const f32x4*)(a.COLF + gi0 + s0);
              unsigned hb[4]; float sum = 0.f;
#pragma unroll
              for (int r = 0; r < 4; ++r) { const float v = (s0 + r <= t) ? acc[r] * __expf(rf + cf[r]) : 0.f; hb[r] = f2bf(v); sum += bf1((bf16raw)hb[r]); }
              *(v2u*)(a.SP + (size_t)unit * 4096 + t * 64 + s0) = (v2u){hb[0] | (hb[1] << 16), hb[2] | (hb[3] << 16)};
              sum += __shfl_xor(sum, 16); sum += __shfl_xor(sum, 32);
              if (kg == 0) atomicAdd((float*)(dsl + t), sum); } }
        __syncthreads();
        if (tid < 64) a.DSUM[gi0 + tid] = dsl[tid];
        __syncthreads();
    }
}

constexpr int P3_CP = 264, P3_SP = 72;
constexpr int P3W = 128;
constexpr int P3_CT = 0, P3_NL = P3_CT + P3W * P3_CP * 2, P3_QN = P3_NL + 1024, P3_QS = P3_QN + 256, P3_SS = P3_QS + 64 * P3_CP * 2, P3_VS = P3_SS + 64 * P3_SP * 2, P3_GS = P3_VS + 2 * P3W * P3_SP * 2, P3_END = P3_GS + 2 * 768;
static_assert(P3_END <= LDS_MISC, "mLSTM LDS map");
struct P3Args { const bf16raw *QC, *KWT, *VT, *SP; const float *KBAR, *DSUM, *WINT, *EDEN, *DECAY; bf16raw* HR; };
typedef __amdgpu_buffer_rsrc_t rsrc_t;
__device__ __forceinline__ rsrc_t mk_rsrc(const void* p, unsigned nbytes) { return __builtin_amdgcn_make_buffer_rsrc((void*)p, (short)0, (int)nbytes, 0x00020000); }
__device__ __forceinline__ v4u bld(rsrc_t r, unsigned voff, unsigned soff) { return __builtin_bit_cast(v4u, __builtin_amdgcn_raw_buffer_load_b128(r, (int)voff, (int)soff, 0)); }
struct P3Stage { v4u q[4], s, v[2], gt; float decay, kb; };
__device__ __forceinline__ void p3_stage_load(const P3Args& a, rsrc_t rq, rsrc_t rs, rsrc_t rv, P3Stage& g, int bh, int b, int hm, int j, int c, int tid) {
    const unsigned uc = (unsigned)(bh * NCH + c), tok0 = (unsigned)(b * T + 64 * c);
#pragma unroll
    for (int k = 0; k < 4; ++k) g.q[k] = bld(rq, (unsigned)(((tid >> 5) + 16 * k) * 2048 + 512 * hm + 16 * (tid & 31)), tok0 * 2048u);
    g.s = bld(rs, (unsigned)((tid >> 3) * 128 + 16 * (tid & 7)), uc * 8192u);
#pragma unroll
    for (int k = 0; k < 2; ++k) g.v[k] = bld(rv, (unsigned)((P3W * j + (tid >> 3) + 64 * k) * 128 + 16 * (tid & 7)), uc * 32768u);
    g.decay = a.DECAY[uc]; g.kb = (tid < 256) ? a.KBAR[(size_t)uc * 256 + tid] : 0.f;
    if (tid < 48) { const long long o1 = (const char*)a.EDEN - (const char*)a.WINT, o2 = (const char*)a.DSUM - (const char*)a.WINT; const long long go = tid < 16 ? 0ll : (tid < 32 ? o1 : o2);
        g.gt = *(const v4u*)((const char*)a.WINT + go + ((size_t)bh * T + 64 * c + 4 * (tid & 15)) * 4); }
}
__device__ __forceinline__ void p3_stage_write_qs(LAS unsigned char* lds, const P3Stage& g, int tid) {
#pragma unroll
    for (int k = 0; k < 4; ++k) *(LAS v4u*)(lds + P3_QS + ((tid >> 5) + 16 * k) * (P3_CP * 2) + 16 * (tid & 31)) = g.q[k];
    *(LAS v4u*)(lds + P3_SS + (tid >> 3) * (P3_SP * 2) + 16 * (tid & 7)) = g.s;
}
__device__ __forceinline__ void p3_stage_write_v(LAS unsigned char* lds, const P3Stage& g, int buf, int tid) {
    if (tid < 48) *(LAS v4u*)(lds + P3_GS + buf * 768 + 16 * tid) = g.gt;
#pragma unroll
    for (int k = 0; k < 2; ++k) *(LAS v4u*)(lds + P3_VS + buf * (P3W * P3_SP * 2) + ((tid >> 3) + 64 * k) * (P3_SP * 2) + 16 * (tid & 7)) = g.v[k];
}
#define P3_BAR() do { asm volatile("s_waitcnt lgkmcnt(0)" ::: "memory"); __builtin_amdgcn_s_barrier(); asm volatile("" ::: "memory"); } while (0)
__device__ __forceinline__ void p3_mlstm(LAS unsigned char* lds, const P3Args& a, int vcu, int G, int wave, int lane, int tid, unsigned* chkflag = nullptr) {
    if (vcu & 3) return;
    for (int unit = vcu >> 2; unit < BATCH * MH * 2; unit += (G + 3) >> 2) {
        const int bh = unit >> 1, j = unit & 1, b = bh >> 2, hm = bh & 3;
        const int rb = wave >> 2, cg = wave & 3, m32 = lane & 31, hh = lane >> 5;
        f32x16 accC[4];
#pragma unroll
        for (int ti = 0; ti < 4; ++ti)
#pragma unroll
            for (int r = 0; r < 16; ++r) accC[ti][r] = 0.f;
        float nst = 0.f;
        const rsrc_t rq = mk_rsrc(a.QC, 0x8000000u), rs = mk_rsrc(a.SP, 0x2000000u), rv = mk_rsrc(a.VT, 0x8000000u), rk = mk_rsrc(a.KWT, 0x8000000u);
        __syncthreads();
        for (int i = tid; i < (P3_QS - P3_CT) / 4; i += NTHR) ((LAS unsigned*)(lds + P3_CT))[i] = 0u;
        P3Stage sg; p3_stage_load(a, rq, rs, rv, sg, bh, b, hm, j, 0, tid);
        p3_stage_write_qs(lds, sg, tid); p3_stage_write_v(lds, sg, 0, tid);
        float decay = sg.decay, kb = sg.kb;
        p3_stage_load(a, rq, rs, rv, sg, bh, b, hm, j, 1, tid);
        bf16x8 kA[4];
#pragma unroll
        for (int kk = 0; kk < 4; ++kk) kA[kk] = __builtin_bit_cast(bf16x8, bld(rk, (unsigned)((32 * wave + m32) * 128 + 32 * kk + 16 * hh), (unsigned)(bh * NCH) * 32768u));
        __syncthreads();
        for (int c = 0; c < NCH; ++c) {
            const int vb = c & 1; const unsigned uc = (unsigned)(bh * NCH + c); const size_t tok0 = (size_t)b * T + 64 * c, gi0 = (size_t)bh * T + 64 * c;
            { const int t = tid >> 3, part = tid & 7; float s = 0.f;
#pragma unroll
              for (int q4 = 0; q4 < 4; ++q4) { const v4u qv = *(const LAS v4u*)(lds + P3_QS + t * (P3_CP * 2) + part * 64 + 16 * q4);
                  const f32x4 n0 = *(const LAS f32x4*)(lds + P3_NL + (32 * part + 8 * q4) * 4), n1 = *(const LAS f32x4*)(lds + P3_NL + (32 * part + 8 * q4 + 4) * 4);
                  s += bflo(qv.x) * n0.x + bfhi(qv.x) * n0.y + bflo(qv.y) * n0.z + bfhi(qv.y) * n0.w + bflo(qv.z) * n1.x + bfhi(qv.z) * n1.y + bflo(qv.w) * n1.z + bfhi(qv.w) * n1.w; }
              s = dpp_add<0xB1>(s); s = dpp_add<0x4E>(s); s = dpp_add<0x141>(s);
              if (part == 0) *(LAS float*)(lds + P3_QN + 4 * t) = s; }
            f32x16 accQ, accS;
#pragma unroll
            for (int r = 0; r < 16; ++r) { accQ[r] = 0.f; accS[r] = 0.f; }
#pragma unroll
            for (int kk = 0; kk < 16; ++kk) { const bf16x8 af = *(const LAS bf16x8*)(lds + P3_QS + (32 * rb + m32) * (P3_CP * 2) + 32 * kk + 16 * hh), bf = *(const LAS bf16x8*)(lds + P3_CT + (32 * cg + m32) * (P3_CP * 2) + 32 * kk + 16 * hh);
                accQ = __builtin_amdgcn_mfma_f32_32x32x16_bf16(af, bf, accQ, 0, 0, 0); }
#pragma unroll
            for (int kk = 0; kk < 4; ++kk) { const bf16x8 af = *(const LAS bf16x8*)(lds + P3_SS + (32 * rb + m32) * (P3_SP * 2) + 32 * kk + 16 * hh), bf = *(const LAS bf16x8*)(lds + P3_VS + vb * (P3W * P3_SP * 2) + (32 * cg + m32) * (P3_SP * 2) + 32 * kk + 16 * hh);
                accS = __builtin_amdgcn_mfma_f32_32x32x16_bf16(af, bf, accS, 0, 0, 0); }
            P3_BAR();
            p3_stage_write_qs(lds, sg, tid); p3_stage_write_v(lds, sg, vb ^ 1, tid);
            const float decay_n = sg.decay, kb_n = sg.kb;
            p3_stage_load(a, rq, rs, rv, sg, bh, b, hm, j, c + 2 < NCH ? c + 2 : NCH - 1, tid);
#pragma unroll
            for (int g = 0; g < 4; ++g) { const f32x4 qn = *(const LAS f32x4*)(lds + P3_QN + (32 * rb + 8 * g + 4 * hh) * 4);
                const int ro = (32 * rb + 8 * g + 4 * hh) * 4; const f32x4 wi = *(const LAS f32x4*)(lds + P3_GS + vb * 768 + ro), ed = *(const LAS f32x4*)(lds + P3_GS + vb * 768 + 256 + ro), ds = *(const LAS f32x4*)(lds + P3_GS + vb * 768 + 512 + ro);
#pragma unroll
                for (int i = 0; i < 4; ++i) { const float den = ds[i] + wi[i] * qn[i]; const float hv = (accS[4 * g + i] + wi[i] * accQ[4 * g + i]) * __builtin_amdgcn_rcpf(fmaxf(fabsf(den), ed[i]));
                    { bf16raw* hp = a.HR + (tok0 + 32 * rb + 8 * g + 4 * hh + i) * D + 256 * hm + P3W * j + 32 * cg + m32; const bf16raw hb = (bf16raw)f2bf(hv);
                      if (chkflag) { if (*hp != hb) atomicOr(chkflag, 1u << (c & 31)); } else *hp = hb; } } }
#pragma unroll
            for (int ti = 0; ti < 4; ++ti) {
#pragma unroll
                for (int r = 0; r < 16; ++r) accC[ti][r] *= decay;
#pragma unroll
                for (int kk = 0; kk < 4; ++kk) { const bf16x8 bf = *(const LAS bf16x8*)(lds + P3_VS + vb * (P3W * P3_SP * 2) + (32 * ti + m32) * (P3_SP * 2) + 32 * kk + 16 * hh);
                    accC[ti] = __builtin_amdgcn_mfma_f32_32x32x16_bf16(kA[kk], bf, accC[ti], 0, 0, 0); }
#pragma unroll
                for (int g = 0; g < 4; ++g) *(LAS v2u*)(lds + P3_CT + (32 * ti + m32) * (P3_CP * 2) + (32 * wave + 8 * g + 4 * hh) * 2) = (v2u){pk2(accC[ti][4 * g], accC[ti][4 * g + 1]), pk2(accC[ti][4 * g + 2], accC[ti][4 * g + 3])}; }
            { const unsigned un = (unsigned)(bh * NCH + (c + 1 < NCH ? c + 1 : c));
#pragma unroll
              for (int kk = 0; kk < 4; ++kk) kA[kk] = __builtin_bit_cast(bf16x8, bld(rk, (unsigned)((32 * wave + m32) * 128 + 32 * kk + 16 * hh), un * 32768u)); }
            if (tid < 256) { nst = decay * nst + kb; *(LAS float*)(lds + P3_NL + 4 * tid) = nst; }
            decay = decay_n; kb = kb_n;
            P3_BAR();
        }
    }
}
#ifndef DBG_STAGE
#define DBG_STAGE 3
#endif
#ifndef FP8A
#define FP8A 1
#endif
#ifndef FP8B
#define FP8B 1
#endif
#ifndef FP8C
#define FP8C 1
#endif
#ifndef MK_ONE_LAUNCH
#define MK_ONE_LAUNCH 0
#endif
#ifndef PROBE_DUP
#define PROBE_DUP -1
#endif
#define NREP(k) ((PROBE_DUP == (k)) ? 2 : 1)
constexpr int NPH = 20;
struct Args { const float* in[16]; float* out; unsigned char* ws; int ph_lo, ph_hi; };
__global__ void __launch_bounds__(NTHR, 2) fwd(Args args) {
    extern __shared__ __attribute__((aligned(16))) unsigned char lds_raw[];
    LAS unsigned char* lds = (LAS unsigned char*)lds_raw;
#define PH_IDS int tid = threadIdx.x; asm volatile("" : "+v"(tid)); const int lane = tid & 63; (void)lane; const int wave = __builtin_amdgcn_readfirstlane(tid >> 6); \
    const __attribute__((address_space(4))) Args* ap_ = (const __attribute__((address_space(4))) Args*)__builtin_amdgcn_kernarg_segment_ptr(); asm volatile("" : "+s"(ap_)); \
    int G = gridDim.x; asm volatile("" : "+s"(G)); const int bx = blockIdx.x, vcu = (G % 8 == 0) ? (bx % 8) * (G / 8) + bx / 8 : bx; const int gw = vcu * NWAVES + wave, NGW = G * NWAVES; (void)gw; (void)NGW;
    if (threadIdx.x < 4) ((LAS unsigned*)(lds + LDS_MISC))[threadIdx.x] = 0u;
    __syncthreads();
#if MK_ONE_LAUNCH
    XcdBarrier bar = xcd_barrier_post((unsigned*)(args.ws + WS_CTL) + CW_BAR, (volatile LAS unsigned*)(lds + LDS_MISC));
#define GRID_BAR() xcd_barrier(bar)
#else
#define GRID_BAR() do {} while (0)
#endif
#define A_x ((const float*)ap_->in[0])
#define A_n1g ((const float*)ap_->in[1])
#define A_w_in ((const float*)ap_->in[2])
#define A_b_in ((const float*)ap_->in[3])
#define A_conv_w ((const float*)ap_->in[4])
#define A_mng ((const float*)ap_->in[5])
#define A_qng ((const float*)ap_->in[6])
#define A_kng ((const float*)ap_->in[7])
#define A_wm ((const float*)ap_->in[8])
#define A_wf ((const float*)ap_->in[9])
#define A_wo ((const float*)ap_->in[10])
#define A_n2g ((const float*)ap_->in[11])
#define A_wpq ((const float*)ap_->in[12])
#define A_skeys ((const float*)ap_->in[13])
#define A_utab ((const float*)ap_->in[14])
#define A_vtab ((const float*)ap_->in[15])
#define A_out (ap_->out)
#define RB(i) ((bf16raw*)(ap_->ws + WS_R0 + (size_t)(i) * RSZ))
#define A_O0 ((bf16raw*)ap_->out)
#define A_O1 ((bf16raw*)((unsigned char*)ap_->out + RSZ))
#define A_WinT ((bf16raw*)(ap_->ws + WS_WINT))
#define A_WinTb ((bf16raw*)(ap_->ws + 208 * MiB))
#define A_SH ((float*)(ap_->ws + WS_JLO + 65536))
#define A_SW ((float*)(ap_->ws + 13 * MiB + 163840))
#define A_SX ((float*)(ap_->ws + WS_JLO + 65536 + 262144))
#define A_SHM ((float*)(ap_->ws + WS_WGT))
#define A_XQ ((signed char*)RB(3))
#define A_XH ((unsigned char*)RB(3) + 64 * MiB)
#define A_XL ((unsigned char*)RB(3) + 96 * MiB)
#define A_SU ((const float*)((unsigned char*)A_UB + 16 * MiB))
#define A_SV ((const float*)((unsigned char*)A_VB + 16 * MiB))
#define A_W8 ((unsigned char*)A_VB + 24 * MiB)
#define A_WSC ((float*)((unsigned char*)A_VB + 40 * MiB))
#define A_WgT ((bf16raw*)(ap_->ws + WS_WGT))
#define A_WmT ((bf16raw*)(ap_->ws + WS_WMT))
#define A_WfT ((bf16raw*)(ap_->ws + WS_WFT))
#define A_WoT ((bf16raw*)(ap_->ws + WS_WOT))
#define A_WpqT ((bf16raw*)(ap_->ws + WS_WPQT))
#define A_SKB ((bf16raw*)(ap_->ws + WS_SKB))
#define A_UB ((bf16raw*)(ap_->ws + WS_UB))
#define A_VB ((bf16raw*)(ap_->ws + WS_VB))
#define A_biasP ((float*)(ap_->ws + WS_BIASP))
#define A_biasG ((float*)(ap_->ws + WS_BIASG))
#define A_Z16 ((float*)(ap_->ws + WS_Z16))
#define A_CS ((float*)(ap_->ws + WS_CS))
#define A_ROWF ((float*)(ap_->ws + WS_GROWF))
#define A_COLF ((float*)(ap_->ws + WS_GCOLF))
#define A_WINT ((float*)(ap_->ws + WS_GWINT))
#define A_EDEN ((float*)(ap_->ws + WS_GEDEN))
#define A_WSW ((float*)(ap_->ws + WS_GWSW))
#define A_DECAY ((float*)(ap_->ws + WS_GDECAY))
#define A_KBAR ((float*)(ap_->ws + WS_KBAR))
#define A_DSUM ((float*)(ap_->ws + WS_DSUM))
#define A_SP ((bf16raw*)(ap_->ws + WS_SP))
#define A_IDS ((unsigned short*)(ap_->ws + WS_IDS))
#define A_GWT ((float*)(ap_->ws + WS_GW))
#define A_JLO ((int*)(ap_->ws + WS_JLO))
#define A_DQK ((float*)(ap_->ws + 208 * MiB + 32 * MiB))
#define A_H8 ((unsigned char*)(ap_->ws + WS_IDS))
    const int lo = args.ph_lo, hi = args.ph_hi;
#define IN(k) (lo <= (k) && (k) < hi)
#define SEAM(k) do { if (IN((k) + 1)) GRID_BAR(); } while (0)
    constexpr size_t RS_E = RSZ / 2;

    if (IN(0)) { PH_IDS P0Args a{A_x, A_n1g, A_w_in, A_b_in, A_wm, A_wf, A_wo, A_wpq, A_skeys, A_utab, A_vtab, A_WinT, A_WgT, A_WmT, A_WfT, A_WoT, A_WpqT, A_SKB, A_UB, A_VB, RB(0), A_biasP, A_biasG, A_H8, A_WinTb, A_SH, (unsigned*)(ap_->ws + WS_CTL) + CW_CMAX};
        for (int rep = 0; rep < NREP(0); ++rep) { p0_prologue(lds, a, vcu, G, wave, lane, tid); __syncthreads(); } SEAM(0); }
    if (IN(1)) { PH_IDS p0b_quant_w(lds, A_w_in, A_wpq, A_wm, (signed char*)A_WinT, A_SW, (const unsigned*)(ap_->ws + WS_CTL) + CW_CMAX, gw, NGW, wave, lane); SEAM(1); }
    if (IN(2)) { PH_IDS
        { pg8::Gemm g{(const bf16raw*)A_H8, A_WinT + (size_t)12288 * D / 2, M, 256, D / 2}; pg8::StaticOrder S; S.init(M, 256, G, bx); pg8::EpiGates16I8 E{A_Z16, A_biasG, A_SW + 12288, A_SH};
          pg8::gemm_phase<pg8::EpiGates16I8, pg8::StaticOrder, false, true, 2>(lds, g, S, E); }
        SEAM(2); }
    if (IN(3)) { PH_IDS
        if (bx * NWAVES + wave < BATCH * (MH + FH)) { ScanArgs a{A_Z16, A_CS, A_ROWF, A_COLF, A_WINT, A_EDEN, A_WSW, A_DECAY}; p_scans(a, bx * NWAVES + wave, lane); }
        __syncthreads();
        { pg8::Gemm g{(const bf16raw*)A_H8, A_WinT, M, 3072, D / 2}; pg8::QueueOrder S; S.init(M, 3072, (unsigned*)(ap_->ws + WS_CTL) + CW_QM, (int)xb_xcc_id(), (LAS int*)(lds + LDS_MISC + 64)); S.prime(); __syncthreads();
          pg8::EpiI8 E{RB(1), D, A_biasP, A_SW, A_SH, RS_E};
          pg8::gemm_phase<pg8::EpiI8, pg8::QueueOrder, true, true, 2>(lds, g, S, E); }
        SEAM(3); }
    if (IN(4)) { PH_IDS
#if DBG_STAGE >= 2
        P2Args a{RB(1), RB(2), RB(3), A_conv_w, RB(4), RB(5), A_O0, A_SP, A_KBAR, A_DSUM, A_ROWF, A_COLF, A_WSW}; for (int rep = 0; rep < NREP(3); ++rep) p2_prep(lds, a, vcu, G, wave, lane, tid);
#endif
        SEAM(4); }
    if (IN(5)) { PH_IDS
#if FP8B
pg8::Gemm g{(const bf16raw*)A_H8, A_WinT + (size_t)3072 * D / 2, M, 3072, D / 2}; pg8::StaticOrder S; S.init(M, 3072, G, bx); pg8::EpiI8 E{RB(1), D, A_biasP + 3072, A_SW + 3072, A_SH, RS_E};
        pg8::gemm_phase<pg8::EpiI8, pg8::StaticOrder, true, true, 2>(lds, g, S, E);
#else
pg8::Gemm g{RB(0), A_WinTb + (size_t)3072 * D, M, 3072, D}; pg8::StaticOrder S; S.init(M, 3072, G, bx); pg8::EpiBf16<0> E{RB(1), D, A_biasP + 3072, 1024, RS_E, 1.f};
        pg8::gemm_phase<pg8::EpiBf16<0>, pg8::StaticOrder, true, true>(lds, g, S, E);
#endif
 SEAM(5); }
    if (IN(6)) { PH_IDS p2b_qknorm(RB(1), RB(2), A_qng, A_kng, A_DQK, gw, NGW, lane); SEAM(6); }
    if (IN(7)) { PH_IDS fox::jlo_table(A_CS, A_DQK, A_qng, A_kng, A_JLO, gw, NGW, lane); SEAM(7); }
    if (IN(8)) { PH_IDS
#if DBG_STAGE >= 2
        { P3Args a{RB(4), RB(5), A_O0, A_SP, A_KBAR, A_DSUM, A_WINT, A_EDEN, A_DECAY, A_O1}; { const int nrep = (PROBE_DUP == 60) ? (args.ph_hi - 18) : 1;
_Pragma("nounroll")
          for (int rep = 0; rep < nrep; ++rep) { p3_mlstm(lds, a, vcu, G, wave, lane, tid, rep ? (unsigned*)(ap_->ws + WS_CTL) + 16 : (unsigned*)nullptr); asm volatile("s_waitcnt vmcnt(0)" ::: "memory"); __syncthreads(); } } }
        __syncthreads();
#ifdef T1_BAR
        GRID_BAR();
#endif
#endif
        if (PROBE_DUP == 61) { fox::phase((char*)lds_raw, (const fox::bf16*)RB(1), (const fox::bf16*)RB(2), (const fox::bf16*)RB(3), (fox::bf16*)RB(0), A_CS, A_JLO, (unsigned*)(ap_->ws + WS_CTL) + CW_QF + 2048, (int)xb_xcc_id()); __syncthreads(); }
        fox::phase((char*)lds_raw, (const fox::bf16*)RB(1), (const fox::bf16*)RB(2), (const fox::bf16*)RB(3), (fox::bf16*)RB(1), A_CS, A_JLO, (unsigned*)(ap_->ws + WS_CTL) + CW_QF, (int)xb_xcc_id(), (unsigned*)(ap_->ws + WS_CTL) + CW_FDONE);
        __syncthreads();
        if (tid == 0) { const unsigned* fd = (const unsigned*)(ap_->ws + WS_CTL) + CW_FDONE; for (int spin = 0; spin < (1 << 22) && __hip_atomic_load(fd, __ATOMIC_RELAXED, __HIP_MEMORY_SCOPE_AGENT) < 2048u; ++spin) __builtin_amdgcn_s_sleep(16); }
        __syncthreads();
        { pg8::Gemm g{(const bf16raw*)A_H8, A_WinT + (size_t)6144 * D / 2, M, 3072, D / 2}; pg8::QueueOrder S; S.init(M, 3072, (unsigned*)(ap_->ws + WS_CTL) + CW_QG, (int)xb_xcc_id(), (LAS int*)(lds + LDS_MISC + 64)); S.prime(); __syncthreads();
          pg8::EpiQ8 E{(signed char*)RB(0), D, A_biasP + 6144, A_SW + 6144, A_SH, (size_t)64 * MiB, 3 * RSZ};
          pg8::gemm_phase<pg8::EpiQ8, pg8::QueueOrder, true, true, 2>(lds, g, S, E); }
        SEAM(8); }
    if (IN(10)) { PH_IDS
#if DBG_STAGE >= 2
        for (int rep = 0; rep < NREP(8); ++rep) p4_hmnorm(A_O1, (const signed char*)RB(0), A_mng, (signed char*)RB(2), A_SHM, gw, M, NGW, lane);
#endif
        SEAM(10); }
    if (IN(11)) { PH_IDS
        pg8::Gemm g0{RB(2), A_WinT + (size_t)11264 * D / 2, M, D, D / 2}, g1{RB(1), A_WfT, M, D, D}; pg8::StaticOrder S; S.init(M, D, G, bx);
        pg8::gemm_dual(lds, g0, g1, S, (const signed char*)RB(0) + 64 * MiB, (const signed char*)RB(3), A_SW + 11264, A_SHM, RB(5), D);
        SEAM(12); }
    if (IN(13)) { PH_IDS pg8::Gemm g{RB(5), A_WoT, M, D, D}; pg8::StaticOrder S; S.init(M, D, G, bx); pg8::EpiResB16 E{A_x, RB(0), D};
        pg8::gemm_phase<pg8::EpiResB16, pg8::StaticOrder, true, true>(lds, g, S, E); SEAM(13); }
#if DBG_STAGE >= 3
    if (IN(14)) { PH_IDS for (int rep = 0; rep < NREP(12); ++rep) rms_rows_phase_b16(RB(0), A_n2g, gw, M, NGW, lane, (unsigned char*)A_XQ, A_SX, A_XH, A_XL); SEAM(14); }
    if (IN(15)) { PH_IDS pg8::Gemm g{(const bf16raw*)A_XQ, A_WinT + (size_t)9216 * D / 2, M, 2048, D / 2}; pg8::StaticOrder S; S.init(M, 2048, G, bx); pg8::EpiI8 E{RB(1), 2048, nullptr, A_SW + 9216, A_SX, 0};
        pg8::gemm_phase<pg8::EpiI8, pg8::StaticOrder, true, true, 2>(lds, g, S, E); SEAM(15); }
    if (IN(16)) { PH_IDS P9Args a{RB(1), A_SKB, A_IDS, A_GWT}; for (int rep = 0; rep < NREP(14); ++rep) p9_topk(lds, a, vcu, G, wave, lane, tid); SEAM(16); }
    if (IN(17)) { PH_IDS if (PROBE_DUP == 15) p15_udot(A_XH, A_XL, (const unsigned char*)A_UB, A_IDS, (short*)RB(1), (unsigned*)(ap_->ws + WS_CTL) + CW_QU + 2048, (int)xb_xcc_id(), lane);
        p15_udot(A_XH, A_XL, (const unsigned char*)A_UB, A_IDS, (short*)RB(1), (unsigned*)(ap_->ws + WS_CTL) + CW_QU, (int)xb_xcc_id(), lane); SEAM(17); }
    if (IN(18)) { PH_IDS p15b_act((const short*)RB(1), A_GWT, A_W8, A_WSC, A_SX, A_SU, A_SV, A_IDS, gw, NGW, lane); SEAM(18); }
#ifndef PROBE_VMODE
#define PROBE_VMODE 0
#endif
    if (IN(19)) { PH_IDS if (PROBE_DUP == 17) p16_vsum<PROBE_VMODE>(lds, (const unsigned char*)A_VB, A_IDS, A_W8, A_WSC, RB(0), (float*)RB(2), (unsigned*)(ap_->ws + WS_CTL) + CW_QV + 2048, (int)xb_xcc_id(), wave, lane);
        p16_vsum(lds, (const unsigned char*)A_VB, A_IDS, A_W8, A_WSC, RB(0), A_out, (unsigned*)(ap_->ws + WS_CTL) + CW_QV, (int)xb_xcc_id(), wave, lane); }
#endif
#undef IN
#undef SEAM
}

extern "C" void kernel_launch(void* const* d_in, const int* in_sizes, int n_in, void* d_out, int out_size, void* d_ws, size_t ws_size, hipStream_t stream) {
    static int grid = 0;
    if (grid == 0) {
        if (n_in != 16 || out_size != M * D || ws_size < WS_END) { fprintf(stderr, "kernel_launch: unexpected shapes (n_in %d out %d ws %zu)\n", n_in, out_size, ws_size); grid = -1; return; }
        int dev = 0, cus = 0, per_cu = 0;
        if (hipGetDevice(&dev) != hipSuccess || hipDeviceGetAttribute(&cus, hipDeviceAttributeMultiprocessorCount, dev) != hipSuccess) { grid = -1; return; }
        if (hipFuncSetAttribute((const void*)fwd, hipFuncAttributeMaxDynamicSharedMemorySize, LDS_BYTES) != hipSuccess) { fprintf(stderr, "kernel_launch: hipFuncSetAttribute failed\n"); grid = -1; return; }
        if (hipOccupancyMaxActiveBlocksPerMultiprocessor(&per_cu, (const void*)fwd, NTHR, LDS_BYTES) != hipSuccess || per_cu < 1) { fprintf(stderr, "kernel_launch: occupancy query says %d\n", per_cu); grid = -1; (void)hipGetLastError(); return; }
        (void)hipGetLastError();
        grid = cus;
    }
    if (grid < 0) return;
    if (hipMemsetAsync((char*)d_ws + WS_CTL, 0, CTL_ZERO_BYTES, stream) != hipSuccess) return;
    Args a{};
    for (int i = 0; i < 16; ++i) a.in[i] = (const float*)d_in[i];
    a.out = (float*)d_out; a.ws = (unsigned char*)d_ws;
#if MK_ONE_LAUNCH
    a.ph_lo = 0; a.ph_hi = NPH;
    hipLaunchKernelGGL(fwd, dim3(grid), dim3(NTHR), LDS_BYTES, stream, a);
#else
    for (int p = 0; p < NPH; ++p) { a.ph_lo = p; a.ph_hi = p + 1; hipLaunchKernelGGL(fwd, dim3(grid), dim3(NTHR), LDS_BYTES, stream, a); }
#endif
}
```

```cpp
#include <hip/hip_runtime.h>
#include <hip/hip_bf16.h>
#include <cstdio>
#include <cstdint>
#define DBG_STAGE 3
#define MK_ONE_LAUNCH 1
namespace pg8 {
#define PG8_LAS __attribute__((address_space(3)))
typedef unsigned short bf16_t;
typedef short bf16x8 __attribute__((ext_vector_type(8)));
typedef float f32x4 __attribute__((ext_vector_type(4)));
typedef unsigned u32x4 __attribute__((ext_vector_type(4)));
constexpr int BM = 256, BK = 64, HALF = 128, HTB = HALF * BK * 2  , STAGE_BYTES = 8 * HTB, NXCD = 8, WGM = 8;

__host__ __device__ __forceinline__ int lds_byte(int r, int c) { const int st = (r >> 4) * 2 + (c >> 5), rr = r & 15, cc = c & 31, ob = rr * 64 + cc * 2; return st * 1024 + (ob ^ (((ob >> 9) & 1) << 5)); }
__host__ __device__ __forceinline__ void stage_rc(int b, int& R, int& C) { const int st = b / 1024, sb = b % 1024, swz = sb ^ (((sb >> 9) & 1) << 5); R = (st >> 1) * 16 + swz / 64; C = (st & 1) * 32 + (swz % 64) / 2; }
__host__ __device__ __forceinline__ int perm32(int rho) { const int n = rho >> 4, i = rho & 15; return 8 * (i >> 2) + 4 * n + (i & 3); }

struct Unit { int pm, pn; };
struct Gemm { const bf16_t* A; const bf16_t* Bt; int M, N, K; };

struct StaticOrder {
    int nM, nN, nwg, G, c;
    __host__ __device__ void init(int M, int N, int G_, int c_) { nM = M / BM; nN = N / BM; nwg = nM * nN; G = G_; c = c_; }
    __host__ __device__ bool next(int i, Unit& u) const {
        const long L = (long)i * G + c; if (L >= nwg) return false;
        int wgid = (int)L; { const int q = nwg / NXCD, r = nwg % NXCD, xcd = wgid % NXCD, off = wgid / NXCD; wgid = (xcd < r ? xcd * (q + 1) : r * (q + 1) + (xcd - r) * q) + off; }
        const int nig = WGM * nN, gid = wgid / nig, fm = gid * WGM, gsz = (nM - fm) < WGM ? (nM - fm) : WGM;
        u.pm = fm + ((wgid % nig) % gsz); u.pn = (wgid % nig) / gsz; return true;
    }
    __device__ __forceinline__ void a_ready(const Unit&) const {}
    __device__ __forceinline__ void done(const Unit&) const {}
};

struct QueueOrder {
    int nM, nN, per; unsigned* Q; int xcc; PG8_LAS int* slot;
    __device__ __forceinline__ void init(int M, int N, unsigned* Q_, int xcc_, PG8_LAS int* slot_) { nM = M / BM; nN = N / BM; per = nM * nN / NXCD; Q = Q_; xcc = xcc_; slot = slot_; }
    __device__ __forceinline__ int fetch() const {
        for (int s = 0; s < NXCD; ++s) { const int b = (xcc + s) & (NXCD - 1); const unsigned n = __hip_atomic_fetch_add(Q + 64 * b, 1u, __ATOMIC_RELAXED, __HIP_MEMORY_SCOPE_AGENT); if (n < (unsigned)per) return b * per + (int)n; }
        return -1; }
    __device__ __forceinline__ void prime() const { if (threadIdx.x == 0) { slot[0] = fetch(); slot[1] = fetch(); } }
    __device__ __forceinline__ bool next(int i, Unit& u) const {
        if (threadIdx.x == 0) slot[(i + 2) & 3] = fetch();
        const int wgid = __builtin_amdgcn_readfirstlane(slot[i & 3]); if (wgid < 0) return false;
        const int nig = WGM * nN, gid = wgid / nig, fm = gid * WGM, gsz = (nM - fm) < WGM ? (nM - fm) : WGM;
        u.pm = fm + ((wgid % nig) % gsz); u.pn = (wgid % nig) / gsz; return true; }
    __device__ __forceinline__ void a_ready(const Unit&) const {}
    __device__ __forceinline__ void done(const Unit&) const {}
};

struct QueueOrderGf : QueueOrder {
    const unsigned* fd; unsigned fd_goal; int pn_wait;
    __device__ __forceinline__ void a_ready(const Unit& u) const {
        if (u.pn >= pn_wait) { for (int spin = 0; spin < (1 << 22) && __hip_atomic_load(fd, __ATOMIC_RELAXED, __HIP_MEMORY_SCOPE_AGENT) < fd_goal; ++spin) __builtin_amdgcn_s_sleep(16); }
    }
};
struct PanelOrder {
    int pm, nN;
    __host__ __device__ bool next(int i, Unit& u) const { if (i >= nN) return false; u.pm = pm; u.pn = i; return true; }
    __device__ __forceinline__ void a_ready(const Unit&) const {}
    __device__ __forceinline__ void done(const Unit&) const {}
};
__device__ __forceinline__ unsigned cvt_pk_bf16(float lo, float hi) { unsigned r; asm volatile("v_cvt_pk_bf16_f32 %0, %1, %2" : "=v"(r) : "v"(lo), "v"(hi)); return r; }
typedef float f32x2 __attribute__((ext_vector_type(2)));
__device__ __forceinline__ f32x2 gelu_pk(f32x2 v) {
    const f32x2 av = __builtin_elementwise_abs(v), d = av * 0.2316418882f + 1.0f;
    f32x2 t; t.x = __builtin_amdgcn_rcpf(d.x); t.y = __builtin_amdgcn_rcpf(d.y);
    f32x2 q = t * 0.5307027145f + (-0.7265760135f); q = q * t + 0.7107068705f; q = q * t + (-0.142248368f); q = q * t + 0.127414796f; q = q * t;
    const f32x2 s = (v * v) * (-0.72134752044f);
    f32x2 e; e.x = __builtin_amdgcn_exp2f(s.x); e.y = __builtin_amdgcn_exp2f(s.y);
    const f32x2 m = v * (q * e), r = v - m;
    f32x2 o; o.x = v.x < 0.f ? m.x : r.x; o.y = v.y < 0.f ? m.y : r.y; return o;
}

template <int ACT  > struct EpiBf16 {
    static constexpr bool PERM = true, AFTER_DRAIN = false; static_assert(ACT == 0 || ACT == 1, "EpiBf16: ACT is 0 (none) or 1 (gelu_pk)");
    bf16_t* O; int ldc; const float* bias; int split_cols; size_t split_stride; float scale0;
    __device__ __forceinline__ void operator()(const f32x4 (&acc)[2][2][4][2], const Unit& u, int wr, int wc, int fr, int fq) const {
        const int row0 = u.pm * BM + wr * 64 + fr; int colt = u.pn * BM; bf16_t* base = O;
        float sc = 1.f; if (split_cols) { const int t = colt / split_cols; base += (size_t)t * split_stride; colt -= t * split_cols; if (t == 0) sc = scale0; }
        const int col0 = colt + wc * 32 + 8 * fq, bcol0 = u.pn * BM + wc * 32 + 8 * fq;
        f32x4 bv[2][2];
#pragma unroll
        for (int bj = 0; bj < 2; ++bj)
#pragma unroll
            for (int n = 0; n < 2; ++n) bv[bj][n] = bias ? *(const f32x4*)(bias + bcol0 + bj * HALF + 4 * n) : (f32x4){0.f, 0.f, 0.f, 0.f};
#pragma unroll
        for (int ai = 0; ai < 2; ++ai)
#pragma unroll
            for (int m = 0; m < 4; ++m) { bf16_t* rowp = base + (size_t)(row0 + ai * HALF + m * 16) * ldc + col0;
#pragma unroll
                for (int bj = 0; bj < 2; ++bj) { f32x4 v0 = acc[ai][bj][m][0] + bv[bj][0], v1 = acc[ai][bj][m][1] + bv[bj][1];
                    if (ACT == 1) { f32x2 a = gelu_pk((f32x2){v0[0], v0[1]}), b = gelu_pk((f32x2){v0[2], v0[3]}), c = gelu_pk((f32x2){v1[0], v1[1]}), d = gelu_pk((f32x2){v1[2], v1[3]});
                        v0 = (f32x4){a.x, a.y, b.x, b.y}; v1 = (f32x4){c.x, c.y, d.x, d.y}; }
                    v0 = v0 * sc; v1 = v1 * sc; u32x4 w; w.x = cvt_pk_bf16(v0[0], v0[1]); w.y = cvt_pk_bf16(v0[2], v0[3]); w.z = cvt_pk_bf16(v1[0], v1[1]); w.w = cvt_pk_bf16(v1[2], v1[3]);
                    *(u32x4*)(rowp + bj * HALF) = w; } }
    }
};

typedef int v8i_t __attribute__((ext_vector_type(8)));
typedef int v4i_t __attribute__((ext_vector_type(4)));
__device__ __forceinline__ v8i_t cat32(bf16x8 lo, bf16x8 hi) { return __builtin_shufflevector(__builtin_bit_cast(v4i_t, lo), __builtin_bit_cast(v4i_t, hi), 0, 1, 2, 3, 4, 5, 6, 7); }
template <class Epi, class Sched, bool ALIGN_EPI = false, bool SP2 = false, int MODE = 0>
__device__ __forceinline__ void gemm_phase(PG8_LAS unsigned char* lds, const Gemm g, const Sched& S, const Epi& E) {
    constexpr bool FP8 = (MODE == 1);
    int tid_ = threadIdx.x; asm volatile("" : "+v"(tid_));
    const int tid = tid_, wid = __builtin_amdgcn_readfirstlane(tid >> 6), lane = tid & 63, wr = wid >> 2, wc = wid & 3, fr = lane & 15, fq = lane >> 4;
    const int K = g.K, nt = K / BK;
    unsigned voffA[2], voffB[2];
#pragma unroll
    for (int i = 0; i < 2; ++i) { int R, C; stage_rc(tid * 16 + i * 8192, R, C); const int Rb = Epi::PERM ? ((R & ~31) + perm32(R & 31)) : R;
        voffA[i] = (unsigned)(R * K + C) * 2u; voffB[i] = (unsigned)(Rb * K + C) * 2u; }
    const size_t kstep = (size_t)(BK * 2);
    const size_t hstep = (size_t)HALF * K * 2;
    const size_t tstep = 2 * hstep;
    const unsigned ldsw = (unsigned)wid * 1024u;
    const int aoff = lds_byte(wr * 64 + fr, fq * 8), boff = lds_byte(wc * 32 + fr, fq * 8);
#define PG8_SA(b, h) (((b) * 2 + (h)) * HTB)
#define PG8_SB(b, h) ((4 + (b) * 2 + (h)) * HTB)
#define PG8_STAGE(bufoff, gbase, voff) do { _Pragma("unroll") for (int _i = 0; _i < 2; ++_i) \
        __builtin_amdgcn_global_load_lds((const unsigned*)((const char*)(gbase) + (voff)[_i]), (PG8_LAS unsigned*)(lds + (bufoff) + ldsw + _i * 8192), 16, 0, 0); } while (0)
#define PG8_LDA(dst, b, h) do { if constexpr (FP8) { _Pragma("unroll") for (int m = 0; m < 4; ++m) dst##8[m] = cat32(*(const PG8_LAS bf16x8*)(lds + PG8_SA(b, h) + aoff + m * 2048), *(const PG8_LAS bf16x8*)(lds + PG8_SA(b, h) + aoff + m * 2048 + 1024)); } \
        else { _Pragma("unroll") for (int m = 0; m < 4; ++m) _Pragma("unroll") for (int k = 0; k < 2; ++k) dst[m][k] = *(const PG8_LAS bf16x8*)(lds + PG8_SA(b, h) + aoff + m * 2048 + k * 1024); } } while (0)
#define PG8_LDB(dst, b, h) do { if constexpr (FP8) { _Pragma("unroll") for (int n = 0; n < 2; ++n) dst##8[n] = cat32(*(const PG8_LAS bf16x8*)(lds + PG8_SB(b, h) + boff + n * 2048), *(const PG8_LAS bf16x8*)(lds + PG8_SB(b, h) + boff + n * 2048 + 1024)); } \
        else { _Pragma("unroll") for (int n = 0; n < 2; ++n) _Pragma("unroll") for (int k = 0; k < 2; ++k) dst[n][k] = *(const PG8_LAS bf16x8*)(lds + PG8_SB(b, h) + boff + n * 2048 + k * 1024); } } while (0)
#define PG8_MMA(ai, bj, At, Bt) do { __builtin_amdgcn_s_setprio(1); _Pragma("unroll") for (int m = 0; m < 4; ++m) _Pragma("unroll") for (int n = 0; n < 2; ++n) { \
        if constexpr (FP8) acc[ai][bj][m][n] = __builtin_amdgcn_mfma_scale_f32_16x16x128_f8f6f4(Bt##8[n], At##8[m], acc[ai][bj][m][n], 0, 0, 0, 0x7F7F7F7F, 0, 0x7F7F7F7F); \
        else if constexpr (MODE == 2) { _Pragma("unroll") for (int k = 0; k < 2; ++k) acc[ai][bj][m][n] = __builtin_bit_cast(f32x4, __builtin_amdgcn_mfma_i32_16x16x64_i8(__builtin_bit_cast(v4i_t, Bt[n][k]), __builtin_bit_cast(v4i_t, At[m][k]), __builtin_bit_cast(v4i_t, acc[ai][bj][m][n]), 0, 0, 0)); } \
        else { _Pragma("unroll") for (int k = 0; k < 2; ++k) acc[ai][bj][m][n] = __builtin_amdgcn_mfma_f32_16x16x32_bf16(Bt[n][k], At[m][k], acc[ai][bj][m][n], 0, 0, 0); } } __builtin_amdgcn_s_setprio(0); } while (0)
#define PG8_WAIT_V(n) asm volatile("s_waitcnt vmcnt(" #n ")" ::: "memory")
#define PG8_WAIT_L(n) asm volatile("s_waitcnt lgkmcnt(" #n ")" ::: "memory")
#define PG8_BAR __builtin_amdgcn_s_barrier()
#define PG8_SCHED __builtin_amdgcn_sched_barrier(0)
    Unit cur, nxt; int ui = 0;
    if (!S.next(0, cur)) return;
    f32x4 acc[2][2][4][2];
#pragma unroll
    for (int a = 0; a < 2; ++a)
#pragma unroll
        for (int b = 0; b < 2; ++b)
#pragma unroll
            for (int m = 0; m < 4; ++m)
#pragma unroll
                for (int n = 0; n < 2; ++n) acc[a][b][m][n] = (f32x4){0.f, 0.f, 0.f, 0.f};
    bf16x8 At[4][2], B0[2][2], B1[2][2]; v8i_t At8[4], B08[2], B18[2];
    const char* cA = (const char*)g.A + (size_t)cur.pm * tstep; const char* cB = (const char*)g.Bt + (size_t)cur.pn * tstep;
    S.a_ready(cur);
    if constexpr (SP2) {
        PG8_STAGE(PG8_SB(0, 0), cB, voffB); PG8_STAGE(PG8_SB(0, 1), cB + hstep, voffB); PG8_STAGE(PG8_SA(0, 0), cA, voffA); PG8_STAGE(PG8_SA(0, 1), cA + hstep, voffA);
        if (wr == 1) PG8_BAR;
        PG8_WAIT_V(2); PG8_BAR;
        PG8_STAGE(PG8_SB(1, 0), cB + kstep, voffB); PG8_STAGE(PG8_SA(1, 0), cA + kstep, voffA); PG8_STAGE(PG8_SB(1, 1), cB + hstep + kstep, voffB);
        PG8_WAIT_V(6); PG8_BAR;
    } else {
        PG8_STAGE(PG8_SB(0, 0), cB, voffB); PG8_STAGE(PG8_SA(0, 0), cA, voffA); PG8_STAGE(PG8_SB(0, 1), cB + hstep, voffB); PG8_STAGE(PG8_SA(0, 1), cA + hstep, voffA);
        if (wr == 1) PG8_BAR;
        PG8_WAIT_V(4); PG8_BAR;
        PG8_STAGE(PG8_SB(1, 0), cB + kstep, voffB); PG8_STAGE(PG8_SA(1, 0), cA + kstep, voffA); PG8_STAGE(PG8_SB(1, 1), cB + hstep + kstep, voffB);
        PG8_WAIT_V(6); PG8_BAR;
    }
    for (;;) {
        const bool has_next = S.next(ui + 1, nxt);
        const char* nA = has_next ? (const char*)g.A + (size_t)nxt.pm * tstep : cA; const char* nB = has_next ? (const char*)g.Bt + (size_t)nxt.pn * tstep : cB;
_Pragma("nounroll")
        for (int t = 0; t < nt; t += 2) {
            const bool last = (t == nt - 2);
            const char* a1 = cA + (size_t)(t + 1) * kstep;
            const char* a2 = last ? nA : cA + (size_t)(t + 2) * kstep; const char* b2 = last ? nB : cB + (size_t)(t + 2) * kstep;
            const char* a3 = a2 + kstep; const char* b3 = b2 + kstep;
            if (last && has_next) S.a_ready(nxt);
            if constexpr (SP2) {
            PG8_LDB(B0, 0, 0); PG8_LDB(B1, 0, 1); PG8_SCHED; PG8_LDA(At, 0, 0); PG8_STAGE(PG8_SA(1, 1), a1 + hstep, voffA);
            PG8_WAIT_V(8); PG8_WAIT_L(0); PG8_BAR; PG8_MMA(0, 0, At, B0); PG8_MMA(0, 1, At, B1); PG8_BAR; PG8_SCHED;
            PG8_LDA(At, 0, 1); PG8_STAGE(PG8_SB(0, 0), b2, voffB); PG8_STAGE(PG8_SB(0, 1), b2 + hstep, voffB); PG8_STAGE(PG8_SA(0, 0), a2, voffA);
            PG8_WAIT_V(8); PG8_WAIT_L(0); PG8_BAR; PG8_MMA(1, 0, At, B0); PG8_MMA(1, 1, At, B1); PG8_BAR; PG8_SCHED;
            PG8_LDB(B0, 1, 0); PG8_LDB(B1, 1, 1); PG8_SCHED; PG8_LDA(At, 1, 0); PG8_STAGE(PG8_SA(0, 1), a2 + hstep, voffA);
            PG8_WAIT_V(8); PG8_WAIT_L(0); PG8_BAR; PG8_MMA(0, 0, At, B0); PG8_MMA(0, 1, At, B1); PG8_BAR; PG8_SCHED;
            PG8_LDA(At, 1, 1); PG8_STAGE(PG8_SB(1, 0), b3, voffB); PG8_STAGE(PG8_SB(1, 1), b3 + hstep, voffB); PG8_STAGE(PG8_SA(1, 0), a3, voffA);
            PG8_WAIT_V(8); PG8_WAIT_L(0); PG8_BAR; PG8_MMA(1, 0, At, B0); PG8_MMA(1, 1, At, B1); PG8_BAR; PG8_SCHED;
            } else {
            PG8_LDB(B0, 0, 0); PG8_SCHED; PG8_LDA(At, 0, 0); PG8_STAGE(PG8_SA(1, 1), a1 + hstep, voffA);
            PG8_WAIT_L(8); PG8_BAR; PG8_WAIT_L(0); PG8_MMA(0, 0, At, B0); PG8_BAR; PG8_SCHED;
            PG8_LDB(B1, 0, 1); PG8_STAGE(PG8_SB(0, 0), b2, voffB);
            PG8_BAR; PG8_WAIT_L(0); PG8_MMA(0, 1, At, B1); PG8_BAR;
            PG8_LDA(At, 0, 1); PG8_STAGE(PG8_SA(0, 0), a2, voffA);
            PG8_BAR; PG8_WAIT_L(0); PG8_MMA(1, 0, At, B0); PG8_BAR; PG8_SCHED;
            PG8_STAGE(PG8_SB(0, 1), b2 + hstep, voffB);
            PG8_WAIT_V(6); PG8_BAR; PG8_MMA(1, 1, At, B1); PG8_BAR;
            PG8_LDB(B0, 1, 0); PG8_SCHED; PG8_LDA(At, 1, 0); PG8_STAGE(PG8_SA(0, 1), a2 + hstep, voffA);
            PG8_WAIT_L(8); PG8_BAR; PG8_WAIT_L(0); PG8_MMA(0, 0, At, B0); PG8_BAR; PG8_SCHED;
            PG8_LDB(B1, 1, 1); PG8_STAGE(PG8_SB(1, 0), b3, voffB);
            PG8_BAR; PG8_WAIT_L(0); PG8_MMA(0, 1, At, B1); PG8_BAR;
            PG8_LDA(At, 1, 1); PG8_STAGE(PG8_SA(1, 0), a3, voffA);
            PG8_BAR; PG8_WAIT_L(0); PG8_MMA(1, 0, At, B0); PG8_BAR; PG8_SCHED;
            PG8_STAGE(PG8_SB(1, 1), b3 + hstep, voffB);
            PG8_WAIT_V(6); PG8_BAR; PG8_MMA(1, 1, At, B1); PG8_BAR;
            }
        }
        if constexpr (ALIGN_EPI) { if (wr == 0) PG8_BAR; }
        if constexpr (!Epi::AFTER_DRAIN) { E(acc, cur, wr, wc, fr, fq); S.done(cur); }
        if (!has_next) break;
#pragma unroll
        for (int a = 0; a < 2; ++a)
#pragma unroll
            for (int b = 0; b < 2; ++b)
#pragma unroll
                for (int m = 0; m < 4; ++m)
#pragma unroll
                    for (int n = 0; n < 2; ++n) acc[a][b][m][n] = (f32x4){0.f, 0.f, 0.f, 0.f};
        cur = nxt; cA = nA; cB = nB; ++ui;
        if constexpr (ALIGN_EPI) { if (wr == 1) PG8_BAR; }
    }
    PG8_WAIT_V(0);
    if constexpr (!ALIGN_EPI) { if (wr == 0) PG8_BAR; }
    PG8_BAR;
    if constexpr (Epi::AFTER_DRAIN) { E.fused(acc, cur, wr, wc, fr, fq, lds, wid, lane); S.done(cur); }
#undef PG8_SA
#undef PG8_SB
#undef PG8_STAGE
#undef PG8_LDA
#undef PG8_LDB
#undef PG8_MMA
#undef PG8_WAIT_V
#undef PG8_WAIT_L
#undef PG8_BAR
#undef PG8_SCHED
}
}
#define PG8_SP2 true
#define GAS __attribute__((address_space(1)))
#define LAS __attribute__((address_space(3)))
typedef unsigned short bf16raw;
typedef unsigned v4u __attribute__((ext_vector_type(4)));
typedef unsigned v2u __attribute__((ext_vector_type(2)));
typedef float f32x4 __attribute__((ext_vector_type(4)));
typedef float f32x2 __attribute__((ext_vector_type(2)));
typedef float f32x16 __attribute__((ext_vector_type(16)));
typedef short bf16x8 __attribute__((ext_vector_type(8)));
typedef GAS unsigned gu32;
#define RLX_AGENT __ATOMIC_RELAXED, __HIP_MEMORY_SCOPE_AGENT
constexpr int NWAVES = 8, NTHR = 512;
constexpr int BATCH = 8, T = 8192, D = 1024, M = BATCH * T;
constexpr int MH = 4, MD = 256, FH = 8, FD = 128, LCH = 64, NCH = T / LCH;
constexpr int DIN = 9232;
constexpr int PH = 8, PKEYS = 128, PTOP = 16, HK = PH * PTOP, NEXP = 16384;
constexpr float EPS = 1e-6f;
__device__ __forceinline__ unsigned f2bf(float f) { unsigned u = __builtin_bit_cast(unsigned, f); return (u + 0x7fffu + ((u >> 16) & 1u)) >> 16; }
typedef __bf16 bf16x2_t __attribute__((ext_vector_type(2)));
__device__ __forceinline__ unsigned pk2(float lo, float hi) { return __builtin_bit_cast(unsigned, __builtin_convertvector((f32x2){lo, hi}, bf16x2_t)); }
__device__ __forceinline__ float bflo(unsigned w) { return __builtin_bit_cast(float, w << 16); }
__device__ __forceinline__ float bfhi(unsigned w) { return __builtin_bit_cast(float, w & 0xffff0000u); }
__device__ __forceinline__ float bf1(bf16raw h) { return __builtin_bit_cast(float, (unsigned)h << 16); }
template <int CTRL> __device__ __forceinline__ float dppf(float v) { return __builtin_bit_cast(float, __builtin_amdgcn_update_dpp(0, __builtin_bit_cast(int, v), CTRL, 0xf, 0xf, false)); }
__device__ __forceinline__ float row8_sum(float v) { v += dppf<0xB1>(v); v += dppf<0x4E>(v); v += dppf<0x141>(v); return v; }
__device__ __forceinline__ float row16_sum(float v) { v = row8_sum(v); v += dppf<0x140>(v); return v; }
__device__ __forceinline__ float row16_max(float v) { v = fmaxf(v, dppf<0xB1>(v)); v = fmaxf(v, dppf<0x4E>(v)); v = fmaxf(v, dppf<0x141>(v)); v = fmaxf(v, dppf<0x140>(v)); return v; }
__device__ __forceinline__ float rdl(float v, int l) { return __builtin_bit_cast(float, __builtin_amdgcn_readlane(__builtin_bit_cast(int, v), l)); }
__device__ __forceinline__ float wave_sum_dpp(float v) { v = row16_sum(v); return (rdl(v, 0) + rdl(v, 16)) + (rdl(v, 32) + rdl(v, 48)); }
__device__ __forceinline__ float wave_max_dpp(float v) { v = row16_max(v); return fmaxf(fmaxf(rdl(v, 0), rdl(v, 16)), fmaxf(rdl(v, 32), rdl(v, 48))); }
__device__ __forceinline__ float wave_sum(float v) {
#pragma unroll
    for (int o = 1; o < 64; o <<= 1) v += __shfl_xor(v, o);
    return v;
}
__device__ __forceinline__ float sigmoidf_(float x) { return __builtin_amdgcn_rcpf(1.0f + __builtin_amdgcn_exp2f(x * -1.4426950408889634f)); }
__device__ __forceinline__ unsigned q8x4_pack(float a, float b, float c, float d, float inv) {
    const unsigned ua = __builtin_bit_cast(unsigned, __builtin_fmaf(a, inv, 12582912.f)), ub = __builtin_bit_cast(unsigned, __builtin_fmaf(b, inv, 12582912.f));
    const unsigned uc = __builtin_bit_cast(unsigned, __builtin_fmaf(c, inv, 12582912.f)), ud = __builtin_bit_cast(unsigned, __builtin_fmaf(d, inv, 12582912.f));
    return __builtin_amdgcn_perm(ub, ua, 0x0c0c0400u) | __builtin_amdgcn_perm(ud, uc, 0x04000c0cu);
}
__device__ __forceinline__ unsigned nib4(unsigned w) { w = (w | (w >> 4)) & 0x00FF00FFu; return (w | (w >> 8)) & 0xFFFFu; }
__device__ __forceinline__ float q8_expneg(unsigned w, int k) { return __builtin_amdgcn_exp2f((float)(int)(signed char)(w >> (8 * k)) * -0.09016844005556021f); }
__device__ __forceinline__ float q8_sigmoid(unsigned w, int k) { return __builtin_amdgcn_rcpf(1.0f + q8_expneg(w, k)); }
__device__ __forceinline__ float logsigf_(float x) { return fminf(x, 0.f) - log1pf(__expf(-fabsf(x))); }
__device__ __forceinline__ float gelu_erf(float v) {
    const float av = fabsf(v), t = __builtin_amdgcn_rcpf(av * 0.2316418882f + 1.0f);
    float q = t * 0.5307027145f + (-0.7265760135f); q = q * t + 0.7107068705f; q = q * t + (-0.142248368f); q = q * t + 0.127414796f; q = q * t;
    const float e = __builtin_amdgcn_exp2f((v * v) * (-0.72134752044f));
    const float m = v * (q * e);
    return v < 0.f ? m : v - m;
}
constexpr size_t MiB = 1u << 20;
constexpr size_t WS_CTL = 0, CTL_ZERO_BYTES = 128 * 1024;
constexpr size_t WS_Z16 = 2 * MiB;
constexpr size_t WS_CS = 6 * MiB;
constexpr size_t WS_GROWF = 8 * MiB, WS_GCOLF = 9 * MiB, WS_GWINT = 10 * MiB, WS_GEDEN = 11 * MiB, WS_GWSW = 12 * MiB;
constexpr size_t WS_JLO = 13 * MiB + 262144;
constexpr size_t WS_GDECAY = 13 * MiB, WS_BIASP = 13 * MiB + 65536, WS_BIASG = 13 * MiB + 131072;
constexpr size_t WS_KBAR = 14 * MiB, WS_DSUM = 18 * MiB;
constexpr size_t WS_SKB = 19 * MiB, WS_WGT = 19 * MiB + 524288;
constexpr size_t WS_WINT = 20 * MiB, WS_WMT = 38 * MiB, WS_WFT = 40 * MiB, WS_WOT = 42 * MiB, WS_WPQT = 44 * MiB;
constexpr size_t WS_SP = 48 * MiB, WS_IDS = 80 * MiB, WS_GW = 112 * MiB, WS_UB = 144 * MiB, WS_VB = 176 * MiB;
constexpr size_t WS_R0 = 256 * MiB, RSZ = 128 * MiB;
constexpr size_t WS_END = 1024 * MiB;
constexpr int CW_TMO = 0, CW_BAR = 4096, CW_QU = 8192, CW_QV = 8192 + 512, CW_QF = 8192 + 1024, CW_CMAX = 16384, CW_QG = 9728  , CW_FDONE = 12288  , CW_QM = 10240  ;
constexpr int LDS_BYTES = 163840;
constexpr int LDS_MISC = 160 * 1024 - 256;
#define XB_TMO      128
#define XB_XCNT(j)  (256  + 64 * (j))
#define XB_XSUB(j)  (1280 + 64 * (j))
#define XB_XGEN(j)  (2304 + 64 * (j))
#define XB_TOP      3328
#define XB_TOPGEN   3392
#define XCD_BAR_WORDS 3456
#define XB_SPIN_CAP (1u << 18)

__device__ __forceinline__ unsigned xb_ld(unsigned* p)              { return __hip_atomic_load(p, __ATOMIC_RELAXED, __HIP_MEMORY_SCOPE_AGENT); }
__device__ __forceinline__ unsigned xb_add(unsigned* p, unsigned v) { return __hip_atomic_fetch_add(p, v, __ATOMIC_RELAXED, __HIP_MEMORY_SCOPE_AGENT); }
__device__ __forceinline__ unsigned xb_xcc_id() { return (unsigned)__builtin_amdgcn_s_getreg((3 << 11) | 20) & 0xFu; }
#define XB_SPIN(cond, bar) do { unsigned _sp = 0; while (cond) { __builtin_amdgcn_s_sleep(1); \
    if ((++_sp & 255u) == 0u) { if (xb_ld(&(bar)[XB_TMO])) break; if (_sp > XB_SPIN_CAP) { atomicAdd(&(bar)[XB_TMO], 1u); break; } } } } while (0)

struct XcdBarrier {
    unsigned* bar; unsigned x;
    volatile LAS unsigned* st;
};

__device__ __forceinline__ XcdBarrier xcd_barrier_post(unsigned* bar, volatile LAS unsigned* st) {
    XcdBarrier b; b.bar = bar; b.x = xb_xcc_id(); b.st = st;
    if (threadIdx.x == 0) (void)xb_add(&bar[XB_XCNT(b.x)], 1u);
    return b;
}
__device__ __forceinline__ void xcd_barrier_complete(unsigned* bar, unsigned x, unsigned& nloc, unsigned& nx) {
    const unsigned G = gridDim.x * gridDim.y * gridDim.z;
    unsigned sum, cnt, mine, sp = 0u;
    for (;;) {
        sum = 0u; cnt = 0u; mine = 0u;
#pragma unroll
        for (unsigned j = 0; j < 16; ++j) { const unsigned c = xb_ld(&bar[XB_XCNT(j)]); sum += c; cnt += (c > 0u) ? 1u : 0u; mine = (j == x) ? c : mine; }
        if (sum == G) break;
        __builtin_amdgcn_s_sleep(1);
        if ((++sp & 255u) == 0u) { if (xb_ld(&bar[XB_TMO])) break; if (sp > XB_SPIN_CAP) { atomicAdd(&bar[XB_TMO], 1u); break; } }
    }
    nloc = mine > 0u ? mine : 1u; nx = cnt > 0u ? cnt : 1u;
}

__device__ __forceinline__ void xcd_barrier(const XcdBarrier& b) {
    asm volatile("s_waitcnt vmcnt(0)" ::: "memory");
    __syncthreads();
    if (threadIdx.x == 0) {
        unsigned* bar = b.bar;
        __builtin_amdgcn_s_waitcnt(0);
        unsigned nloc = b.st[0], nx = b.st[1];
        if (nloc == 0u) { xcd_barrier_complete(bar, b.x, nloc, nx); b.st[0] = nloc; b.st[1] = nx; }
        const unsigned old = xb_add(&bar[XB_XSUB(b.x)], 1u);
        const unsigned gen = old / nloc;
        if (old + 1u == (gen + 1u) * nloc) {
            __builtin_amdgcn_fence(__ATOMIC_RELEASE, "agent");
            asm volatile("s_waitcnt vmcnt(0)" ::: "memory");
            const unsigned og = xb_add(&bar[XB_TOP], 1u);
            const unsigned tg = og / nx;
            if (og + 1u == (tg + 1u) * nx) xb_add(&bar[XB_TOPGEN], 1u);
            else XB_SPIN(xb_ld(&bar[XB_TOPGEN]) == tg, bar);
            __builtin_amdgcn_fence(__ATOMIC_ACQUIRE, "agent");
            xb_add(&bar[XB_XGEN(b.x)], 1u);
            asm volatile("s_waitcnt vmcnt(0)" ::: "memory");
        } else {
            XB_SPIN(xb_ld(&bar[XB_XGEN(b.x)]) == gen, bar);
            __builtin_amdgcn_fence(__ATOMIC_ACQUIRE, "agent");
            asm volatile("s_waitcnt vmcnt(0)" ::: "memory");
        }
    }
    __syncthreads();
}
namespace pg8 {
__device__ __forceinline__ float q8f(unsigned w, int k) { return (float)(int)(signed char)(w >> (8 * k)) * (1.f / 16.f); }
struct EpiGate {
    static constexpr bool PERM = true, AFTER_DRAIN = false;
    bf16_t* O; const signed char* Gt; const bf16_t* Add; int ldc;
    __device__ __forceinline__ void operator()(const f32x4 (&acc)[2][2][4][2], const Unit& u, int wr, int wc, int fr, int fq) const {
        const int row0 = u.pm * BM + wr * 64 + fr, col0 = u.pn * BM + wc * 32 + 8 * fq;
        unsigned long long g[2][4][2]; u32x4 ad[2][4][2];
#pragma unroll
        for (int ai = 0; ai < 2; ++ai)
#pragma unroll
            for (int m = 0; m < 4; ++m) { const size_t ro = (size_t)(row0 + ai * HALF + m * 16) * ldc + col0;
#pragma unroll
                for (int bj = 0; bj < 2; ++bj) { g[ai][m][bj] = *(const unsigned long long*)(Gt + ro + bj * HALF); ad[ai][m][bj] = (u32x4){0u, 0u, 0u, 0u}; if (Add && ai == 0) ad[ai][m][bj] = *(const u32x4*)(Add + ro + bj * HALF); } }
#pragma unroll
        for (int ai = 0; ai < 2; ++ai)
#pragma unroll
            for (int m = 0; m < 4; ++m) { const size_t ro = (size_t)(row0 + ai * HALF + m * 16) * ldc + col0;
#pragma unroll
                for (int bj = 0; bj < 2; ++bj) {
                    if (Add && ai == 0 && m > 0) ad[1][m - 1][bj] = *(const u32x4*)(Add + ro + (size_t)(HALF - 16) * ldc + bj * HALF);
                    if (Add && ai == 1 && m == 0) ad[1][3][bj] = *(const u32x4*)(Add + ro + (size_t)48 * ldc + bj * HALF);
                    const f32x4 v0 = acc[ai][bj][m][0], v1 = acc[ai][bj][m][1];
                    const unsigned gw[2] = {(unsigned)g[ai][m][bj], (unsigned)(g[ai][m][bj] >> 32)}, aw[4] = {ad[ai][m][bj].x, ad[ai][m][bj].y, ad[ai][m][bj].z, ad[ai][m][bj].w}; const float vv[8] = {v0[0], v0[1], v0[2], v0[3], v1[0], v1[1], v1[2], v1[3]};
                    unsigned o[4];
#pragma unroll
                    for (int i = 0; i < 4; ++i) { const float a = vv[2 * i] * q8_sigmoid(gw[i >> 1], 2 * (i & 1)) + bflo(aw[i]), b = vv[2 * i + 1] * q8_sigmoid(gw[i >> 1], 2 * (i & 1) + 1) + bfhi(aw[i]); o[i] = cvt_pk_bf16(a, b); }
                    *(u32x4*)(O + ro + bj * HALF) = (u32x4){o[0], o[1], o[2], o[3]}; } }
    }
};
struct EpiBf16S {
    static constexpr bool PERM = false, AFTER_DRAIN = false;
    bf16_t* O; int ldc; const float* bias; size_t split_stride; float sc;
    __device__ __forceinline__ void operator()(const f32x4 (&acc)[2][2][4][2], const Unit& u, int wr, int wc, int fr, int fq) const {
        typedef unsigned u32x2 __attribute__((ext_vector_type(2)));
        { int t_ = threadIdx.x; asm volatile("" : "+v"(t_)); fr = t_ & 15; fq = (t_ >> 4) & 3; }
        const int row0 = u.pm * BM + wr * 64 + fr; int colt = u.pn * BM; const int t = colt >> 10; bf16_t* base = O + (size_t)t * split_stride; colt -= t << 10;
        const int col0 = colt + wc * 32 + 4 * fq, bcol0 = u.pn * BM + wc * 32 + 4 * fq;
#pragma unroll
        for (int bj = 0; bj < 2; ++bj)
#pragma unroll
            for (int n = 0; n < 2; ++n) { const f32x4 bv = *(const f32x4*)(bias + bcol0 + bj * HALF + 16 * n);
#pragma unroll
                for (int ai = 0; ai < 2; ++ai)
#pragma unroll
                    for (int m = 0; m < 4; ++m) { const f32x4 v = acc[ai][bj][m][n] * sc + bv; u32x2 w; w.x = cvt_pk_bf16(v[0], v[1]); w.y = cvt_pk_bf16(v[2], v[3]);
                        *(u32x2*)(base + (size_t)(row0 + ai * HALF + m * 16) * ldc + col0 + bj * HALF + 16 * n) = w; } }
    }
};
struct EpiQ8 {
    static constexpr bool PERM = true, AFTER_DRAIN = false;
    signed char* O; int ldc; const float* bias; const float* sw; const float* sh; size_t off1, off2;
    __device__ __forceinline__ void operator()(const f32x4 (&acc)[2][2][4][2], const Unit& u, int wr, int wc, int fr, int fq) const {
        typedef int i32x4 __attribute__((ext_vector_type(4)));
        { int t_ = threadIdx.x; asm volatile("" : "+v"(t_)); fr = t_ & 15; fq = (t_ >> 4) & 3; }
        const int row0 = u.pm * BM + wr * 64 + fr; int colt = u.pn * BM; const int t = colt >> 10; signed char* base = O + (t == 0 ? (size_t)0 : t == 1 ? off1 : off2); colt -= t << 10;
        const int col0 = colt + wc * 32 + 8 * fq, bcol0 = u.pn * BM + wc * 32 + 8 * fq;
        float rs[2][4];
#pragma unroll
        for (int ai = 0; ai < 2; ++ai)
#pragma unroll
            for (int m = 0; m < 4; ++m) rs[ai][m] = sh[row0 + ai * HALF + m * 16];
        f32x4 bv_[2][2], cs_[2][2];
#pragma unroll
        for (int bj = 0; bj < 2; ++bj)
#pragma unroll
            for (int n = 0; n < 2; ++n) { bv_[bj][n] = (bias ? *(const f32x4*)(bias + bcol0 + bj * HALF + 4 * n) : (f32x4){0.f, 0.f, 0.f, 0.f}) * 16.f; cs_[bj][n] = *(const f32x4*)(sw + bcol0 + bj * HALF + 4 * n) * 16.f; }
#pragma unroll
        for (int bj = 0; bj < 2; ++bj) { const f32x4 (&bv)[2] = bv_[bj]; const f32x4 (&cs)[2] = cs_[bj];
#pragma unroll
            for (int ai = 0; ai < 2; ++ai)
#pragma unroll
                for (int m = 0; m < 4; ++m) { unsigned w2[2];
#pragma unroll
                    for (int n = 0; n < 2; ++n) { const i32x4 iv = __builtin_bit_cast(i32x4, acc[ai][bj][m][n]);
                        const f32x4 v = (f32x4){(float)iv[0], (float)iv[1], (float)iv[2], (float)iv[3]} * cs[n] * rs[ai][m] + bv[n];
                        w2[n] = q8x4_pack(__builtin_amdgcn_fmed3f(v[0], -127.f, 127.f), __builtin_amdgcn_fmed3f(v[1], -127.f, 127.f), __builtin_amdgcn_fmed3f(v[2], -127.f, 127.f), __builtin_amdgcn_fmed3f(v[3], -127.f, 127.f), 1.f); }
                    *(unsigned long long*)(base + (size_t)(row0 + ai * HALF + m * 16) * ldc + col0 + bj * HALF) = (unsigned long long)w2[0] | ((unsigned long long)w2[1] << 32); } }
    }
};
struct EpiI8 {
    static constexpr bool PERM = true, AFTER_DRAIN = false;
    bf16_t* O; int ldc; const float* bias; const float* sw; const float* sh; size_t split_stride;
    __device__ __forceinline__ void operator()(const f32x4 (&acc)[2][2][4][2], const Unit& u, int wr, int wc, int fr, int fq) const {
        typedef int i32x4 __attribute__((ext_vector_type(4)));
        { int t_ = threadIdx.x; asm volatile("" : "+v"(t_)); fr = t_ & 15; fq = (t_ >> 4) & 3; }
        const int row0 = u.pm * BM + wr * 64 + fr; int colt = u.pn * BM; const int t = split_stride ? (colt >> 10) : 0; bf16_t* base = O + (size_t)t * split_stride; colt -= t << 10;
        const int col0 = colt + wc * 32 + 8 * fq, bcol0 = u.pn * BM + wc * 32 + 8 * fq;
        float rs[2][4];
#pragma unroll
        for (int ai = 0; ai < 2; ++ai)
#pragma unroll
            for (int m = 0; m < 4; ++m) rs[ai][m] = sh[row0 + ai * HALF + m * 16];
        f32x4 bv_[2][2], cs_[2][2];
#pragma unroll
        for (int bj = 0; bj < 2; ++bj)
#pragma unroll
            for (int n = 0; n < 2; ++n) { bv_[bj][n] = bias ? *(const f32x4*)(bias + bcol0 + bj * HALF + 4 * n) : (f32x4){0.f, 0.f, 0.f, 0.f}; cs_[bj][n] = *(const f32x4*)(sw + bcol0 + bj * HALF + 4 * n); }
#pragma unroll
        for (int bj = 0; bj < 2; ++bj) { const f32x4 (&bv)[2] = bv_[bj]; const f32x4 (&cs)[2] = cs_[bj];
#pragma unroll
            for (int ai = 0; ai < 2; ++ai)
#pragma unroll
                for (int m = 0; m < 4; ++m) { u32x4 w;
#pragma unroll
                    for (int n = 0; n < 2; ++n) { const i32x4 iv = __builtin_bit_cast(i32x4, acc[ai][bj][m][n]);
                        const f32x4 v = (f32x4){(float)iv[0], (float)iv[1], (float)iv[2], (float)iv[3]} * cs[n] * rs[ai][m] + bv[n];
                        if (n == 0) { w.x = cvt_pk_bf16(v[0], v[1]); w.y = cvt_pk_bf16(v[2], v[3]); } else { w.z = cvt_pk_bf16(v[0], v[1]); w.w = cvt_pk_bf16(v[2], v[3]); } }
                    *(u32x4*)(base + (size_t)(row0 + ai * HALF + m * 16) * ldc + col0 + bj * HALF) = w; } }
    }
};
struct EpiRes {
    static constexpr bool PERM = true, AFTER_DRAIN = false;
    const float* X; float* O; int ldc;
    __device__ __forceinline__ void operator()(const f32x4 (&acc)[2][2][4][2], const Unit& u, int wr, int wc, int fr, int fq) const {
        const int row0 = u.pm * BM + wr * 64 + fr, col0 = u.pn * BM + wc * 32 + 8 * fq;
#pragma unroll
        for (int ai = 0; ai < 2; ++ai)
#pragma unroll
            for (int m = 0; m < 4; ++m) { const size_t ro = (size_t)(row0 + ai * HALF + m * 16) * ldc + col0;
#pragma unroll
                for (int bj = 0; bj < 2; ++bj)
#pragma unroll
                    for (int n = 0; n < 2; ++n) { const size_t off = ro + bj * HALF + n * 4; *(f32x4*)(O + off) = *(const f32x4*)(X + off) + acc[ai][bj][m][n]; } }
    }
};
struct EpiGateI8 {
    static constexpr bool PERM = true, AFTER_DRAIN = false;
    bf16_t* O; const signed char* Gt; const bf16_t* Add; int ldc; const float* sw; const float* sh;
    __device__ __forceinline__ void operator()(const f32x4 (&acc)[2][2][4][2], const Unit& u, int wr, int wc, int fr, int fq) const {
        typedef int i32x4 __attribute__((ext_vector_type(4)));
        const int row0 = u.pm * BM + wr * 64 + fr, col0 = u.pn * BM + wc * 32 + 8 * fq;
        f32x4 c0[2], c1[2]; float rs[2][4]; unsigned long long g[2][4][2]; u32x4 ad[2][4][2];
#pragma unroll
        for (int bj = 0; bj < 2; ++bj) { c0[bj] = *(const f32x4*)(sw + col0 + bj * HALF); c1[bj] = *(const f32x4*)(sw + col0 + bj * HALF + 4); }
#pragma unroll
        for (int ai = 0; ai < 2; ++ai)
#pragma unroll
            for (int m = 0; m < 4; ++m) { const int row = row0 + ai * HALF + m * 16; rs[ai][m] = sh[row];
#pragma unroll
                for (int bj = 0; bj < 2; ++bj) { const size_t ro = (size_t)row * ldc + col0 + bj * HALF; g[ai][m][bj] = *(const unsigned long long*)(Gt + ro); ad[ai][m][bj] = (u32x4){0u, 0u, 0u, 0u}; if (Add) ad[ai][m][bj] = *(const u32x4*)(Add + ro); } }
#pragma unroll
        for (int ai = 0; ai < 2; ++ai)
#pragma unroll
            for (int m = 0; m < 4; ++m) { const int row = row0 + ai * HALF + m * 16;
#pragma unroll
                for (int bj = 0; bj < 2; ++bj) { const size_t ro = (size_t)row * ldc + col0 + bj * HALF;
                    const i32x4 i0 = __builtin_bit_cast(i32x4, acc[ai][bj][m][0]), i1 = __builtin_bit_cast(i32x4, acc[ai][bj][m][1]);
                    const f32x4 v0 = (f32x4){(float)i0[0], (float)i0[1], (float)i0[2], (float)i0[3]} * c0[bj] * rs[ai][m], v1 = (f32x4){(float)i1[0], (float)i1[1], (float)i1[2], (float)i1[3]} * c1[bj] * rs[ai][m];
                    const unsigned gw[2] = {(unsigned)g[ai][m][bj], (unsigned)(g[ai][m][bj] >> 32)}, aw[4] = {ad[ai][m][bj].x, ad[ai][m][bj].y, ad[ai][m][bj].z, ad[ai][m][bj].w}; const float vv[8] = {v0[0], v0[1], v0[2], v0[3], v1[0], v1[1], v1[2], v1[3]};
                    unsigned o[4];
#pragma unroll
                    for (int i = 0; i < 4; ++i) { const float a = vv[2 * i] * q8_sigmoid(gw[i >> 1], 2 * (i & 1)) + bflo(aw[i]), b = vv[2 * i + 1] * q8_sigmoid(gw[i >> 1], 2 * (i & 1) + 1) + bfhi(aw[i]); o[i] = cvt_pk_bf16(a, b); }
                    *(u32x4*)(O + ro) = (u32x4){o[0], o[1], o[2], o[3]}; } }
    }
};
struct EpiGates16I8 {
    static constexpr bool PERM = false, AFTER_DRAIN = false;
    float* Z; const float* bias; const float* sw; const float* sh;
    __device__ __forceinline__ void operator()(const f32x4 (&acc)[2][2][4][2], const Unit& u, int wr, int wc, int fr, int fq) const {
        typedef int i32x4 __attribute__((ext_vector_type(4)));
        if (wc != 0) return;
        const f32x4 bv = *(const f32x4*)(bias + 4 * fq), cs = *(const f32x4*)(sw + 4 * fq); const int row0 = u.pm * BM + wr * 64 + fr;
#pragma unroll
        for (int ai = 0; ai < 2; ++ai)
#pragma unroll
            for (int m = 0; m < 4; ++m) { const int row = row0 + ai * HALF + m * 16; const i32x4 iv = __builtin_bit_cast(i32x4, acc[ai][0][m][0]);
                *(f32x4*)(Z + (size_t)row * 16 + 4 * fq) = (f32x4){(float)iv[0], (float)iv[1], (float)iv[2], (float)iv[3]} * cs * sh[row] + bv; }
    }
};
struct EpiResB16 {
    static constexpr bool PERM = true, AFTER_DRAIN = false;
    const float* X; bf16_t* O; int ldc;
    __device__ __forceinline__ void operator()(const f32x4 (&acc)[2][2][4][2], const Unit& u, int wr, int wc, int fr, int fq) const {
        const int row0 = u.pm * BM + wr * 64 + fr, col0 = u.pn * BM + wc * 32 + 8 * fq;
        f32x4 x0[2][4][2], x1[2][4][2];
#pragma unroll
        for (int m = 0; m < 4; ++m) { const size_t ro = (size_t)(row0 + m * 16) * ldc + col0;
#pragma unroll
            for (int bj = 0; bj < 2; ++bj) { x0[0][m][bj] = *(const f32x4*)(X + ro + bj * HALF); x1[0][m][bj] = *(const f32x4*)(X + ro + bj * HALF + 4); } }
#pragma unroll
        for (int ai = 0; ai < 2; ++ai)
#pragma unroll
            for (int m = 0; m < 4; ++m) { const size_t ro = (size_t)(row0 + ai * HALF + m * 16) * ldc + col0, rn = ro + (size_t)HALF * ldc;
#pragma unroll
                for (int bj = 0; bj < 2; ++bj) { const f32x4 v0 = x0[ai][m][bj] + acc[ai][bj][m][0], v1 = x1[ai][m][bj] + acc[ai][bj][m][1];
                    u32x4 w; w.x = cvt_pk_bf16(v0[0], v0[1]); w.y = cvt_pk_bf16(v0[2], v0[3]); w.z = cvt_pk_bf16(v1[0], v1[1]); w.w = cvt_pk_bf16(v1[2], v1[3]);
                    *(u32x4*)(O + ro + bj * HALF) = w;
                    if (ai == 0) { x0[1][m][bj] = *(const f32x4*)(X + rn + bj * HALF); x1[1][m][bj] = *(const f32x4*)(X + rn + bj * HALF + 4); } } }
    }
};
struct EpiGates16 {
    static constexpr bool PERM = false, AFTER_DRAIN = false;
    float* Z; const float* bias;
    __device__ __forceinline__ void operator()(const f32x4 (&acc)[2][2][4][2], const Unit& u, int wr, int wc, int fr, int fq) const {
        if (wc != 0) return;
        const f32x4 bv = *(const f32x4*)(bias + 4 * fq); const int row0 = u.pm * BM + wr * 64 + fr;
#pragma unroll
        for (int ai = 0; ai < 2; ++ai)
#pragma unroll
            for (int m = 0; m < 4; ++m) *(f32x4*)(Z + (size_t)(row0 + ai * HALF + m * 16) * 16 + 4 * fq) = acc[ai][0][m][0] + bv;
    }
};
template <class Sched>
__device__ __forceinline__ void gemm_dual(PG8_LAS unsigned char* lds, const Gemm g0, const Gemm g1, const Sched& S, const signed char* Gm, const signed char* Gf, const float* sw, const float* sh, bf16_t* O, int ldc) {
    int tid_ = threadIdx.x; asm volatile("" : "+v"(tid_));
    const int tid = tid_, wid = __builtin_amdgcn_readfirstlane(tid >> 6), lane = tid & 63, wr = wid >> 2, wc = wid & 3, fr = lane & 15, fq = lane >> 4;
    const int K0 = g0.K, K1 = g1.K, nt0 = K0 / BK, nt1 = K1 / BK;
    unsigned vA0, vB0, vA1, vB1;
    { int R, C; stage_rc(tid * 16, R, C); const int Rb = (R & ~31) + perm32(R & 31);
      vA0 = (unsigned)(R * K0 + C) * 2u; vB0 = (unsigned)(Rb * K0 + C) * 2u; vA1 = (unsigned)(R * K1 + C) * 2u; vB1 = (unsigned)(Rb * K1 + C) * 2u; }
    const size_t kstep = (size_t)(BK * 2), hs0 = (size_t)HALF * K0 * 2, hs1 = (size_t)HALF * K1 * 2, ts0 = 2 * hs0, ts1 = 2 * hs1;
    const unsigned ldsw = (unsigned)wid * 1024u;
    const int aoff = lds_byte(wr * 64 + fr, fq * 8), boff = lds_byte(wc * 32 + fr, fq * 8);
#define PG8_SA(b, h) (((b) * 2 + (h)) * HTB)
#define PG8_SB(b, h) ((4 + (b) * 2 + (h)) * HTB)
#define PG8_STAGE(bufoff, gbase, voff, hstp) do { _Pragma("unroll") for (int _i = 0; _i < 2; ++_i) \
        __builtin_amdgcn_global_load_lds((const unsigned*)((const char*)(gbase) + (size_t)_i * ((hstp) >> 1) + (voff)), (PG8_LAS unsigned*)(lds + (bufoff) + ldsw + _i * 8192), 16, 0, 0); } while (0)
#define PG8_LDA(dst, b, h) do { _Pragma("unroll") for (int m = 0; m < 4; ++m) _Pragma("unroll") for (int k = 0; k < 2; ++k) dst[m][k] = *(const PG8_LAS bf16x8*)(lds + PG8_SA(b, h) + aoff + m * 2048 + k * 1024); } while (0)
#define PG8_LDB(dst, b, h) do { _Pragma("unroll") for (int n = 0; n < 2; ++n) _Pragma("unroll") for (int k = 0; k < 2; ++k) dst[n][k] = *(const PG8_LAS bf16x8*)(lds + PG8_SB(b, h) + boff + n * 2048 + k * 1024); } while (0)
#define PG8_MMA(md, ai, bj, At, Bt) do { __builtin_amdgcn_s_setprio(1); _Pragma("unroll") for (int m = 0; m < 4; ++m) _Pragma("unroll") for (int n = 0; n < 2; ++n) { \
        if constexpr ((md) == 2) { _Pragma("unroll") for (int k = 0; k < 2; ++k) acc[ai][bj][m][n] = __builtin_bit_cast(f32x4, __builtin_amdgcn_mfma_i32_16x16x64_i8(__builtin_bit_cast(v4i_t, Bt[n][k]), __builtin_bit_cast(v4i_t, At[m][k]), __builtin_bit_cast(v4i_t, acc[ai][bj][m][n]), 0, 0, 0)); } \
        else { _Pragma("unroll") for (int k = 0; k < 2; ++k) acc[ai][bj][m][n] = __builtin_amdgcn_mfma_f32_16x16x32_bf16(Bt[n][k], At[m][k], acc[ai][bj][m][n], 0, 0, 0); } } __builtin_amdgcn_s_setprio(0); } while (0)
#define PG8_WAIT_V(n) asm volatile("s_waitcnt vmcnt(" #n ")" ::: "memory")
#define PG8_WAIT_L(n) asm volatile("s_waitcnt lgkmcnt(" #n ")" ::: "memory")
#define PG8_BAR __builtin_amdgcn_s_barrier()
#define PG8_SCHED __builtin_amdgcn_sched_barrier(0)
#define PG8_KLOOP(md, nt, cA, cB, vA, vB, hs, nA, nB, nvA, nvB, nhs) do { _Pragma("nounroll") for (int t = 0; t < (nt); t += 2) { \
        const bool last = (t == (nt) - 2); \
        const char* a1 = (cA) + (size_t)(t + 1) * kstep; \
        const char* a2 = last ? (nA) : (cA) + (size_t)(t + 2) * kstep; const char* b2 = last ? (nB) : (cB) + (size_t)(t + 2) * kstep; \
        const char* a3 = a2 + kstep; const char* b3 = b2 + kstep; \
        const unsigned xA = last ? (nvA) : (vA), xB = last ? (nvB) : (vB); const size_t xh = last ? (nhs) : (hs); \
        PG8_LDB(B0, 0, 0); PG8_LDB(B1, 0, 1); PG8_SCHED; PG8_LDA(At, 0, 0); PG8_STAGE(PG8_SA(1, 1), a1 + (hs), vA, hs); \
        PG8_WAIT_V(8); PG8_WAIT_L(0); PG8_BAR; PG8_MMA(md, 0, 0, At, B0); PG8_MMA(md, 0, 1, At, B1); PG8_BAR; PG8_SCHED; \
        PG8_LDA(At, 0, 1); PG8_STAGE(PG8_SB(0, 0), b2, xB, xh); PG8_STAGE(PG8_SB(0, 1), b2 + xh, xB, xh); PG8_STAGE(PG8_SA(0, 0), a2, xA, xh); \
        PG8_WAIT_V(8); PG8_WAIT_L(0); PG8_BAR; PG8_MMA(md, 1, 0, At, B0); PG8_MMA(md, 1, 1, At, B1); PG8_BAR; PG8_SCHED; \
        PG8_LDB(B0, 1, 0); PG8_LDB(B1, 1, 1); PG8_SCHED; PG8_LDA(At, 1, 0); PG8_STAGE(PG8_SA(0, 1), a2 + xh, xA, xh); \
        PG8_WAIT_V(8); PG8_WAIT_L(0); PG8_BAR; PG8_MMA(md, 0, 0, At, B0); PG8_MMA(md, 0, 1, At, B1); PG8_BAR; PG8_SCHED; \
        PG8_LDA(At, 1, 1); PG8_STAGE(PG8_SB(1, 0), b3, xB, xh); PG8_STAGE(PG8_SB(1, 1), b3 + xh, xB, xh); PG8_STAGE(PG8_SA(1, 0), a3, xA, xh); \
        PG8_WAIT_V(8); PG8_WAIT_L(0); PG8_BAR; PG8_MMA(md, 1, 0, At, B0); PG8_MMA(md, 1, 1, At, B1); PG8_BAR; PG8_SCHED; } } while (0)
    Unit cur, nxt; int ui = 0;
    if (!S.next(0, cur)) return;
    f32x4 acc[2][2][4][2];
#pragma unroll
    for (int a = 0; a < 2; ++a)
#pragma unroll
        for (int b = 0; b < 2; ++b)
#pragma unroll
            for (int m = 0; m < 4; ++m)
#pragma unroll
                for (int n = 0; n < 2; ++n) acc[a][b][m][n] = (f32x4){0.f, 0.f, 0.f, 0.f};
    bf16x8 At[4][2], B0[2][2], B1[2][2];
    const char* cA0 = (const char*)g0.A + (size_t)cur.pm * ts0; const char* cB0 = (const char*)g0.Bt + (size_t)cur.pn * ts0;
    const char* cA1 = (const char*)g1.A + (size_t)cur.pm * ts1; const char* cB1 = (const char*)g1.Bt + (size_t)cur.pn * ts1;
    PG8_STAGE(PG8_SB(0, 0), cB0, vB0, hs0); PG8_STAGE(PG8_SB(0, 1), cB0 + hs0, vB0, hs0); PG8_STAGE(PG8_SA(0, 0), cA0, vA0, hs0); PG8_STAGE(PG8_SA(0, 1), cA0 + hs0, vA0, hs0);
    if (wr == 1) PG8_BAR;
    PG8_WAIT_V(2); PG8_BAR;
    PG8_STAGE(PG8_SB(1, 0), cB0 + kstep, vB0, hs0); PG8_STAGE(PG8_SA(1, 0), cA0 + kstep, vA0, hs0); PG8_STAGE(PG8_SB(1, 1), cB0 + hs0 + kstep, vB0, hs0);
    PG8_WAIT_V(6); PG8_BAR;
    typedef int i32x4 __attribute__((ext_vector_type(4)));
    for (;;) {
        const bool has_next = S.next(ui + 1, nxt);
        PG8_KLOOP(2, nt0, cA0, cB0, vA0, vB0, hs0, cA1, cB1, vA1, vB1, hs1);
        if (wr == 0) PG8_BAR;
        {
            int t_ = threadIdx.x; asm volatile("" : "+v"(t_));
            const int row0 = cur.pm * BM + wr * 64 + (t_ & 15), col0 = cur.pn * BM + wc * 32 + 8 * ((t_ >> 4) & 3);
            f32x4 c0[2], c1[2];
#pragma unroll
            for (int bj = 0; bj < 2; ++bj) { c0[bj] = *(const f32x4*)(sw + col0 + bj * HALF); c1[bj] = *(const f32x4*)(sw + col0 + bj * HALF + 4); }
#pragma unroll
            for (int ai = 0; ai < 2; ++ai) { float rs[4]; unsigned long long gm[4][2], gf[4][2];
#pragma unroll
                for (int m = 0; m < 4; ++m) { const int row = row0 + ai * HALF + m * 16; rs[m] = sh[row];
#pragma unroll
                    for (int bj = 0; bj < 2; ++bj) { const size_t ro = (size_t)row * ldc + col0 + bj * HALF; gm[m][bj] = *(const unsigned long long*)(Gm + ro); gf[m][bj] = *(const unsigned long long*)(Gf + ro); } }
#pragma unroll
                for (int m = 0; m < 4; ++m)
#pragma unroll
                    for (int bj = 0; bj < 2; ++bj) {
                        const unsigned mw[2] = {(unsigned)gm[m][bj], (unsigned)(gm[m][bj] >> 32)}, fw[2] = {(unsigned)gf[m][bj], (unsigned)(gf[m][bj] >> 32)};
#pragma unroll
                        for (int n = 0; n < 2; ++n) { const i32x4 iv = __builtin_bit_cast(i32x4, acc[ai][bj][m][n]); const f32x4 cs = n ? c1[bj] : c0[bj]; f32x4 v;
#pragma unroll
                            for (int i = 0; i < 4; ++i) { const float ea = q8_expneg(mw[n], i), eb = q8_expneg(fw[n], i);
                                v[i] = (float)iv[i] * cs[i] * rs[m] * ((1.f + eb) * __builtin_amdgcn_rcpf(1.f + ea)); }
                            acc[ai][bj][m][n] = v; } } }
        }
        if (wr == 1) PG8_BAR;
        const char* nA = has_next ? (const char*)g0.A + (size_t)nxt.pm * ts0 : cA0; const char* nB = has_next ? (const char*)g0.Bt + (size_t)nxt.pn * ts0 : cB0;
        PG8_KLOOP(0, nt1, cA1, cB1, vA1, vB1, hs1, nA, nB, vA0, vB0, hs0);
        if (wr == 0) PG8_BAR;
        {
            int t_ = threadIdx.x; asm volatile("" : "+v"(t_));
            const int row0 = cur.pm * BM + wr * 64 + (t_ & 15), col0 = cur.pn * BM + wc * 32 + 8 * ((t_ >> 4) & 3);
            unsigned long long gf[2][4][2];
#pragma unroll
            for (int ai = 0; ai < 2; ++ai)
#pragma unroll
                for (int m = 0; m < 4; ++m)
#pragma unroll
                    for (int bj = 0; bj < 2; ++bj) gf[ai][m][bj] = *(const unsigned long long*)(Gf + (size_t)(row0 + ai * HALF + m * 16) * ldc + col0 + bj * HALF);
#pragma unroll
            for (int ai = 0; ai < 2; ++ai)
#pragma unroll
                for (int m = 0; m < 4; ++m)
#pragma unroll
                    for (int bj = 0; bj < 2; ++bj) { const unsigned fw[2] = {(unsigned)gf[ai][m][bj], (unsigned)(gf[ai][m][bj] >> 32)}; const f32x4 v0 = acc[ai][bj][m][0], v1 = acc[ai][bj][m][1]; u32x4 w;
                        w.x = cvt_pk_bf16(v0[0] * q8_sigmoid(fw[0], 0), v0[1] * q8_sigmoid(fw[0], 1)); w.y = cvt_pk_bf16(v0[2] * q8_sigmoid(fw[0], 2), v0[3] * q8_sigmoid(fw[0], 3));
                        w.z = cvt_pk_bf16(v1[0] * q8_sigmoid(fw[1], 0), v1[1] * q8_sigmoid(fw[1], 1)); w.w = cvt_pk_bf16(v1[2] * q8_sigmoid(fw[1], 2), v1[3] * q8_sigmoid(fw[1], 3));
                        *(u32x4*)(O + (size_t)(row0 + ai * HALF + m * 16) * ldc + col0 + bj * HALF) = w; }
        }
        if (!has_next) break;
#pragma unroll
        for (int a = 0; a < 2; ++a)
#pragma unroll
            for (int b = 0; b < 2; ++b)
#pragma unroll
                for (int m = 0; m < 4; ++m)
#pragma unroll
                    for (int n = 0; n < 2; ++n) acc[a][b][m][n] = (f32x4){0.f, 0.f, 0.f, 0.f};
        cur = nxt; cA0 = nA; cB0 = nB; cA1 = (const char*)g1.A + (size_t)cur.pm * ts1; cB1 = (const char*)g1.Bt + (size_t)cur.pn * ts1; ++ui;
        if (wr == 1) PG8_BAR;
    }
    PG8_WAIT_V(0);
    PG8_BAR;
#undef PG8_SA
#undef PG8_SB
#undef PG8_STAGE
#undef PG8_LDA
#undef PG8_LDB
#undef PG8_MMA
#undef PG8_WAIT_V
#undef PG8_WAIT_L
#undef PG8_BAR
#undef PG8_SCHED
#undef PG8_KLOOP
}
}
namespace fox {
using bf16 = __hip_bfloat16;
constexpr int D = 128, SQ = 8192, SKV = 8192, QOFF = 0, WINDOW = SKV, PITCH = 1024;
constexpr float THR = 8.f; constexpr bool WSKIP = false;
constexpr float SCALE = 0.08838834764831845f;
constexpr int NW = 8, QBLK = 32, KVBLK = 64, QB = NW * QBLK;
constexpr int SHM_V = KVBLK * D * 2, SHM_K = KVBLK * D * 2;
constexpr int LDS_CS = 2 * SHM_V + 2 * SHM_K + NW * 64 * 4; constexpr int LDS_BYTES = LDS_CS + 2 * 64 * 4;

typedef short bf16x8 __attribute__((ext_vector_type(8)));
typedef short s16x4 __attribute__((ext_vector_type(4)));
typedef float f32x16 __attribute__((ext_vector_type(16)));
typedef float f32x4 __attribute__((ext_vector_type(4)));
typedef unsigned u32x4 __attribute__((ext_vector_type(4)));
template <class A, class Bt> struct same_t { static constexpr bool v = false; };
template <class A> struct same_t<A, A> { static constexpr bool v = true; };

#define KSWZ(row, colB) ((row) * 256 + ((colB) ^ (((row) & 7) << 4)))
#define SBAR() __builtin_amdgcn_sched_barrier(0)
__device__ __forceinline__ int v_st(int k, int c) { const int kk = (k & ~0xC) | ((k & 4) << 1) | ((k & 8) >> 1); return ((kk >> 3) * 4 + (c >> 5)) * 512 + ((kk & 7) * 32 + (c & 31)) * 2; }
__device__ __forceinline__ int v_rd_base(int lane) { return ((lane & 3) << 3) | (((lane >> 2) & 3) << 6) | (((lane >> 4) & 1) << 5) | (((lane >> 5) & 1) << 8); }
constexpr int v_rd_off(int d0, int ks, int half) { return d0 * 512 + ks * 4096 + half * 2048; }
__device__ __forceinline__ int crow(int r, int hi) { return (r & 3) + 8 * (r >> 2) + 4 * hi; }
__device__ __forceinline__ unsigned cvtpk(float lo, float hi) {
    unsigned r; asm volatile("v_cvt_pk_bf16_f32 %0, %1, %2" : "=v"(r) : "v"(lo), "v"(hi)); return r;
}
__device__ __forceinline__ bf16x8 pack8(f32x4 a, f32x4 b) {
    u32x4 w = {cvtpk(a[0], a[1]), cvtpk(a[2], a[3]), cvtpk(b[0], b[1]), cvtpk(b[2], b[3])};
    return *reinterpret_cast<bf16x8*>(&w);
}
template <class T> __device__ __forceinline__ bf16x8 load8(const T* p) {
    if constexpr (same_t<T, float>::v) { return pack8(*(const f32x4*)p, *(const f32x4*)(p + 4)); }
    else { return *reinterpret_cast<const bf16x8*>(p); }
}
__device__ __forceinline__ void mask_tile(f32x16& p0, f32x16& p1, int dq, unsigned W) {
    const float NEG = -__builtin_inff();
#pragma unroll
    for (int r = 0; r < 16; ++r) {
        const int c = (r & 3) + 8 * (r >> 2);
        if ((unsigned)(dq - c) >= W) p0[r] = NEG;
        if ((unsigned)(dq - c - 32) >= W) p1[r] = NEG;
    }
}
__device__ __forceinline__ void partialSM(f32x16& p0, f32x16& p1, float& m_reg, float& mn, float& alpha) {
    float pmax = p0[0]; for (int r = 1; r < 16; ++r) pmax = fmaxf(pmax, p0[r]); for (int r = 0; r < 16; ++r) pmax = fmaxf(pmax, p1[r]);
    { auto rr = __builtin_amdgcn_permlane32_swap(__float_as_uint(pmax), __float_as_uint(pmax), false, false);
      pmax = fmaxf(__uint_as_float(rr[0]), __uint_as_float(rr[1])); }
    constexpr float C2 = 1.4426950408889634f * SCALE;
    if (__builtin_expect(__all((pmax - m_reg) * SCALE <= THR), 1)) { mn = m_reg; alpha = 1.f; }
    else { mn = fmaxf(m_reg, pmax); alpha = __builtin_amdgcn_exp2f((m_reg - mn) * C2); m_reg = mn; }
    const float mnL = -mn * C2;
    for (int r = 0; r < 16; ++r) p0[r] = fmaf(p0[r], C2, mnL); for (int r = 0; r < 16; ++r) p1[r] = fmaf(p1[r], C2, mnL);
    for (int r = 0; r < 16; ++r) p0[r] = __builtin_amdgcn_exp2f(p0[r]);
}
__device__ __forceinline__ void finishSM(f32x16& p0, f32x16& p1, float alpha, float& l_reg, bf16x8& pa0, bf16x8& pa1, bf16x8& pa2, bf16x8& pa3) {
    for (int r = 0; r < 16; ++r) p1[r] = __builtin_amdgcn_exp2f(p1[r]);
    float ps = 0; for (int r = 0; r < 16; ++r) ps += p0[r]; for (int r = 0; r < 16; ++r) ps += p1[r];
    { auto rr = __builtin_amdgcn_permlane32_swap(__float_as_uint(ps), __float_as_uint(ps), false, false);
      ps = __uint_as_float(rr[0]) + __uint_as_float(rr[1]); }
    l_reg = l_reg * alpha + ps;
#define PK4(P, B_, OUT) do { unsigned a0 = cvtpk(P[B_+0], P[B_+1]), a1 = cvtpk(P[B_+2], P[B_+3]);                          \
        unsigned b0 = cvtpk(P[B_+4], P[B_+5]), b1 = cvtpk(P[B_+6], P[B_+7]);                                             \
        auto r0 = __builtin_amdgcn_permlane32_swap(a0, b0, false, false); auto r1 = __builtin_amdgcn_permlane32_swap(a1, b1, false, false); \
        u32x4 w = {r0[0], r1[0], r0[1], r1[1]}; OUT = *reinterpret_cast<bf16x8*>(&w); } while (0)
    PK4(p0, 0, pa0); PK4(p0, 8, pa1); PK4(p1, 0, pa2); PK4(p1, 8, pa3);
#undef PK4
}
template <int KB, bool SK>
__device__ __forceinline__ void qkt(f32x16& p0, f32x16& p1, const char* K_lds, int r32, int hi, const bf16x8* qr, bool act, const float* cs_lds) {
    if (SK && !act) { const float NEG = -__builtin_inff();
#pragma unroll
        for (int r = 0; r < 16; ++r) { p0[r] = NEG; p1[r] = NEG; } return; }
    { const float* ck_ = cs_lds + KB * 64 + 4 * hi;
#pragma unroll
      for (int g_ = 0; g_ < 4; ++g_) { const f32x4 c0_ = *(const f32x4*)(ck_ + 8 * g_), c1_ = *(const f32x4*)(ck_ + 32 + 8 * g_);
#pragma unroll
          for (int i_ = 0; i_ < 4; ++i_) { p0[4 * g_ + i_] = c0_[i_]; p1[4 * g_ + i_] = c1_[i_]; } } }
    const char* kb[4];
#pragma unroll
    for (int dd = 0; dd < 4; ++dd) kb[dd] = K_lds + KB * SHM_K + KSWZ(r32, (dd * 16 + hi * 8) * 2);
#pragma unroll
    for (int d0 = 0; d0 < 8; ++d0) { const char* a = kb[d0 & 3] + (d0 >> 2) * 128;
        bf16x8 b0 = *reinterpret_cast<const bf16x8*>(a);
        bf16x8 b1 = *reinterpret_cast<const bf16x8*>(a + 32 * 256);
        p0 = __builtin_amdgcn_mfma_f32_32x32x16_bf16(b0, qr[d0], p0, 0, 0, 0);
        p1 = __builtin_amdgcn_mfma_f32_32x32x16_bf16(b1, qr[d0], p1, 0, 0, 0); }
}
template <int VB, bool SK>
__device__ __forceinline__ void pv_tile(f32x16* o, int vb0, bf16x8 pa0, bf16x8 pa1, bf16x8 pa2, bf16x8 pa3, bool act) {
    if (SK && !act) return;
#define TRRD(dst, off) asm volatile("ds_read_b64_tr_b16 %0, %1 offset:%2" : "=&v"(dst) : "v"(vb0), "i"(off) : "memory")
#define PV_D0(d0) do { s16x4 l0, l1, l2, l3, h0, h1, h2, h3; constexpr int b_ = VB * SHM_V + v_rd_off(d0, 0, 0);     \
        TRRD(l0, b_); TRRD(h0, b_ + 2048); TRRD(l1, b_ + 4096); TRRD(h1, b_ + 6144); TRRD(l2, b_ + 8192); TRRD(h2, b_ + 10240); TRRD(l3, b_ + 12288); TRRD(h3, b_ + 14336); \
        asm volatile("s_waitcnt lgkmcnt(0)" ::: "memory"); SBAR();                 \
        o[d0] = __builtin_amdgcn_mfma_f32_32x32x16_bf16(pa0, (bf16x8){l0[0], l0[1], l0[2], l0[3], h0[0], h0[1], h0[2], h0[3]}, o[d0], 0, 0, 0);   \
        o[d0] = __builtin_amdgcn_mfma_f32_32x32x16_bf16(pa1, (bf16x8){l1[0], l1[1], l1[2], l1[3], h1[0], h1[1], h1[2], h1[3]}, o[d0], 0, 0, 0);   \
        o[d0] = __builtin_amdgcn_mfma_f32_32x32x16_bf16(pa2, (bf16x8){l2[0], l2[1], l2[2], l2[3], h2[0], h2[1], h2[2], h2[3]}, o[d0], 0, 0, 0);   \
        o[d0] = __builtin_amdgcn_mfma_f32_32x32x16_bf16(pa3, (bf16x8){l3[0], l3[1], l3[2], l3[3], h3[0], h3[1], h3[2], h3[3]}, o[d0], 0, 0, 0); } while (0)
    PV_D0(0); PV_D0(1); PV_D0(2); PV_D0(3);
#undef PV_D0
#undef TRRD
}

template <class TIn> struct FoxBases { const TIn* K; const TIn* V; const float* CS; };
template <class TIn, class TOut> struct BlockRef { const TIn* Q; unsigned kv; unsigned cs; int P0; int jlo; };
template <class TIn> struct Seam {
    bf16x8 qr[8];
    bf16x8 st_v0, st_v1, st_k0, st_k1; float st_c; f32x4 sf0, sf1, sf2, sf3;
    f32x4 tq[16];
};
__device__ __forceinline__ int swa_jlo(int P0, int W) { const int lowk = P0 - W + 1; return lowk > 0 ? lowk / KVBLK : 0; }
#define ROW(p, k0, rr) ((p) + (size_t)(k0) * PITCH + (((rr) == sr) ? ro0 : ro1))
#define VMW() asm volatile("s_waitcnt vmcnt(0)" ::: "memory")
#define VMWN(n) asm volatile("s_waitcnt vmcnt(%0)" :: "i"(n) : "memory")
#define SLOAD_H(Kp, Vp, Cp, k0) do { if (tid < 64) S.st_c = (Cp)[(k0) + tid]; S.st_v0 = load8<TIn>(ROW(Vp, k0, sr)); S.st_v1 = load8<TIn>(ROW(Vp, k0, 32 + sr));              \
                         S.st_k0 = load8<TIn>(ROW(Kp, k0, sr)); S.st_k1 = load8<TIn>(ROW(Kp, k0, 32 + sr)); } while (0)
#define SWRITE_HK(bf) do { if (tid < 64) cs_lds[(bf) * 64 + tid] = S.st_c; *(bf16x8*)(K_lds + (bf) * SHM_K + kws) = S.st_k0; *(bf16x8*)(K_lds + (bf) * SHM_K + kws + 32 * 256) = S.st_k1; } while (0)
#define SWRITE_HV(bf) do { *(bf16x8*)(V_lds + (bf) * SHM_V + vst0) = S.st_v0; *(bf16x8*)(V_lds + (bf) * SHM_V + vst1) = S.st_v1; } while (0)
#define SWRITE_H(bf) do { SWRITE_HV(bf); SWRITE_HK(bf); } while (0)
#define SLOAD_F(p, k0) do { S.sf0 = *(const f32x4*)ROW(p, k0, sr); S.sf1 = *(const f32x4*)(ROW(p, k0, sr) + 4);                \
                            S.sf2 = *(const f32x4*)ROW(p, k0, 32 + sr); S.sf3 = *(const f32x4*)(ROW(p, k0, 32 + sr) + 4); } while (0)
#define SWRITE_KF(bf) do { *(bf16x8*)(K_lds + (bf) * SHM_K + kws) = pack8(S.sf0, S.sf1); *(bf16x8*)(K_lds + (bf) * SHM_K + kws + 32 * 256) = pack8(S.sf2, S.sf3); } while (0)
#define SWRITE_VF(bf) do { *(bf16x8*)(V_lds + (bf) * SHM_V + vst0) = pack8(S.sf0, S.sf1); *(bf16x8*)(V_lds + (bf) * SHM_V + vst1) = pack8(S.sf2, S.sf3); } while (0)
template <class TIn, class TOut>
__device__ __forceinline__ void causal_swa_prime(const FoxBases<TIn>& FB, const BlockRef<TIn, TOut>& cur, int W, char* lds, Seam<TIn>& S) {
    constexpr bool F32 = same_t<TIn, float>::v;
    const int tid = threadIdx.x, wid = __builtin_amdgcn_readfirstlane(tid >> 6), lane = tid & 63, r32 = lane & 31, hi = lane >> 5;
    const int sr = tid >> 4, sc = (tid & 15) * 8, kws = KSWZ(sr, sc * 2); const unsigned ro0 = (unsigned)(sr * PITCH + sc), ro1 = ro0 + 32u * PITCH; char* K_lds = lds + 2 * SHM_V; float* cs_lds = (float*)(lds + LDS_CS);
    const int kb0 = cur.P0 + QB - KVBLK;
    for (int d0 = 0; d0 < 8; ++d0) S.qr[d0] = load8<TIn>(cur.Q + (unsigned)((wid * QBLK + r32) * PITCH) + d0 * 16 + hi * 8);
    if constexpr (F32) { SLOAD_F((const float*)(FB.K + cur.kv), kb0); VMW(); SWRITE_KF(0); SBAR(); SLOAD_F((const float*)(FB.V + cur.kv), kb0); }
    else { SLOAD_H(FB.K + cur.kv, FB.V + cur.kv, FB.CS + cur.cs, kb0); VMW(); SWRITE_HK(0); }
    __syncthreads();
}
template <class TIn, class TOut>
__device__ __forceinline__ void causal_swa_block(const FoxBases<TIn>& FB, const BlockRef<TIn, TOut>& cur, const BlockRef<TIn, TOut>& nxt, int skv, int W, char* lds, Seam<TIn>& S) {
    constexpr bool F32 = same_t<TIn, float>::v;
    const int tid = threadIdx.x, wid = __builtin_amdgcn_readfirstlane(tid >> 6), lane = tid & 63, r32 = lane & 31, hi = lane >> 5;
    const int j_lo = cur.jlo;
    int j_hi = (cur.P0 + QB - 1) / KVBLK + 1; if (j_hi > skv / KVBLK) j_hi = skv / KVBLK;
    const int NT = j_hi - j_lo;
    const int kbn = nxt.P0 + QB - KVBLK;
    const int qlo = cur.P0 + wid * QBLK, qm = qlo + r32 - 4 * hi;
    char* V_lds = lds; char* K_lds = lds + 2 * SHM_V; float* cs_lds = (float*)(lds + LDS_CS);
    float* ws = (float*)(lds + 2 * SHM_V + 2 * SHM_K) + wid * 64; float* li_l = ws, * al_l = ws + 32;
    float m_reg = -1e30f, l_reg = 0; f32x16 o[4] = {};
    const int sr = tid >> 4, sc = (tid & 15) * 8, vst0 = v_st(sr, sc), vst1 = v_st(32 + sr, sc), kws = KSWZ(sr, sc * 2); const unsigned ro0 = (unsigned)(sr * PITCH + sc), ro1 = ro0 + 32u * PITCH;
    const int vb0 = (int)(uintptr_t)V_lds + v_rd_base(lane);
    const TIn* Kh = FB.K + cur.kv; const TIn* Vh = FB.V + cur.kv; const float* Ch = FB.CS + cur.cs;
#define RESC(a) do { if (__any((a) < 1.f)) { if (hi == 0) al_l[r32] = (a); asm volatile("s_waitcnt lgkmcnt(0)" ::: "memory");              \
                     for (int d_ = 0; d_ < 4; ++d_) for (int r = 0; r < 16; ++r) o[d_][r] *= al_l[crow(r, hi)]; } } while (0)
#define KBASE(t) ((j_hi - 1 - (t)) * KVBLK)
#define ACT(t) (KBASE(t) <= qlo + QBLK - 1 && KBASE(t) + KVBLK - 1 >= qlo - W + 1)
#define MASKT(P0_, P1_, t) do { const int kb_ = KBASE(t); if ((!SK || ACT(t)) && (kb_ + KVBLK - 1 > qlo || kb_ <= qlo + QBLK - 1 - W)) mask_tile(P0_, P1_, qm - kb_, (unsigned)W); } while (0)
    constexpr int NQL = F32 ? 16 : 8;
    constexpr bool SK = WSKIP && !F32;
#define SEAM_K0() do { VMWN(NQL); if constexpr (F32) { SWRITE_KF(0); SBAR(); SLOAD_F((const float*)(FB.V + nxt.kv), kbn); } else { SWRITE_HK(0); } SBAR(); } while (0)
    f32x16 pA0, pA1, pB0, pB1; float mnA, mnB, alA, alB; bf16x8 pa0, pa1, pa2, pa3;
    if constexpr (F32) { VMW(); SWRITE_VF(0); SBAR(); } else { SWRITE_HV(0); SBAR(); }
    if (NT > 1) { if constexpr (F32) SLOAD_F((const float*)Kh, KBASE(1)); else SLOAD_H(Kh, Vh, Ch, KBASE(1)); }
    SBAR(); qkt<0, SK>(pA0, pA1, K_lds, r32, hi, S.qr, ACT(0), cs_lds);
    if constexpr (F32) { if (NT > 1) { VMW(); SWRITE_KF(1); SBAR(); SLOAD_F((const float*)Vh, KBASE(1)); } }
    MASKT(pA0, pA1, 0); partialSM(pA0, pA1, m_reg, mnA, alA);
    if (NT > 1) { VMW(); if constexpr (F32) { SWRITE_VF(1); SBAR(); if (NT > 2) SLOAD_F((const float*)Kh, KBASE(2)); } else SWRITE_H(1); }
    __syncthreads();
#define HALF_STEP(PX0, PX1, mnX, alX, PY0, PY1, alY, t, KB, VB, SB) do {                                                      \
        SBAR(); qkt<KB, SK>(PX0, PX1, K_lds, r32, hi, S.qr, ACT(t), cs_lds);                                             \
        finishSM(PY0, PY1, alY, l_reg, pa0, pa1, pa2, pa3); SBAR();                                                           \
        if ((t) + 1 < NT) { if constexpr (F32) { VMW(); SWRITE_KF(SB); SBAR(); SLOAD_F((const float*)Vh, KBASE((t) + 1)); }  \
                            else { SLOAD_H(Kh, Vh, Ch, KBASE((t) + 1)); } SBAR(); }                                               \
        pv_tile<VB, SK>(o, vb0, pa0, pa1, pa2, pa3, ACT((t) - 1)); MASKT(PX0, PX1, (t)); partialSM(PX0, PX1, m_reg, mnX, alX);                                        \
        __syncthreads();                                                                                                      \
        if ((t) + 1 < NT) { VMW(); if constexpr (F32) { SWRITE_VF(SB); SBAR(); if ((t) + 2 < NT) SLOAD_F((const float*)Kh, KBASE((t) + 2)); } \
                            else { SWRITE_H(SB); } }                                                                          \
        RESC(alX); __syncthreads(); } while (0)
    for (int t = 1; t + 1 < NT; t += 2) {
        HALF_STEP(pB0, pB1, mnB, alB, pA0, pA1, alA, t, 1, 0, 0);
        HALF_STEP(pA0, pA1, mnA, alA, pB0, pB1, alB, t + 1, 0, 1, 1);
    }
    const bool even = (NT & 1) == 0;
    if (even) { SBAR(); qkt<1, SK>(pB0, pB1, K_lds, r32, hi, S.qr, ACT(NT - 1), cs_lds); SBAR(); }
#define QROW(e) (nxt.Q + (unsigned)((wid * QBLK + r32) * PITCH) + ((e) >> 1) * 16 + hi * 8 + ((e) & 1) * 4)
    if constexpr (F32) { SLOAD_F((const float*)(FB.K + nxt.kv), kbn); SBAR();
#pragma unroll
        for (int e = 0; e < 8; ++e) S.tq[e] = *(const f32x4*)QROW(e); }
    else { SLOAD_H(FB.K + nxt.kv, FB.V + nxt.kv, FB.CS + nxt.cs, kbn); SBAR();
#pragma unroll
        for (int d0 = 0; d0 < 8; ++d0) S.qr[d0] = load8<TIn>(nxt.Q + (unsigned)((wid * QBLK + r32) * PITCH) + d0 * 16 + hi * 8); }
    SBAR();
    finishSM(pA0, pA1, alA, l_reg, pa0, pa1, pa2, pa3); SBAR();
    if constexpr (F32) {
#pragma unroll
        for (int e = 8; e < 16; ++e) S.tq[e] = *(const f32x4*)QROW(e); SBAR(); }
#undef QROW
    pv_tile<0, SK>(o, vb0, pa0, pa1, pa2, pa3, ACT(even ? NT - 2 : NT - 1));
    if (even) { MASKT(pB0, pB1, NT - 1); partialSM(pB0, pB1, m_reg, mnB, alB); __syncthreads(); RESC(alB);
        finishSM(pB0, pB1, alB, l_reg, pa0, pa1, pa2, pa3); SBAR(); pv_tile<1, SK>(o, vb0, pa0, pa1, pa2, pa3, ACT(NT - 1)); }
    SBAR(); SEAM_K0();
    if (hi == 0) li_l[r32] = l_reg; asm volatile("s_waitcnt lgkmcnt(0)" ::: "memory");
    float rli[16];
#pragma unroll
    for (int r = 0; r < 16; ++r) rli[r] = __builtin_amdgcn_rcpf(li_l[crow(r, hi)]);
    TOut* Ow = (TOut*)cur.Q + (unsigned)((wid * QBLK) * PITCH);
#pragma unroll
    for (int r = 0; r < 16; ++r) { const int orow = crow(r, hi);
#pragma unroll
        for (int d0 = 0; d0 < 4; ++d0) { const float v = o[d0][r] * rli[r];
            if constexpr (same_t<TOut, float>::v) { Ow[(unsigned)(orow * PITCH) + d0 * 32 + r32] = v; }
            else { const float vn = __shfl_xor(v, 1);
                   if ((r32 & 1) == 0) *(unsigned*)(Ow + (unsigned)(orow * PITCH) + d0 * 32 + r32) = cvtpk(v, vn); } } }
    if constexpr (F32) {
#pragma unroll
        for (int d0 = 0; d0 < 8; ++d0) S.qr[d0] = pack8(S.tq[2 * d0], S.tq[2 * d0 + 1]); }
    __syncthreads();
#undef RESC
#undef KBASE
#undef ACT
#undef MASKT
#undef SEAM_K0
#undef HALF_STEP
}
#undef ROW
#undef VMW
#undef VMWN
#undef SLOAD_H
#undef SWRITE_HK
#undef SWRITE_HV
#undef SWRITE_H
#undef SLOAD_F
#undef SWRITE_KF
#undef SWRITE_VF

}
namespace fox {
constexpr float SKIP_LOG = 12.f;
__device__ __forceinline__ BlockRef<bf16, bf16> mkref(int b, int n, const bf16* Q, const int* JLO) {
    const int h = 7 - (n >> 5), qb = 31 - (n & 31), bh = b * 8 + h; const unsigned base = (unsigned)b * SKV * PITCH + (unsigned)h * D;
    BlockRef<bf16, bf16> r; r.Q = Q + base + (size_t)qb * QB * PITCH; r.kv = base; r.cs = (unsigned)bh * SKV; r.P0 = qb * QB;
    r.jlo = JLO[bh * 32 + qb];
    return r;
}
__device__ __forceinline__ void jlo_table(const float* CS, const float* DQK, const float* qg, const float* kg, int* JLO, int gw, int NGW, int lane) {
    float gq = fmaxf(fabsf(qg[lane]), fabsf(qg[64 + lane])), gk = fmaxf(fabsf(kg[lane]), fabsf(kg[64 + lane]));
#pragma unroll
    for (int o = 1; o < 64; o <<= 1) { gq = fmaxf(gq, __shfl_xor(gq, o)); gk = fmaxf(gk, __shfl_xor(gk, o)); }
    const float qkmax = 128.f * gq * gk;
    for (int i = gw; i < 64 * 32; i += NGW) { const int bh = i >> 5, qb = i & 31, b = bh >> 3, h = bh & 7; const float* cs = CS + (size_t)bh * SKV;
        float dmin = 3.4e38f;
#pragma unroll
        for (int r = 0; r < 4; ++r) dmin = fminf(dmin, DQK[((size_t)b * SKV + qb * QB + 64 * r + lane) * 8 + h]);
#pragma unroll
        for (int o = 1; o < 64; o <<= 1) dmin = fminf(dmin, __shfl_xor(dmin, o));
        dmin = fmaxf(dmin - 0.01f * fabsf(dmin) - 0.01f, -qkmax);
        const float thr = cs[qb * QB] - qkmax + dmin - SKIP_LOG * 11.313708498984761f; const int nt = 4 * qb;
        const bool c0 = lane < nt && cs[64 * lane + 63] < thr, c1 = lane + 64 < nt && cs[64 * (lane + 64) + 63] < thr;
        const int j = __popcll(__ballot(c0)) + __popcll(__ballot(c1));
        if (lane == 0) JLO[i] = j; }
}
struct JloPre { float c0v, e0, e1; };
__device__ __forceinline__ void jlo_pre(const float* CS, int b, int h, int qb, int lane, JloPre& p) {
    const float* cs = CS + (size_t)(b * 8 + h) * SKV; const int nt = 4 * qb;
    p.c0v = cs[qb * QB]; p.e0 = lane < nt ? cs[64 * lane + 63] : 0.f; p.e1 = lane + 64 < nt ? cs[64 * (lane + 64) + 63] : 0.f;
}
__device__ __forceinline__ void jlo_block(const JloPre& p, const __attribute__((address_space(3))) float* dq, float qkmax, int* JLO, int b, int h, int qb, int lane) {
    const int bh = b * 8 + h; const int nt = 4 * qb;
    float dmin = 3.4e38f;
#pragma unroll
    for (int r = 0; r < 4; ++r) dmin = fminf(dmin, dq[(64 * r + lane) * 8 + h]);
#pragma unroll
    for (int o = 1; o < 64; o <<= 1) dmin = fminf(dmin, __shfl_xor(dmin, o));
    dmin = fmaxf(dmin - 0.01f * fabsf(dmin) - 0.01f, -qkmax);
    const float thr = p.c0v - qkmax + dmin - SKIP_LOG * 11.313708498984761f;
    const bool c0 = lane < nt && p.e0 < thr, c1 = lane + 64 < nt && p.e1 < thr;
    const int j = __popcll(__ballot(c0)) + __popcll(__ballot(c1));
    if (lane == 0) JLO[bh * 32 + qb] = j;
}
__device__ __forceinline__ float jlo_qkmax(const float* qg, const float* kg, int lane) {
    float gq = fmaxf(fabsf(qg[lane]), fabsf(qg[64 + lane])), gk = fmaxf(fabsf(kg[lane]), fabsf(kg[64 + lane]));
#pragma unroll
    for (int o = 1; o < 64; o <<= 1) { gq = fmaxf(gq, __shfl_xor(gq, o)); gk = fmaxf(gk, __shfl_xor(gk, o)); }
    return 128.f * gq * gk;
}
__device__ __forceinline__ int fetch_ticket(unsigned* Qw, int xcc) {
    for (int s = 0; s < 8; ++s) { const int b = (xcc + s) & 7; const unsigned n = __hip_atomic_fetch_add(Qw + 64 * b, 1u, __ATOMIC_RELAXED, __HIP_MEMORY_SCOPE_AGENT); if (n < 256u) return b * 256 + (int)n; }
    return 1 << 20;
}
__device__ __forceinline__ void phase(char* lds, const bf16* Q, const bf16* K, const bf16* V, bf16* O, const float* CS, const int* JLO, unsigned* Qw, int xcc, unsigned* done = nullptr) {
    const int tid = threadIdx.x; const FoxBases<bf16> FB{K, V, CS}; (void)O;
    volatile int* tk = (volatile int*)(lds + LDS_BYTES);
    __syncthreads();
    if (tid == 0) { tk[0] = fetch_ticket(Qw, xcc); tk[1] = fetch_ticket(Qw, xcc); }
    __syncthreads();
    int n0 = __builtin_amdgcn_readfirstlane(tk[0]), n1 = __builtin_amdgcn_readfirstlane(tk[1]);
    if (n0 >= 2048) return;
    BlockRef<bf16, bf16> cur = mkref(n0 >> 8, n0 & 255, Q, JLO);
    Seam<bf16> S;
    causal_swa_prime<bf16, bf16>(FB, cur, WINDOW, lds, S);
    for (;;) {
        const bool last = n1 >= 2048;
        const BlockRef<bf16, bf16> nxt = last ? cur : mkref(n1 >> 8, n1 & 255, Q, JLO);
        if (tid == 0 && !last) tk[0] = fetch_ticket(Qw, xcc);
        causal_swa_block<bf16, bf16>(FB, cur, nxt, SKV, WINDOW, lds, S);
        if (done && tid == 0) __hip_atomic_fetch_add(done, 1u, __ATOMIC_RELAXED, __HIP_MEMORY_SCOPE_AGENT);
        if (last) break;
        cur = nxt; n1 = __builtin_amdgcn_readfirstlane(tk[0]);
        __syncthreads();
    }
}
}
__device__ __forceinline__ int sortable(float f) { int i = __builtin_bit_cast(int, f); return i ^ ((i >> 31) & 0x7fffffff); }
__device__ __forceinline__ float unsortable(int i) { return __builtin_bit_cast(float, i ^ ((i >> 31) & 0x7fffffff)); }
__device__ __forceinline__ int med3i(int a, int b, int c) { int r; asm("v_med3_i32 %0, %1, %2, %3" : "=v"(r) : "v"(a), "v"(b), "v"(c)); return r; }
__device__ __forceinline__ void ins16(int (&t)[16], int x) {
#pragma unroll
    for (int i = 15; i >= 1; --i) t[i] = med3i(t[i - 1], t[i], x);
    t[0] = t[0] > x ? t[0] : x;
}
__device__ __forceinline__ void sort16_desc(int (&k)[16]) {
    constexpr int SI[63] = {0, 2, 0, 1, 1, 4, 6, 4, 5, 5, 0, 2, 2, 1, 3, 3, 1, 3, 5, 8, 10, 8, 9, 9, 12, 14, 12, 13, 13, 8, 10, 10, 9, 11, 11, 9, 11, 13, 0, 4, 4, 2, 6, 6, 2, 6, 10, 1, 5, 5, 3, 7, 7, 3, 7, 11, 1, 3, 5, 7, 9, 11, 13};
    constexpr int SJ[63] = {1, 3, 2, 3, 2, 5, 7, 6, 7, 6, 4, 6, 4, 5, 7, 5, 2, 4, 6, 9, 11, 10, 11, 10, 13, 15, 14, 15, 14, 12, 14, 12, 13, 15, 13, 10, 12, 14, 8, 12, 8, 10, 14, 10, 4, 8, 12, 9, 13, 9, 11, 15, 11, 5, 9, 13, 2, 4, 6, 8, 10, 12, 14};
#pragma unroll
    for (int c = 0; c < 63; ++c) { const int a = k[SI[c]], b = k[SJ[c]]; k[SI[c]] = a > b ? a : b; k[SJ[c]] = a > b ? b : a; }
}
__device__ __forceinline__ void merge16_top(int (&t)[16], const int (&s_)[16]) {
#pragma unroll
    for (int i = 0; i < 16; ++i) t[i] = t[i] > s_[15 - i] ? t[i] : s_[15 - i];
#pragma unroll
    for (int d = 8; d >= 1; d >>= 1)
#pragma unroll
        for (int i = 0; i < 16; ++i) if ((i & d) == 0) { const int hi_ = t[i] > t[i + d] ? t[i] : t[i + d], lo_ = t[i] > t[i + d] ? t[i + d] : t[i]; t[i] = hi_; t[i + d] = lo_; }
}
struct P9Args { const bf16raw* QH; const bf16raw* SKB; unsigned short* IDS; float* GW; };
constexpr int P9_KP = 136;
__device__ __forceinline__ void p9_half(const LAS bf16raw* SK, const bf16x8 (&bq)[8], int m32, int hh, int (&t)[16]) {
#pragma unroll
    for (int kt = 0; kt < 4; ++kt) {
        f32x16 acc;
#pragma unroll
        for (int r = 0; r < 16; ++r) acc[r] = 0.f;
#pragma unroll
        for (int kk = 0; kk < 8; ++kk) { const bf16x8 af = *(const LAS bf16x8*)(SK + (32 * kt + m32) * P9_KP + 16 * kk + 8 * hh);
            acc = __builtin_amdgcn_mfma_f32_32x32x16_bf16(af, bq[kk], acc, 0, 0, 0); }
        int k[16];
#pragma unroll
        for (int r = 0; r < 16; ++r) { const int kidx = 32 * kt + (r & 3) + 8 * (r >> 2) + 4 * hh; k[r] = (sortable(acc[r]) & ~127) | (127 - kidx); }
        sort16_desc(k);
        if (kt == 0) {
#pragma unroll
            for (int i = 0; i < 16; ++i) t[i] = k[i];
        } else merge16_top(t, k);
    }
    int p[16];
#pragma unroll
    for (int i = 0; i < 16; ++i) { auto rr = __builtin_amdgcn_permlane32_swap((unsigned)t[i], (unsigned)t[i], false, false); p[i] = (int)(hh ? rr[0] : rr[1]); }
    merge16_top(t, p);
}
struct P9Stage { v4u r[4]; };
__device__ __forceinline__ void p9_stage_load(const bf16raw* SKB, int hc, int tid, P9Stage& g) {
#pragma unroll
    for (int k = 0; k < 4; ++k) { const int i = tid + 512 * k, row = i >> 4, ch = i & 15; g.r[k] = *(const v4u*)(SKB + ((size_t)hc * 128 + row) * 128 + 8 * ch); }
}
__device__ __forceinline__ void p9_stage_write(LAS unsigned char* lds, int buf, int tid, const P9Stage& g) {
#pragma unroll
    for (int k = 0; k < 4; ++k) { const int i = tid + 512 * k, row = i >> 4, ch = i & 15; *(LAS v4u*)(lds + buf * (128 * P9_KP * 2) + row * (P9_KP * 2) + 16 * ch) = g.r[k]; }
}
__device__ __forceinline__ void p9_stage(const bf16raw* SKB, LAS unsigned char* lds, int buf, int hc, int tid) { P9Stage g; p9_stage_load(SKB, hc, tid, g); p9_stage_write(lds, buf, tid, g); }
__device__ __forceinline__ void p9_q_load(const P9Args& a, size_t tok, int h, int c, int hh, bf16x8 (&bq)[8]) {
#pragma unroll
    for (int kk = 0; kk < 8; ++kk) bq[kk] = *(const bf16x8*)(a.QH + tok * 2048 + h * 256 + c * 128 + 16 * kk + 8 * hh);
}
__device__ __forceinline__ int pick8(unsigned long long lo, unsigned long long hi, int i) { const unsigned long long w = (i & 8) ? hi : lo; return (int)((w >> (8 * (i & 7))) & 255ull); }
__device__ __forceinline__ void p9_topk(LAS unsigned char* lds, const P9Args& a, int wg0, int nwg, int wave, int lane, int tid) {
    const int m32 = lane & 31, hh = lane >> 5;
    for (int tw = wg0; tw < M / 256; tw += nwg) {
        const size_t tok = (size_t)tw * 256 + 32 * wave + m32;
        __syncthreads();
        p9_stage(a.SKB, lds, 0, 0, tid);
        __syncthreads();
        bf16x8 bqA[8], bqB[8]; P9Stage sg;
        p9_q_load(a, tok, 0, 0, hh, bqA);
        for (int h = 0; h < PH; ++h) {
            int L0[16], L1[16];
            p9_stage_load(a.SKB, 2 * h + 1, tid, sg); p9_q_load(a, tok, h, 1, hh, bqB);
            p9_half((const LAS bf16raw*)(lds), bqA, m32, hh, L0);
            p9_stage_write(lds, 1, tid, sg);
            __syncthreads();
            if (h + 1 < PH) { p9_stage_load(a.SKB, 2 * h + 2, tid, sg); p9_q_load(a, tok, h + 1, 0, hh, bqA); }
            p9_half((const LAS bf16raw*)(lds + 128 * P9_KP * 2), bqB, m32, hh, L1);
            float v0[16], v1[16]; unsigned long long P0l = 0, P0h = 0, P1l = 0, P1h = 0;
#pragma unroll
            for (int i = 0; i < 16; ++i) { v0[i] = unsortable(L0[i] & ~127); v1[i] = unsortable(L1[i] & ~127);
                if (i < 8) { P0l |= (unsigned long long)(127 - (L0[i] & 127)) << (8 * (i & 7)); P1l |= (unsigned long long)(127 - (L1[i] & 127)) << (8 * (i & 7)); }
                else { P0h |= (unsigned long long)(127 - (L0[i] & 127)) << (8 * (i & 7)); P1h |= (unsigned long long)(127 - (L1[i] & 127)) << (8 * (i & 7)); } }
            int t2[16];
#pragma unroll
            for (int i = 0; i < 16; ++i) t2[i] = (int)0x80000000;
#pragma unroll
            for (int i = 0; i < 16; ++i)
#pragma unroll
                for (int j = 0; j < 16; ++j) if ((i + 1) * (j + 1) <= 16) ins16(t2, (sortable(v0[i] + v1[j]) & ~255) | (255 - (16 * i + j)));
            const float ts0 = unsortable(t2[0] & ~255); float ex[16]; int ids[16]; float sum = 0.f;
#pragma unroll
            for (int k = 0; k < 16; ++k) { ex[k] = __expf(unsortable(t2[k] & ~255) - ts0); sum += ex[k];
                const int ci = 255 - (t2[k] & 255), i = ci >> 4, j = ci & 15;
                ids[k] = pick8(P0l, P0h, i) * 128 + pick8(P1l, P1h, j); }
            const float inv = __builtin_amdgcn_rcpf(sum);
            if (hh == 0) {
#pragma unroll
                for (int q = 0; q < 2; ++q) *(v4u*)(a.IDS + tok * HK + h * 16 + 8 * q) = (v4u){(unsigned)ids[8 * q] | ((unsigned)ids[8 * q + 1] << 16), (unsigned)ids[8 * q + 2] | ((unsigned)ids[8 * q + 3] << 16), (unsigned)ids[8 * q + 4] | ((unsigned)ids[8 * q + 5] << 16), (unsigned)ids[8 * q + 6] | ((unsigned)ids[8 * q + 7] << 16)};
            } else {
#pragma unroll
                for (int q = 0; q < 4; ++q) *(f32x4*)(a.GW + tok * HK + h * 16 + 4 * q) = (f32x4){ex[4 * q] * inv, ex[4 * q + 1] * inv, ex[4 * q + 2] * inv, ex[4 * q + 3] * inv};
            }
            if (h + 1 < PH) p9_stage_write(lds, 0, tid, sg);
            __syncthreads();
        }
    }
}

constexpr float U_SCALE = 256.f, V_SCALE = 16.f, U4_STEP = 0.345f, X7_RESCALE = 127.f / 63.f;
constexpr size_t SLICE_BYTES = (size_t)NEXP * 128;
__device__ __forceinline__ void cvt16p(const v4u r, f32x2 (&f)[8]) {
    const unsigned w[4] = {r.x, r.y, r.z, r.w};
#pragma unroll
    for (int i = 0; i < 4; ++i) { f[2 * i] = __builtin_amdgcn_cvt_pk_f32_fp8((int)w[i], false); f[2 * i + 1] = __builtin_amdgcn_cvt_pk_f32_fp8((int)w[i], true); }
}
__device__ __forceinline__ unsigned e2m1_code(float x) {
    const float m = fabsf(x);
    const unsigned c = (unsigned)(m > 0.25f) + (unsigned)(m >= 0.75f) + (unsigned)(m > 1.25f) + (unsigned)(m >= 1.75f) + (unsigned)(m > 2.5f) + (unsigned)(m >= 3.5f) + (unsigned)(m > 5.f);
    return c | (x < 0.f ? 8u : 0u);
}
__device__ __forceinline__ float e2m1_val(unsigned c) { const unsigned m = c & 7u; const float v = m < 4u ? 0.5f * (float)m : m == 4u ? 2.f : m == 5u ? 3.f : m == 6u ? 4.f : 6.f; return (c & 8u) ? -v : v; }
typedef __amdgpu_buffer_rsrc_t prsrc_t;
__device__ __forceinline__ v4u pbld16(prsrc_t r, unsigned voff) { return __builtin_bit_cast(v4u, __builtin_amdgcn_raw_buffer_load_b128(r, (int)voff, 0, 0)); }
template <int CTRL> __device__ __forceinline__ float dpp_add(float v) { return v + __builtin_bit_cast(float, __builtin_amdgcn_update_dpp(0, __builtin_bit_cast(int, v), CTRL, 0xf, 0xf, false)); }
template <int CTRL> __device__ __forceinline__ int dpp_addi(int v) { return v + __builtin_amdgcn_update_dpp(0, v, CTRL, 0xf, 0xf, false); }
__device__ __forceinline__ void p15_udot(const unsigned char* XH, const unsigned char* XL, const unsigned char* U4S, const unsigned short* IDS, short* PA, unsigned* Q, int xcc, int lane) {
    const int sub = lane & 7, tk = lane >> 3;
    for (int sidx = 0; sidx < 4; ++sidx) { const int s = (xcc + sidx) & 3; const prsrc_t tab = __builtin_amdgcn_make_buffer_rsrc((void*)(U4S + (size_t)s * SLICE_BYTES), (short)0, (int)SLICE_BYTES, 0x00020000);
        unsigned tn_raw = 0; if (lane == 0) tn_raw = __hip_atomic_fetch_add(Q + 64 * s, 16u, __ATOMIC_RELAXED, __HIP_MEMORY_SCOPE_AGENT);
        for (;;) {
            const unsigned t0 = (unsigned)__builtin_amdgcn_readfirstlane((int)tn_raw);
            if (t0 >= (unsigned)M) break;
            tn_raw = 0; if (lane == 0) tn_raw = __hip_atomic_fetch_add(Q + 64 * s, 16u, __ATOMIC_RELAXED, __HIP_MEMORY_SCOPE_AGENT);
            const size_t tA = (size_t)t0 + tk, tB = tA + 8;
            auto xload = [&](size_t t, v4u& xh, v4u& xl) { xh = *(const v4u*)(XH + t * 512 + 128 * s + 16 * sub); xl = *(const v4u*)(XL + t * 512 + 128 * s + 16 * sub); };
            auto gather = [&](size_t t, int b8, v4u (&row)[16]) { const int i0 = 16 * b8; int id[16];
#pragma unroll
                for (int q = 0; q < 2; ++q) { const v4u v = *(const v4u*)(IDS + t * HK + i0 + 8 * q); id[8 * q] = v.x & 0xffffu; id[8 * q + 1] = v.x >> 16; id[8 * q + 2] = v.y & 0xffffu; id[8 * q + 3] = v.y >> 16; id[8 * q + 4] = v.z & 0xffffu; id[8 * q + 5] = v.z >> 16; id[8 * q + 6] = v.w & 0xffffu; id[8 * q + 7] = v.w >> 16; }
#pragma unroll
                for (int i = 0; i < 16; ++i) row[i] = pbld16(tab, (unsigned)id[i] * 128u + 16u * sub); };
            auto dots = [&](const v4u xh, const v4u xl, const v4u (&row)[16], int& r0, int& r1) { r0 = 0; r1 = 0;
#pragma unroll
                for (int i = 0; i < 16; ++i) { int ph = __builtin_amdgcn_sdot8((int)xh.x, (int)row[i].x, 0, false); ph = __builtin_amdgcn_sdot8((int)xh.y, (int)row[i].y, ph, false);
                    ph = __builtin_amdgcn_sdot8((int)xh.z, (int)row[i].z, ph, false); ph = __builtin_amdgcn_sdot8((int)xh.w, (int)row[i].w, ph, false);
                    int p = __builtin_amdgcn_sdot8((int)xl.x, (int)row[i].x, ph << 3, false); p = __builtin_amdgcn_sdot8((int)xl.y, (int)row[i].y, p, false);
                    p = __builtin_amdgcn_sdot8((int)xl.z, (int)row[i].z, p, false); p = __builtin_amdgcn_sdot8((int)xl.w, (int)row[i].w, p, false);
                    p = dpp_addi<0xB1>(p); p = dpp_addi<0x4E>(p); p = dpp_addi<0x141>(p);
                    if (sub == (i & 7)) { if (i < 8) r0 = p; else r1 = p; } } };
            auto store = [&](size_t t, const int (&res)[16]) {
#pragma unroll
                for (int q = 0; q < 2; ++q) { unsigned w[4];
#pragma unroll
                    for (int z = 0; z < 4; ++z) { const int lo = min(max(res[8 * q + 2 * z], -32767), 32767), hi = min(max(res[8 * q + 2 * z + 1], -32767), 32767); w[z] = ((unsigned)lo & 0xffffu) | ((unsigned)hi << 16); }
                    *(v4u*)(PA + ((size_t)s * M + t) * HK + q * 64 + sub * 8) = (v4u){w[0], w[1], w[2], w[3]}; } };
            v4u rowA[16], rowB[16], xah, xal, xbh, xbl; int resA[16], resB[16];
            xload(tA, xah, xal); gather(tA, 0, rowA);
#pragma unroll
            for (int b8 = 0; b8 < 6; b8 += 2) { gather(tA, b8 + 1, rowB); dots(xah, xal, rowA, resA[2 * b8], resA[2 * b8 + 1]); gather(tA, b8 + 2, rowA); dots(xah, xal, rowB, resA[2 * b8 + 2], resA[2 * b8 + 3]); }
            gather(tA, 7, rowB); dots(xah, xal, rowA, resA[12], resA[13]);
            xload(tB, xbh, xbl); gather(tB, 0, rowA);
            dots(xah, xal, rowB, resA[14], resA[15]);
            store(tA, resA);
#pragma unroll
            for (int b8 = 0; b8 < 6; b8 += 2) { gather(tB, b8 + 1, rowB); dots(xbh, xbl, rowA, resB[2 * b8], resB[2 * b8 + 1]); gather(tB, b8 + 2, rowA); dots(xbh, xbl, rowB, resB[2 * b8 + 2], resB[2 * b8 + 3]); }
            gather(tB, 7, rowB); dots(xbh, xbl, rowA, resB[12], resB[13]); dots(xbh, xbl, rowB, resB[14], resB[15]);
            store(tB, resB);
        }
    }
}
struct ActL1 { short pa[2][4]; unsigned short id[2]; float gw[2]; float sx; };
struct ActL2 { float su[2], sv[2]; };
__device__ __forceinline__ void act_l1(const short* PA, const float* GW, const float* SX, const unsigned short* IDS, int t, int lane, ActL1& r) {
    r.sx = SX[t];
#pragma unroll
    for (int h = 0; h < 2; ++h) { const int e = lane + 64 * h, pos = (e >> 6) * 64 + (e & 7) * 8 + ((e >> 3) & 7);
#pragma unroll
        for (int s = 0; s < 4; ++s) r.pa[h][s] = PA[((size_t)s * M + t) * HK + pos];
        r.id[h] = IDS[(size_t)t * HK + e]; r.gw[h] = GW[(size_t)t * HK + e]; }
}
struct ActS { ActL1 a; ActL2 b; };
__device__ __forceinline__ void p15b_act(const short* PA, const float* GW, unsigned char* W4, float* WSC, const float* SX, const float* SU, const float* SV, const unsigned short* IDS, int gw, int NGW, int lane) {
    if (gw >= M) return;
    auto L1 = [&](int t, ActS& r) { act_l1(PA, GW, SX, IDS, t < M ? t : gw, lane, r.a); };
    auto L2 = [&](ActS& r) {
#pragma unroll
        for (int h = 0; h < 2; ++h) { r.b.su[h] = SU[r.a.id[h]]; r.b.sv[h] = SV[r.a.id[h]]; } };
    auto PROC = [&](int t, const ActS& r) {
        float w[2]; const float sx = r.a.sx * X7_RESCALE;
#pragma unroll
        for (int h = 0; h < 2; ++h) { const int a = (int)r.a.pa[h][0] + (int)r.a.pa[h][1] + (int)r.a.pa[h][2] + (int)r.a.pa[h][3]; w[h] = r.a.gw[h] * gelu_erf((float)a * sx * r.b.su[h]) * r.b.sv[h]; }
        float mx = wave_max_dpp(fmaxf(fabsf(w[0]), fabsf(w[1])));
        mx = fmaxf(mx, 1e-30f); const float sc = 6.f * __builtin_amdgcn_rcpf(mx); if (lane == 0) WSC[t] = mx * (1.f / 6.f);
#pragma unroll
        for (int h = 0; h < 2; ++h) { float x = w[h] * sc;
#pragma unroll
            for (int r4 = 0; r4 < 4; ++r4) { const unsigned c = e2m1_code(fminf(fmaxf(x, -6.f), 6.f)); x = (x - e2m1_val(c)) * 4.f;
                const unsigned oc = (unsigned)__builtin_amdgcn_update_dpp(0, (int)c, 0xB1, 0xf, 0xf, false);
                if (!(lane & 1)) W4[(size_t)t * 256 + r4 * 64 + 32 * h + (lane >> 1)] = (unsigned char)(c | (oc << 4)); } } };
    ActS s0, s1, s2;
    L1(gw, s0); L1(gw + NGW, s1); L2(s0);
    auto trip = [&](int t) -> bool { const int ta = t + NGW, tb = ta + NGW, tc = tb + NGW, td = tc + NGW;
        L1(tb, s2); L2(s1); PROC(t, s0); if (ta >= M) return false;
        L1(tc, s0); L2(s2); PROC(ta, s1); if (tb >= M) return false;
        L1(td, s1); L2(s0); PROC(tb, s2); return true; };
    if (!trip(gw)) return;
    for (int t = gw + 3 * NGW; t < M; t += 3 * NGW) if (!trip(t)) break;
}
typedef int pv2i __attribute__((ext_vector_type(2)));
typedef int pv8i __attribute__((ext_vector_type(8)));
struct VsRows { v4u row[16]; };
#define VS_GAS __attribute__((address_space(1)))
template <class T> __device__ __forceinline__ VS_GAS T* vs_uni(T* p) {
    const unsigned long long v = (unsigned long long)p; const unsigned lo = (unsigned)__builtin_amdgcn_readfirstlane((int)(unsigned)v), hi = (unsigned)__builtin_amdgcn_readfirstlane((int)(unsigned)(v >> 32));
    return (VS_GAS T*)(((unsigned long long)hi << 32) | lo);
}
__device__ __forceinline__ void vs_ids(const unsigned short* IDS, size_t t, int r, int (&id)[16]) {
    const VS_GAS unsigned short* ip = vs_uni(IDS + t * HK) + 16 * r;
#pragma unroll
    for (int q = 0; q < 2; ++q) { const v4u v = *(const VS_GAS v4u*)(ip + 8 * q); id[8 * q] = v.x & 0xffffu; id[8 * q + 1] = v.x >> 16; id[8 * q + 2] = v.y & 0xffffu; id[8 * q + 3] = v.y >> 16; id[8 * q + 4] = v.z & 0xffffu; id[8 * q + 5] = v.z >> 16; id[8 * q + 6] = v.w & 0xffffu; id[8 * q + 7] = v.w >> 16; }
}
__device__ __forceinline__ void vs_gather(prsrc_t tab, const int (&id)[16], int sub, VsRows& R) {
#pragma unroll
    for (int n = 0; n < 16; ++n) R.row[n] = pbld16(tab, (unsigned)id[n] * 128u + 16u * sub);
}
struct VsSmall { v4u a; float xi[4]; float isc; };
__device__ __forceinline__ void vs_small(const unsigned char* W4, const float* WSC, const bf16raw* X1B, size_t t, int s, int lane, VsSmall& S) {
    const int j = lane & 15, kg = lane >> 4;
    S.a = *(const VS_GAS v4u*)(vs_uni(W4 + t * 256) + (j & 3) * 64 + 16 * kg);
    const VS_GAS bf16raw* xb = vs_uni(X1B + t * D + 256 * s);
    S.isc = *vs_uni(WSC + t);
#pragma unroll
    for (int G = 0; G < 4; ++G) S.xi[G] = __builtin_bit_cast(float, (unsigned)xb[64 * G + lane] << 16);
}
template <bool PF1, bool PF2, int MODE = 0>
__device__ __forceinline__ void vs_unit(float& keep, LAS unsigned char* wl, prsrc_t tab, const unsigned short* IDS, const unsigned char* W4, const float* WSC, const bf16raw* X1B, float* OUT, size_t t, size_t t1, size_t t2, int s, int lane, VsRows& cur, VsRows& nxt, int (&idg)[16], int (&idl)[16], VsSmall& sc, VsSmall& sn) {
    const int sub = lane & 7, r = lane >> 3, j = lane & 15, kg = lane >> 4;
    if (PF1) vs_small(W4, WSC, X1B, t1, s, lane, sn);
    if (PF2) vs_ids(IDS, t2, r, idl);
    asm volatile("" ::: "memory");
    if (PF1) {
#pragma unroll
        for (int k = 0; k < 16; ++k) asm volatile("" : "+v"(idg[k]));
        vs_gather(tab, idg, sub, nxt); }
    asm volatile("" ::: "memory");
#pragma unroll
    for (int n = 0; n < 16; ++n) { const int e = 16 * r + n; *(LAS v4u*)(wl + e * 128 + ((sub ^ ((e >> 1) & 7)) << 4)) = cur.row[n]; }
    asm volatile("" ::: "memory");
    const int row0 = 32 * kg + j, row1 = row0 + 16, f0 = (row0 >> 1) & 7, f1 = (row1 >> 1) & 7;
    const v4u a0 = sc.a;
    float o[4];
#pragma unroll
    for (int G = 0; G < 4; ++G) { f32x4 acc = (f32x4){0.f, 0.f, 0.f, 0.f};
#pragma unroll
        for (int q = 0; q < 4; ++q) { const int g = 4 * G + q, c = g >> 1, hf = 8 * (g & 1);
            const pv2i b0 = __builtin_amdgcn_ds_read_tr4_b64_v2i32((LAS pv2i*)(wl + row0 * 128 + ((c ^ f0) << 4) + hf));
            const pv2i b1 = __builtin_amdgcn_ds_read_tr4_b64_v2i32((LAS pv2i*)(wl + row1 * 128 + ((c ^ f1) << 4) + hf));
            const bool mine = (j >> 2) == q;
            const pv8i A = (pv8i){mine ? (int)a0.x : 0, mine ? (int)a0.y : 0, mine ? (int)a0.z : 0, mine ? (int)a0.w : 0, 0, 0, 0, 0};
            const pv8i B = (pv8i){b0.x, b0.y, b1.x, b1.y, 0, 0, 0, 0};
            acc = __builtin_amdgcn_mfma_scale_f32_16x16x128_f8f6f4(A, B, acc, 4, 4, 0, 0x7F7F7F7F, 0, 0x7F7F7F7F); }
        o[G] = ((acc[0] + acc[1] * 0.25f) + (acc[2] * (1.f / 16.f) + acc[3] * (1.f / 64.f))) * sc.isc; }
    asm volatile("" ::: "memory");
    VS_GAS float* ob = vs_uni(OUT + t * D + 256 * s);
#pragma unroll
    for (int G = 0; G < 4; ++G) { if (MODE == 0) ob[64 * G + lane] = sc.xi[G] + o[G]; else keep += sc.xi[G] + o[G]; }
}
__device__ __forceinline__ unsigned vs_ticket(unsigned* q, int lane) { unsigned t0 = 0; if (lane == 0) t0 = __hip_atomic_fetch_add(q, 16u, __ATOMIC_RELAXED, __HIP_MEMORY_SCOPE_AGENT); return t0; }
template <int MODE = 0>
__device__ __forceinline__ void p16_vsum(LAS unsigned char* lds, const unsigned char* V4S, const unsigned short* IDS, const unsigned char* W4, const float* WSC, const bf16raw* X1B, float* OUT, unsigned* Q, int xcc, int wave, int lane) {
    LAS unsigned char* wl = lds + wave * 16384; float keep = 0.f;
    const int sub = lane & 7, r = lane >> 3;
    for (int sidx = 0; sidx < 4; ++sidx) { const int s = (xcc + sidx) & 3; const prsrc_t tab = __builtin_amdgcn_make_buffer_rsrc((void*)(V4S + (size_t)s * SLICE_BYTES), (short)0, (int)SLICE_BYTES, 0x00020000);
        unsigned tkc = (unsigned)__builtin_amdgcn_readfirstlane((int)vs_ticket(Q + 64 * s, lane));
        if (tkc >= (unsigned)M) continue;
        VsRows ra, rb; int idA[16], idB[16]; VsSmall sa, sb;
        vs_ids(IDS, (size_t)tkc, r, idA); vs_gather(tab, idA, sub, ra); vs_ids(IDS, (size_t)tkc + 1, r, idB); vs_small(W4, WSC, X1B, (size_t)tkc, s, lane, sa);
        for (;;) {
            const unsigned tkn_raw = vs_ticket(Q + 64 * s, lane);
#pragma unroll
            for (int u = 0; u < 14; u += 2) { unsigned tu = tkc + u; asm volatile("" : "+s"(tu));
                vs_unit<true, true, MODE>(keep, wl, tab, IDS, W4, WSC, X1B, OUT, (size_t)tu, (size_t)tu + 1, (size_t)tu + 2, s, lane, ra, rb, idB, idA, sa, sb);
                vs_unit<true, true, MODE>(keep, wl, tab, IDS, W4, WSC, X1B, OUT, (size_t)tu + 1, (size_t)tu + 2, (size_t)tu + 3, s, lane, rb, ra, idA, idB, sb, sa); }
            const unsigned tkn = (unsigned)__builtin_amdgcn_readfirstlane((int)tkn_raw);
            if (tkn < (unsigned)M) { vs_unit<true, true, MODE>(keep, wl, tab, IDS, W4, WSC, X1B, OUT, (size_t)tkc + 14, (size_t)tkc + 15, (size_t)tkn, s, lane, ra, rb, idB, idA, sa, sb);
                                     vs_unit<true, true, MODE>(keep, wl, tab, IDS, W4, WSC, X1B, OUT, (size_t)tkc + 15, (size_t)tkn, (size_t)tkn + 1, s, lane, rb, ra, idA, idB, sb, sa); tkc = tkn; }
            else { vs_unit<true, false, MODE>(keep, wl, tab, IDS, W4, WSC, X1B, OUT, (size_t)tkc + 14, (size_t)tkc + 15, 0, s, lane, ra, rb, idB, idA, sa, sb);
                   vs_unit<false, false, MODE>(keep, wl, tab, IDS, W4, WSC, X1B, OUT, (size_t)tkc + 15, 0, 0, s, lane, rb, ra, idA, idB, sb, sa); break; }
        }
    }
    if (MODE != 0 && keep == 123.456f) OUT[lane] = keep;
}
template <class R, class LD, class PR>
__device__ __forceinline__ void rows_pipe3(int m0, int m1, int mstep, const LD& LOAD, const PR& PROC) {
    if (m0 >= m1) return;
    R r0, r1, r2; LOAD(m0, r0); LOAD(m0 + mstep < m1 ? m0 + mstep : m0, r1);
    auto trip = [&](int m) -> bool { const int ma = m + mstep, mb = ma + mstep, mc = mb + mstep, md = mc + mstep;
        LOAD(mb < m1 ? mb : m0, r2); PROC(m, r0); if (ma >= m1) return false;
        LOAD(mc < m1 ? mc : m0, r0); PROC(ma, r1); if (mb >= m1) return false;
        LOAD(md < m1 ? md : m0, r1); PROC(mb, r2); return true; };
    if (!trip(m0)) return;
    for (int m = m0 + 3 * mstep; m < m1; m += 3 * mstep) if (!trip(m)) break;
}
struct TabRow { f32x4 v[4]; };
__device__ __forceinline__ void quant_u_i4_sliced(const float* src, unsigned char* dst, float* su, int gw, int NGW, int lane) {
    const int c0 = 16 * lane;
    rows_pipe3<TabRow>(gw, NEXP, NGW, [&](int e, TabRow& r) {
#pragma unroll
        for (int q = 0; q < 4; ++q) r.v[q] = *(const f32x4*)(src + (size_t)e * D + c0 + 4 * q); },
      [&](int e, const TabRow& r) { float ss = 0.f;
#pragma unroll
        for (int q = 0; q < 4; ++q) ss += (r.v[q].x * r.v[q].x + r.v[q].y * r.v[q].y) + (r.v[q].z * r.v[q].z + r.v[q].w * r.v[q].w);
        ss = wave_sum_dpp(ss);
        const float sc = fmaxf(sqrtf(ss * (1.f / 1024.f)) * U4_STEP, 1e-30f), inv = 1.f / sc; if (lane == 0) su[e] = sc;
        unsigned o2[2];
#pragma unroll
        for (int h = 0; h < 2; ++h) { unsigned w = 0u;
#pragma unroll
            for (int q = 0; q < 2; ++q)
#pragma unroll
                for (int z = 0; z < 4; ++z) { const int qi = (int)fminf(fmaxf(__builtin_rintf(r.v[2 * h + q][z] * inv), -7.f), 7.f); w |= (unsigned)(qi & 15) << (16 * q + 4 * z); }
            o2[h] = w; }
        *(unsigned long long*)(dst + (size_t)(c0 >> 8) * SLICE_BYTES + (size_t)e * 128 + ((c0 & 255) >> 1)) = (unsigned long long)o2[0] | ((unsigned long long)o2[1] << 32); });
}
__device__ __forceinline__ void cvt_fp4_sliced(const float* src, unsigned char* dst, float* SV, int gw, int NGW, int m_) {
    rows_pipe3<TabRow>(gw, NEXP, NGW, [&](int e, TabRow& r) {
#pragma unroll
        for (int q = 0; q < 4; ++q) r.v[q] = *(const f32x4*)(src + (size_t)e * D + 16 * m_ + 4 * q); },
      [&](int e, const TabRow& r) { float mx = 0.f;
#pragma unroll
        for (int q = 0; q < 4; ++q) mx = fmaxf(fmaxf(mx, fmaxf(fabsf(r.v[q].x), fabsf(r.v[q].y))), fmaxf(fabsf(r.v[q].z), fabsf(r.v[q].w)));
        mx = wave_max_dpp(mx);
        const float sc = fmaxf(mx, 1e-30f) * (1.f / 6.f), inv = 1.f / sc; if (m_ == 0) SV[e] = sc;
        unsigned w0 = 0u, w1 = 0u;
#pragma unroll
        for (int q = 0; q < 2; ++q)
#pragma unroll
            for (int z = 0; z < 4; ++z) { w0 |= e2m1_code(r.v[q][z] * inv) << (16 * q + 4 * z); w1 |= e2m1_code(r.v[2 + q][z] * inv) << (16 * q + 4 * z); }
        *(unsigned long long*)(dst + (size_t)(m_ >> 4) * SLICE_BYTES + (size_t)e * 128 + 8 * (m_ & 15)) = (unsigned long long)w0 | ((unsigned long long)w1 << 32); });
}
__device__ __forceinline__ void transpose_item(const float* W, int ldw, int col0, int K, bf16raw* WT, int row_off, LAS float* scr, int kb, int nb, int lane) {
    const int k0 = 64 * kb, n0 = 32 * nb;
    { float v_[32];
#pragma unroll
      for (int i = 0; i < 32; ++i) v_[i] = W[(size_t)(k0 + 2 * i + (lane >> 5)) * ldw + col0 + n0 + (lane & 31)];
      __builtin_amdgcn_sched_barrier(0);
#pragma unroll
      for (int i = 0; i < 32; ++i) scr[(2 * i + (lane >> 5)) * 33 + (lane & 31)] = v_[i]; }
    asm volatile("s_waitcnt lgkmcnt(0)" ::: "memory");
    const int c = lane & 7;
#pragma unroll
    for (int j = 0; j < 4; ++j) { const int n = (lane >> 3) + 8 * j; const LAS float* s = scr + (8 * c) * 33 + n;
        v4u o; o.x = pk2(s[0 * 33], s[1 * 33]); o.y = pk2(s[2 * 33], s[3 * 33]); o.z = pk2(s[4 * 33], s[5 * 33]); o.w = pk2(s[6 * 33], s[7 * 33]);
        *(v4u*)(WT + (size_t)(row_off + n0 + n) * K + k0 + 8 * c) = o; }
    asm volatile("s_waitcnt lgkmcnt(0)" ::: "memory");
}
__device__ __forceinline__ unsigned pk4_fp8(float a, float b, float c, float d) { int w = 0; w = __builtin_amdgcn_cvt_pk_fp8_f32(fminf(fmaxf(a, -448.f), 448.f), fminf(fmaxf(b, -448.f), 448.f), w, false);
    w = __builtin_amdgcn_cvt_pk_fp8_f32(fminf(fmaxf(c, -448.f), 448.f), fminf(fmaxf(d, -448.f), 448.f), w, true); return (unsigned)w; }
__device__ __forceinline__ void transpose_item_fp8(const float* W, int ldw, int col0, int K, unsigned char* WT, int row_off, LAS float* scr, int kb, int nb, int lane, float scale) {
    const int k0 = 64 * kb, n0 = 32 * nb;
    { float v_[32];
#pragma unroll
      for (int i = 0; i < 32; ++i) v_[i] = W[(size_t)(k0 + 2 * i + (lane >> 5)) * ldw + col0 + n0 + (lane & 31)];
      __builtin_amdgcn_sched_barrier(0);
#pragma unroll
      for (int i = 0; i < 32; ++i) scr[(2 * i + (lane >> 5)) * 33 + (lane & 31)] = v_[i]; }
    asm volatile("s_waitcnt lgkmcnt(0)" ::: "memory");
    const int c = lane & 7;
#pragma unroll
    for (int j = 0; j < 4; ++j) { const int n = (lane >> 3) + 8 * j; const LAS float* s = scr + (8 * c) * 33 + n;
        v2u o; o.x = pk4_fp8(s[0 * 33] * scale, s[1 * 33] * scale, s[2 * 33] * scale, s[3 * 33] * scale); o.y = pk4_fp8(s[4 * 33] * scale, s[5 * 33] * scale, s[6 * 33] * scale, s[7 * 33] * scale);
        *(v2u*)(WT + (size_t)(row_off + n0 + n) * K + k0 + 8 * c) = o; }
    asm volatile("s_waitcnt lgkmcnt(0)" ::: "memory");
}
__device__ __forceinline__ int win_src_col(int g);
__device__ __forceinline__ int gate_src_col(int n);
__device__ __forceinline__ void colmax_item(const float* W, int ldw, int col0, unsigned* cmax, int row_off, int nb, int kq, int lane) {
    const int n0 = 32 * nb; float mx = 0.f;
    const float* wp = W + (size_t)(128 * kq + (lane >> 5)) * ldw + col0 + n0 + (lane & 31);
#pragma unroll 1
    for (int i0 = 0; i0 < 64; i0 += 16) { float v[16];
#pragma unroll
        for (int i = 0; i < 16; ++i) v[i] = wp[(size_t)(2 * (i0 + i)) * ldw];
        __builtin_amdgcn_sched_barrier(0);
#pragma unroll
        for (int i = 0; i < 16; ++i) mx = fmaxf(mx, fabsf(v[i])); }
    mx = fmaxf(mx, __shfl_xor(mx, 32));
    if (lane < 32) atomicMax(cmax + row_off + n0 + lane, __builtin_bit_cast(unsigned, mx));
}
__device__ __forceinline__ void quant_item_i8(const float* W, int ldw, int col0, signed char* WT, const unsigned* cmax, float* sw, int row_off, LAS float* scr, int kb, int nb, int lane) {
    const int k0 = 64 * kb, n0 = 32 * nb;
    const float sc = fmaxf(__builtin_bit_cast(float, cmax[row_off + n0 + (lane & 31)]), 1e-30f) * (1.f / 127.f), inv = 1.f / sc;
    if (kb == 0 && lane < 32) sw[row_off + n0 + lane] = sc;
    { float v_[32];
#pragma unroll
      for (int i = 0; i < 32; ++i) v_[i] = W[(size_t)(k0 + 2 * i + (lane >> 5)) * ldw + col0 + n0 + (lane & 31)];
      __builtin_amdgcn_sched_barrier(0);
#pragma unroll
      for (int i = 0; i < 32; ++i) scr[(2 * i + (lane >> 5)) * 33 + (lane & 31)] = v_[i] * inv; }
    asm volatile("s_waitcnt lgkmcnt(0)" ::: "memory");
    const int c = lane & 7;
#pragma unroll
    for (int j = 0; j < 4; ++j) { const int n = (lane >> 3) + 8 * j; const LAS float* s = scr + (8 * c) * 33 + n; int q[8];
#pragma unroll
        for (int e2 = 0; e2 < 8; ++e2) q[e2] = (int)__builtin_rintf(s[e2 * 33]);
        v2u o; o.x = (unsigned)(q[0] & 255) | ((unsigned)(q[1] & 255) << 8) | ((unsigned)(q[2] & 255) << 16) | ((unsigned)(q[3] & 255) << 24);
        o.y = (unsigned)(q[4] & 255) | ((unsigned)(q[5] & 255) << 8) | ((unsigned)(q[6] & 255) << 16) | ((unsigned)(q[7] & 255) << 24);
        *(v2u*)(WT + (size_t)(row_off + n0 + n) * 1024 + k0 + 8 * c) = o; }
    asm volatile("s_waitcnt lgkmcnt(0)" ::: "memory");
}
__device__ __forceinline__ void p0b_quant_w(LAS unsigned char* lds, const float* w_in, const float* wpq, const float* wm, signed char* WT, float* sw, const unsigned* cmax, int gw, int NGW, int wave, int lane) {
    LAS float* scr = (LAS float*)(lds + wave * 16384);
    for (int it = gw; it < 9 * 512 + 1024 + 512; it += NGW) {
        if (it < 9 * 512) { const int g = it / 512, q = it % 512; quant_item_i8(w_in, DIN, win_src_col(g), WT, cmax, sw, 1024 * g, scr, q / 32, q % 32, lane); }
        else if (it < 9 * 512 + 1024) { const int q = it - 9 * 512; quant_item_i8(wpq, 2048, 0, WT, cmax, sw, 9216, scr, q / 64, q % 64, lane); }
        else { const int q = it - 9 * 512 - 1024; quant_item_i8(wm, 1024, 0, WT, cmax, sw, 11264, scr, q / 32, q % 32, lane); } }
    for (int i = gw * 64 + lane; i < 256 * 1024; i += NGW * 64) { const int n = i >> 10, k = i & 1023; signed char qv = 0;
        if (n < 16) { const float sc = fmaxf(__builtin_bit_cast(float, cmax[12288 + n]), 1e-30f) * (1.f / 127.f); qv = (signed char)(int)__builtin_rintf(w_in[(size_t)k * DIN + gate_src_col(n)] / sc); if (k == 0) sw[12288 + n] = sc; }
        WT[(size_t)(12288 + n) * 1024 + k] = qv; }
}
__device__ __forceinline__ void cvt_bf16_stream(const float* src, bf16raw* dst, size_t n, size_t gtid, size_t gthreads) {
    for (size_t i = gtid * 8; i < n; i += gthreads * 8) { const f32x4 a = *(const f32x4*)(src + i), b = *(const f32x4*)(src + i + 4);
        v4u o; o.x = pk2(a.x, a.y); o.y = pk2(a.z, a.w); o.z = pk2(b.x, b.y); o.w = pk2(b.z, b.w); *(v4u*)(dst + i) = o; }
}
constexpr float H8_SCALE = 16.f, W8_SCALE = 256.f;
__device__ __forceinline__ void rms_row_load(const float* xrow, int lane, f32x4 (&v)[4]) {
    const f32x4* xr = (const f32x4*)xrow + lane;
#pragma unroll
    for (int j = 0; j < 4; ++j) v[j] = xr[64 * j];
}
__device__ __forceinline__ void rms_row_load_b16(const bf16raw* xrow, int lane, f32x4 (&v)[4]) {
#pragma unroll
    for (int j = 0; j < 4; ++j) { const v2u w = *(const v2u*)(xrow + 256 * j + 4 * lane); v[j] = (f32x4){bflo(w.x), bfhi(w.x), bflo(w.y), bfhi(w.y)}; }
}
__device__ __forceinline__ void rms_gain_load(const float* gain, int lane, f32x4 (&gr)[4]) {
#pragma unroll
    for (int j = 0; j < 4; ++j) gr[j] = ((const f32x4*)gain + lane)[64 * j];
}
__device__ __forceinline__ void rms_row_to_bf16(const f32x4 (&v)[4], const f32x4 (&gr)[4], bf16raw* orow, int lane, unsigned char* o8row = nullptr, float* shrow = nullptr, unsigned char* xhrow = nullptr, unsigned char* xlrow = nullptr) {
    float s = 0.f;
#pragma unroll
    for (int j = 0; j < 4; ++j) { const f32x4 q = v[j] * v[j]; s += (q.x + q.y) + (q.z + q.w); }
    const float rstd = __builtin_amdgcn_rsqf(wave_sum_dpp(s) * (1.f / 1024.f) + EPS);
    unsigned long long* o8 = (unsigned long long*)orow + lane;
    f32x4 hh[4]; float mx = 0.f;
#pragma unroll
    for (int j = 0; j < 4; ++j) { const f32x4 g = gr[j]; hh[j] = v[j] * g;
        if (orow) o8[64 * j] = (unsigned long long)pk2(hh[j].x * rstd, hh[j].y * rstd) | ((unsigned long long)pk2(hh[j].z * rstd, hh[j].w * rstd) << 32);
        mx = fmaxf(fmaxf(mx, fmaxf(fabsf(hh[j].x), fabsf(hh[j].y))), fmaxf(fabsf(hh[j].z), fabsf(hh[j].w))); }
    if (o8row) {
        mx = wave_max_dpp(mx);
        const float sc = fmaxf(mx, 1e-30f) * (1.f / 127.f), inv = __builtin_amdgcn_rcpf(sc);
        if (lane == 0) *shrow = sc * rstd;
#pragma unroll
        for (int j = 0; j < 4; ++j) ((unsigned*)o8row)[64 * j + lane] = q8x4_pack(hh[j].x, hh[j].y, hh[j].z, hh[j].w, inv);
        if (xhrow) { const float inv7 = inv * (63.f / 127.f);
#pragma unroll
            for (int j = 0; j < 4; ++j) { const unsigned p7 = q8x4_pack(hh[j].x, hh[j].y, hh[j].z, hh[j].w, inv7);
                ((unsigned short*)xhrow)[64 * j + lane] = (unsigned short)nib4((p7 >> 3) & 0x0F0F0F0Fu);
                ((unsigned short*)xlrow)[64 * j + lane] = (unsigned short)nib4(p7 & 0x07070707u); } } }
}
struct RowF32 { f32x4 v[4]; };
struct RowB16 { v2u w[4]; };
__device__ __forceinline__ void rms_rows_phase(const float* X, const float* gain, bf16raw* O, int m0, int m1, int mstep, int lane, unsigned char* O8 = nullptr, float* SH = nullptr, unsigned char* XH = nullptr, unsigned char* XL = nullptr) {
    f32x4 gr[4]; rms_gain_load(gain, lane, gr);
    rows_pipe3<RowF32>(m0, m1, mstep, [&](int m, RowF32& r) { rms_row_load(X + (size_t)m * D, lane, r.v); },
        [&](int m, const RowF32& r) { rms_row_to_bf16(r.v, gr, O ? O + (size_t)m * D : nullptr, lane, O8 ? O8 + (size_t)m * D : nullptr, SH ? SH + m : nullptr, XH ? XH + (size_t)m * 512 : nullptr, XL ? XL + (size_t)m * 512 : nullptr); });
}
__device__ __forceinline__ void rms_row_load_raw16(const bf16raw* xrow, int lane, v2u (&w)[4]) {
#pragma unroll
    for (int j = 0; j < 4; ++j) w[j] = *(const v2u*)(xrow + 256 * j + 4 * lane);
}
__device__ __forceinline__ void rms_rows_phase_b16(const bf16raw* X, const float* gain, int m0, int m1, int mstep, int lane, unsigned char* O8, float* SH, unsigned char* XH = nullptr, unsigned char* XL = nullptr) {
    f32x4 gr[4]; rms_gain_load(gain, lane, gr);
    rows_pipe3<RowB16>(m0, m1, mstep, [&](int m, RowB16& r) { rms_row_load_raw16(X + (size_t)m * D, lane, r.w); },
        [&](int m, const RowB16& r) { f32x4 v[4];
#pragma unroll
            for (int j = 0; j < 4; ++j) v[j] = (f32x4){bflo(r.w[j].x), bfhi(r.w[j].x), bflo(r.w[j].y), bfhi(r.w[j].y)};
            rms_row_to_bf16(v, gr, nullptr, lane, O8 + (size_t)m * D, SH + m, XH ? XH + (size_t)m * 512 : nullptr, XL ? XL + (size_t)m * 512 : nullptr); });
}
__device__ __forceinline__ int win_src_col(int g) { return g == 0 ? 0 : g == 1 ? 1024 : g == 2 ? 2048 : g == 3 ? 4104 : g == 4 ? 5128 : g == 5 ? 6152 : g == 6 ? 3072 : g == 7 ? 7184 : 8208; }
__device__ __forceinline__ int gate_src_col(int n) { return n < 8 ? 4096 + n : 7176 + (n - 8); }
struct P0Args { const float *x, *n1g, *w_in, *b_in, *wm, *wf, *wo, *wpq, *sk, *ut, *vt; bf16raw *WinT, *WgT, *WmT, *WfT, *WoT, *WpqT, *SKB, *UB, *VB, *H; float *biasP, *biasG; unsigned char* H8; bf16raw* WinTb; float* SH; unsigned* CMAX; };
__device__ __forceinline__ void p0_prologue(LAS unsigned char* lds, const P0Args& a, int vcu, int G, int wave, int lane, int tid) {
    LAS float* scr = (LAS float*)(lds + wave * 16384);
    const int gw = vcu * NWAVES + wave, NGW = G * NWAVES;
    constexpr int NI_G = 16 * 32;
    constexpr int NITEMS = 9 * NI_G + 3 * NI_G + 2 * NI_G;
    for (int it = gw; it < NITEMS; it += NGW) {
        int r = it;
        if (r < 9 * NI_G) { if (r < 288 * 8) { const int g = r / 256, nb = (r % 256) / 8, kq = r % 8; colmax_item(a.w_in, DIN, win_src_col(g), a.CMAX, 1024 * g, nb, kq, lane); }
            else if (r < 288 * 8 + 64 * 8) { const int q = r - 288 * 8; colmax_item(a.wpq, 2048, 0, a.CMAX, 9216, q / 8, q % 8, lane); }
            else if (r < 288 * 8 + 64 * 8 + 32 * 8) { const int q = r - 288 * 8 - 64 * 8; colmax_item(a.wm, 1024, 0, a.CMAX, 11264, q / 8, q % 8, lane); }
            else if (r == 288 * 8 + 64 * 8 + 32 * 8) { float mx = 0.f; const int col = gate_src_col(lane & 15);
                for (int k = (lane >> 4) * 256; k < (lane >> 4) * 256 + 256; ++k) mx = fmaxf(mx, fabsf(a.w_in[(size_t)k * DIN + col]));
                mx = fmaxf(mx, __shfl_xor(mx, 16)); mx = fmaxf(mx, __shfl_xor(mx, 32)); if (lane < 16) atomicMax(a.CMAX + 12288 + lane, __builtin_bit_cast(unsigned, mx)); }
            continue; } r -= 9 * NI_G;
        if (r < NI_G) { continue; } r -= NI_G;
        if (r < NI_G) { transpose_item(a.wf, D, 0, D, a.WfT, 0, scr, r / 32, r % 32, lane); continue; } r -= NI_G;
        if (r < NI_G) { transpose_item(a.wo, D, 0, D, a.WoT, 0, scr, r / 32, r % 32, lane); continue; } r -= NI_G;
        (void)0;
    }
    const size_t gtid = (size_t)vcu * NTHR + tid, gthreads = (size_t)G * NTHR;
    for (size_t i = gtid; i < 9216; i += gthreads) a.biasP[i] = a.b_in[win_src_col((int)(i >> 10)) + (int)(i & 1023)];
    for (size_t i = gtid; i < 16; i += gthreads) a.biasG[i] = a.b_in[gate_src_col((int)i)];
    cvt_bf16_stream(a.sk, a.SKB, (size_t)PH * 2 * 128 * 128, gtid, gthreads);
    quant_u_i4_sliced(a.ut, (unsigned char*)a.UB, (float*)((unsigned char*)a.UB + 16 * MiB), gw, NGW, lane);
    cvt_fp4_sliced(a.vt, (unsigned char*)a.VB, (float*)((unsigned char*)a.VB + 16 * MiB), gw, NGW, lane);
    rms_rows_phase(a.x, a.n1g, nullptr, gw, M, NGW, lane, a.H8, a.SH);
}

__device__ __forceinline__ float wave_incl_sum(float v, int lane) {
#pragma unroll
    for (int o = 1; o < 64; o <<= 1) { const float t = __shfl_up(v, o); if (lane >= o) v += t; }
    return v;
}
__device__ __forceinline__ float wave_incl_max(float v, int lane) {
#pragma unroll
    for (int o = 1; o < 64; o <<= 1) { const float t = __shfl_up(v, o); if (lane >= o) v = fmaxf(v, t); }
    return v;
}
struct ScanArgs { const float* Z16; float *CS, *ROWF, *COLF, *WINT, *EDEN, *WSW, *DECAY; };
__device__ __forceinline__ void p_scans(const ScanArgs& a, int gwave, int lane) {
    if (gwave < BATCH * MH) {
        const int bh = gwave, b = bh >> 2, hm = bh & 3; float m_prev = -1e30f;
        const float* zp = a.Z16 + ((size_t)b * T + lane) * 16; float ipn[4], fpn[4];
#pragma unroll
        for (int u = 0; u < 4; ++u) { ipn[u] = zp[(size_t)(64 * u) * 16 + hm]; fpn[u] = zp[(size_t)(64 * u) * 16 + 4 + hm]; }
        for (int c0 = 0; c0 < NCH; c0 += 4) {
            float ipc[4], fpc[4];
#pragma unroll
            for (int u = 0; u < 4; ++u) { ipc[u] = ipn[u]; fpc[u] = fpn[u]; }
            if (c0 + 4 < NCH) {
#pragma unroll
                for (int u = 0; u < 4; ++u) { ipn[u] = zp[(size_t)(64 * (c0 + 4 + u)) * 16 + hm]; fpn[u] = zp[(size_t)(64 * (c0 + 4 + u)) * 16 + 4 + hm]; } }
#pragma unroll
            for (int u = 0; u < 4; ++u) { const int c = c0 + u; const size_t gi = (size_t)bh * T + 64 * c + lane;
                const float ip = ipc[u], fp = fpc[u];
                const float bt = wave_incl_sum(logsigf_(fp), lane), g = __shfl(bt, 63);
                const float at = ip - bt, pm = wave_incl_max(at, lane), amax = __shfl(pm, 63);
                const float mt = fmaxf(bt + pm, bt + m_prev), m_new = fmaxf(g + m_prev, g + amax);
                a.ROWF[gi] = bt - mt; a.COLF[gi] = at; a.WINT[gi] = __expf(bt - mt + m_prev); a.EDEN[gi] = __expf(-mt); a.WSW[gi] = __expf(at + g - m_new);
                if (lane == 0) a.DECAY[bh * NCH + c] = __expf(g + m_prev - m_new);
                m_prev = m_new; }
        }
    } else if (gwave < BATCH * MH + BATCH * FH) {
        const int bh = gwave - BATCH * MH, b = bh >> 3, hf = bh & 7; float carry = 0.f;
        const float* zp = a.Z16 + ((size_t)b * T + lane) * 16 + 8 + hf; float fn[4];
#pragma unroll
        for (int u = 0; u < 4; ++u) fn[u] = zp[(size_t)(64 * u) * 16];
        for (int c0 = 0; c0 < NCH; c0 += 4) {
            float fc[4];
#pragma unroll
            for (int u = 0; u < 4; ++u) fc[u] = fn[u];
            if (c0 + 4 < NCH) {
#pragma unroll
                for (int u = 0; u < 4; ++u) fn[u] = zp[(size_t)(64 * (c0 + 4 + u)) * 16]; }
#pragma unroll
            for (int u = 0; u < 4; ++u) { const int c = c0 + u;
                const float s = wave_incl_sum(logsigf_(fc[u]), lane) + carry;
                a.CS[(size_t)bh * T + 64 * c + lane] = -s * 11.313708498984761f;
                carry = __shfl(s, 63); }
        }
    }
}

__device__ __forceinline__ void qknorm_vals(const v4u a, const v4u b, bf16raw* row, const f32x4 (&g)[4], int lane, float (&v)[16]) {
    v4u* p = (v4u*)(row + 16 * lane);
    const unsigned w[8] = {a.x, a.y, a.z, a.w, b.x, b.y, b.z, b.w};
    float s = 0.f;
#pragma unroll
    for (int i = 0; i < 8; ++i) { v[2 * i] = bflo(w[i]); v[2 * i + 1] = bfhi(w[i]); s += v[2 * i] * v[2 * i] + v[2 * i + 1] * v[2 * i + 1]; }
    s = row8_sum(s);
    const float rstd = __builtin_amdgcn_rsqf(s * (1.f / 128.f) + EPS);
    unsigned o[8];
#pragma unroll
    for (int i = 0; i < 4; ++i) { const f32x4 gg = g[i]; o[2 * i] = pk2(v[4 * i] * rstd * gg.x, v[4 * i + 1] * rstd * gg.y); o[2 * i + 1] = pk2(v[4 * i + 2] * rstd * gg.z, v[4 * i + 3] * rstd * gg.w); }
#pragma unroll
    for (int i = 0; i < 8; ++i) { v[2 * i] = bflo(o[i]); v[2 * i + 1] = bfhi(o[i]); }
    p[0] = (v4u){o[0], o[1], o[2], o[3]}; p[1] = (v4u){o[4], o[5], o[6], o[7]};
}
struct QkRow { v4u qa, qb, ka, kb; };
__device__ __forceinline__ void qk_load(const bf16raw* FQ, const bf16raw* FK, int m, int lane, QkRow& r) {
    const v4u* pq = (const v4u*)(FQ + (size_t)m * D + 16 * lane); const v4u* pk = (const v4u*)(FK + (size_t)m * D + 16 * lane); r.qa = pq[0]; r.qb = pq[1]; r.ka = pk[0]; r.kb = pk[1];
}
template <bool TO_LDS = false>
__device__ __forceinline__ void p2b_qknorm(bf16raw* FQ, bf16raw* FK, const float* qg, const float* kg, float* DQK, int gw, int NGW, int lane, int m_end = M, LAS float* dq = nullptr, int row0 = 0) {
    f32x4 gq[4], gk[4];
#pragma unroll
    for (int i = 0; i < 4; ++i) { gq[i] = ((const f32x4*)(qg + 16 * (lane & 7)))[i]; gk[i] = ((const f32x4*)(kg + 16 * (lane & 7)))[i]; }
    rows_pipe3<QkRow>(gw, m_end, NGW, [&](int m, QkRow& r) { qk_load(FQ, FK, m, lane, r); },
        [&](int m, const QkRow& c0) { float vq[16], vk[16];
            qknorm_vals(c0.qa, c0.qb, FQ + (size_t)m * D, gq, lane, vq); qknorm_vals(c0.ka, c0.kb, FK + (size_t)m * D, gk, lane, vk);
            float d = 0.f;
#pragma unroll
            for (int i = 0; i < 16; ++i) d += vq[i] * vk[i];
            d = row8_sum(d);
            if ((lane & 7) == 0) { if (TO_LDS) dq[(m - row0) * 8 + (lane >> 3)] = d; else DQK[(size_t)m * 8 + (lane >> 3)] = d; } });
}

struct HmRow { v4u a, b, ma; };
__device__ __forceinline__ void p4_hmnorm(const bf16raw* HR, const signed char* MO, const float* gain, signed char* HM8, float* SHM, int m0, int m1, int mstep, int lane) {
    f32x4 g[4];
#pragma unroll
    for (int i = 0; i < 4; ++i) g[i] = ((const f32x4*)(gain + 16 * lane))[i];
    rows_pipe3<HmRow>(m0, m1, mstep, [&](int m, HmRow& r) { const v4u* p = (const v4u*)(HR + (size_t)m * D + 16 * lane); r.a = p[0]; r.b = p[1]; r.ma = *(const v4u*)(MO + (size_t)m * D + 16 * lane); },
        [&](int m, const HmRow& r) {
        const unsigned w[8] = {r.a.x, r.a.y, r.a.z, r.a.w, r.b.x, r.b.y, r.b.z, r.b.w}, mw[4] = {r.ma.x, r.ma.y, r.ma.z, r.ma.w};
        f32x2 vv[8]; float s = 0.f;
#pragma unroll
        for (int i = 0; i < 8; ++i) { vv[i] = (f32x2){bflo(w[i]), bfhi(w[i])}; const f32x2 q = vv[i] * vv[i]; s += q.x + q.y; }
        s = row16_sum(s);
        const float rstd = __builtin_amdgcn_rsqf(s * (1.f / 256.f) + EPS);
        float mx = 0.f;
#pragma unroll
        for (int i = 0; i < 4; ++i) { const f32x4 gg = g[i];
            const f32x2 gb0 = (f32x2){(float)(int)(signed char)(mw[i]), (float)(int)(signed char)(mw[i] >> 8)} * -0.09016844005556021f, gb1 = (f32x2){(float)(int)(signed char)(mw[i] >> 16), (float)(int)(signed char)(mw[i] >> 24)} * -0.09016844005556021f;
            const f32x2 d0 = (f32x2){__builtin_amdgcn_exp2f(gb0.x), __builtin_amdgcn_exp2f(gb0.y)} + 1.0f, d1 = (f32x2){__builtin_amdgcn_exp2f(gb1.x), __builtin_amdgcn_exp2f(gb1.y)} + 1.0f;
            const f32x2 s0 = (f32x2){__builtin_amdgcn_rcpf(d0.x), __builtin_amdgcn_rcpf(d0.y)}, s1 = (f32x2){__builtin_amdgcn_rcpf(d1.x), __builtin_amdgcn_rcpf(d1.y)};
            vv[2 * i] = vv[2 * i] * ((f32x2){gg.x, gg.y} * rstd) * s0; vv[2 * i + 1] = vv[2 * i + 1] * ((f32x2){gg.z, gg.w} * rstd) * s1;
            mx = fmaxf(fmaxf(mx, fmaxf(fabsf(vv[2 * i].x), fabsf(vv[2 * i].y))), fmaxf(fabsf(vv[2 * i + 1].x), fabsf(vv[2 * i + 1].y))); }
        mx = wave_max_dpp(mx);
        const float sc = fmaxf(mx, 1e-30f) * (1.f / 127.f), inv = __builtin_amdgcn_rcpf(sc); if (lane == 0) SHM[m] = sc;
        unsigned o4[4];
#pragma unroll
        for (int i = 0; i < 4; ++i) o4[i] = q8x4_pack(vv[2 * i].x, vv[2 * i].y, vv[2 * i + 1].x, vv[2 * i + 1].y, inv);
        *(v4u*)(HM8 + (size_t)m * D + 16 * lane) = (v4u){o4[0], o4[1], o4[2], o4[3]}; });
}
constexpr int P2_RP = 264;
constexpr int P2_QS = 0, P2_KS = 33792, P2_VS = 67584, P2_DSL = 101376, P2_KB = P2_DSL + 256;
struct P2Args { const bf16raw *MQ, *MK, *MV; const float* conv_w; bf16raw *QC, *KWT, *VT, *SP; float *KBAR, *DSUM; const float *ROWF, *COLF, *WSW; };
struct P2Raw { v4u q[7], k[7], v[4]; };
__device__ __forceinline__ void p2_load(const P2Args& a, P2Raw& r, int unit, int rg, int cc) {
    const int bh = unit / NCH, c = unit % NCH, b = bh >> 2, hm = bh & 3; const size_t col = (size_t)256 * hm + 8 * cc;
#pragma unroll
    for (int i = 0; i < 7; ++i) { const int tm = 64 * c + 4 * rg - 3 + i; const size_t o = ((size_t)b * T + (tm < 0 ? 0 : tm)) * D + col;
        const v4u z = (v4u){0u, 0u, 0u, 0u}; const v4u qv = *(const v4u*)(a.MQ + o), kv = *(const v4u*)(a.MK + o); r.q[i] = tm < 0 ? z : qv; r.k[i] = tm < 0 ? z : kv; }
#pragma unroll
    for (int i = 0; i < 4; ++i) r.v[i] = *(const v4u*)(a.MV + ((size_t)b * T + 64 * c + 4 * rg + i) * D + col);
}
__device__ __forceinline__ void p2_conv_row(const v4u (&x)[7], int i, const float (&w)[4][8], float (&o)[8]) {
#pragma unroll
    for (int e = 0; e < 8; ++e) o[e] = 0.f;
#pragma unroll
    for (int j = 0; j < 4; ++j) { const v4u xv = x[i + j];
        o[0] += w[j][0] * bflo(xv.x); o[1] += w[j][1] * bfhi(xv.x); o[2] += w[j][2] * bflo(xv.y); o[3] += w[j][3] * bfhi(xv.y);
        o[4] += w[j][4] * bflo(xv.z); o[5] += w[j][5] * bfhi(xv.z); o[6] += w[j][6] * bflo(xv.w); o[7] += w[j][7] * bfhi(xv.w); }
#pragma unroll
    for (int e = 0; e < 8; ++e) o[e] = o[e] * sigmoidf_(o[e]);
}
__device__ __forceinline__ void p2_prep(LAS unsigned char* lds, const P2Args& a, int vcu, int G, int wave, int lane, int tid) {
    LAS bf16raw* qs = (LAS bf16raw*)(lds + P2_QS); LAS bf16raw* ks = (LAS bf16raw*)(lds + P2_KS); LAS bf16raw* vs = (LAS bf16raw*)(lds + P2_VS);
    LAS float* dsl = (LAS float*)(lds + P2_DSL); LAS float* kbp = (LAS float*)(lds + P2_KB);
    const int rg = tid >> 5, cc = tid & 31;
    int unit = vcu; if (unit >= BATCH * MH * NCH) return;
    P2Raw raw; p2_load(a, raw, unit, rg, cc);
    for (; unit < BATCH * MH * NCH; unit += G) {
        const int bh = unit / NCH, c = unit % NCH, b = bh >> 2, hm = bh & 3, ch0 = 256 * hm; const size_t tok0 = (size_t)b * T + 64 * c, gi0 = (size_t)bh * T + 64 * c;
        float wq[4][8], wk[4][8];
#pragma unroll
        for (int j = 0; j < 4; ++j) { const f32x4 a0 = *(const f32x4*)(a.conv_w + j * 2048 + ch0 + 8 * cc), a1 = *(const f32x4*)(a.conv_w + j * 2048 + ch0 + 8 * cc + 4), b0 = *(const f32x4*)(a.conv_w + j * 2048 + 1024 + ch0 + 8 * cc), b1 = *(const f32x4*)(a.conv_w + j * 2048 + 1024 + ch0 + 8 * cc + 4);
            wq[j][0] = a0.x; wq[j][1] = a0.y; wq[j][2] = a0.z; wq[j][3] = a0.w; wq[j][4] = a1.x; wq[j][5] = a1.y; wq[j][6] = a1.z; wq[j][7] = a1.w;
            wk[j][0] = b0.x; wk[j][1] = b0.y; wk[j][2] = b0.z; wk[j][3] = b0.w; wk[j][4] = b1.x; wk[j][5] = b1.y; wk[j][6] = b1.z; wk[j][7] = b1.w; }
        if (tid < 64) dsl[tid] = 0.f;
        const int sch = tid & 7; const f32x4 w0 = *(const f32x4*)(a.WSW + gi0 + 8 * sch), w1 = *(const f32x4*)(a.WSW + gi0 + 8 * sch + 4);
        const int rb = wave >> 1, m = lane & 15, kg = lane >> 4;
        const float rf = a.ROWF[gi0 + 16 * rb + m]; const f32x4 cf0 = *(const f32x4*)(a.COLF + gi0 + 16 * (2 * (wave & 1)) + 4 * kg), cf1 = *(const f32x4*)(a.COLF + gi0 + 16 * (2 * (wave & 1) + 1) + 4 * kg);
#pragma unroll
        for (int i = 0; i < 4; ++i) { const int r = 4 * rg + i; float o[8];
            p2_conv_row(raw.q, i, wq, o);
            const v4u pq = (v4u){pk2(o[0] * 0.0625f, o[1] * 0.0625f), pk2(o[2] * 0.0625f, o[3] * 0.0625f), pk2(o[4] * 0.0625f, o[5] * 0.0625f), pk2(o[6] * 0.0625f, o[7] * 0.0625f)};
            *(LAS v4u*)(qs + r * P2_RP + 8 * cc) = pq; *(v4u*)(a.QC + (tok0 + r) * D + ch0 + 8 * cc) = pq;
            p2_conv_row(raw.k, i, wk, o);
            *(LAS v4u*)(ks + r * P2_RP + 8 * cc) = (v4u){pk2(o[0], o[1]), pk2(o[2], o[3]), pk2(o[4], o[5]), pk2(o[6], o[7])};
            *(LAS v4u*)(vs + r * P2_RP + 8 * cc) = raw.v[i]; }
        if (unit + G < BATCH * MH * NCH) p2_load(a, raw, unit + G, rg, cc);
        __syncthreads();
        { const float ww[8] = {w0.x, w0.y, w0.z, w0.w, w1.x, w1.y, w1.z, w1.w};
#pragma unroll
          for (int q = 0; q < 4; ++q) { const int dk = (tid >> 3) + 64 * q; unsigned hb[8]; float part = 0.f;
#pragma unroll
              for (int e = 0; e < 8; ++e) { const float kv = bf1(ks[(8 * sch + e) * P2_RP + dk]) * ww[e]; hb[e] = f2bf(kv); part += bf1((bf16raw)hb[e]); }
              *(v4u*)(a.KWT + (size_t)unit * 16384 + dk * 64 + 8 * sch) = (v4u){hb[0] | (hb[1] << 16), hb[2] | (hb[3] << 16), hb[4] | (hb[5] << 16), hb[6] | (hb[7] << 16)};
              part = dpp_add<0xB1>(part); part = dpp_add<0x4E>(part); part = dpp_add<0x141>(part);
              if (sch == 0) a.KBAR[(size_t)unit * 256 + dk] = part;
#pragma unroll
              for (int e = 0; e < 8; ++e) hb[e] = vs[(8 * sch + e) * P2_RP + dk];
              *(v4u*)(a.VT + (size_t)unit * 16384 + dk * 64 + 8 * sch) = (v4u){hb[0] | (hb[1] << 16), hb[2] | (hb[3] << 16), hb[4] | (hb[5] << 16), hb[6] | (hb[7] << 16)}; }
#pragma unroll
          for (int cbi = 0; cbi < 2; ++cbi) { const int cb = 2 * (wave & 1) + cbi;
              f32x4 acc = (f32x4){0.f, 0.f, 0.f, 0.f};
              if (cb <= rb) {
#pragma unroll
                  for (int kk = 0; kk < 8; ++kk) { const bf16x8 af = *(const LAS bf16x8*)(ks + (16 * cb + m) * P2_RP + 32 * kk + 8 * kg), bfr = *(const LAS bf16x8*)(qs + (16 * rb + m) * P2_RP + 32 * kk + 8 * kg);
                      acc = __builtin_amdgcn_mfma_f32_16x16x32_bf16(af, bfr, acc, 0, 0, 0); } }
              const int t = 16 * rb + m, s0 = 16 * cb + 4 * kg; const f32x4 cf = cbi ? cf1 : cf0;
              unsigned hb[4]; float sum = 0.f;
#pragma unroll
              for (int r = 0; r < 4; ++r) { const float v = (s0 + r <= t) ? acc[r] * __expf(rf + cf[r]) : 0.f; hb[r] = f2bf(v); sum += bf1((bf16raw)hb[r]); }
              *(v2u*)(a.SP + (size_t)unit * 4096 + t * 64 + s0) = (v2u){hb[0] | (hb[1] << 16), hb[2] | (hb[3] << 16)};
              sum += __shfl_xor(sum, 16); sum += __shfl_xor(sum, 32);
              if (kg == 0) atomicAdd((float*)(dsl + t), sum); } }
        __syncthreads();
        if (tid < 64) a.DSUM[gi0 + tid] = dsl[tid];
    }
}

constexpr int P3_CP = 264, P3_SP = 72;
constexpr int P3W = 128;
constexpr int P3_CT = 0, P3_NL = P3_CT + P3W * P3_CP * 2, P3_QN = P3_NL + 1024, P3_QS = P3_QN + 256, P3_SS = P3_QS + 64 * P3_CP * 2, P3_VS = P3_SS + 64 * P3_SP * 2, P3_GS = P3_VS + 2 * P3W * P3_SP * 2, P3_END = P3_GS + 2 * 768;
static_assert(P3_END <= LDS_MISC, "mLSTM LDS map");
struct P3Args { const bf16raw *QC, *KWT, *VT, *SP; const float *KBAR, *DSUM, *WINT, *EDEN, *DECAY; bf16raw* HR; };
typedef __amdgpu_buffer_rsrc_t rsrc_t;
__device__ __forceinline__ rsrc_t mk_rsrc(const void* p, unsigned nbytes) { return __builtin_amdgcn_make_buffer_rsrc((void*)p, (short)0, (int)nbytes, 0x00020000); }
__device__ __forceinline__ v4u bld(rsrc_t r, unsigned voff, unsigned soff) { return __builtin_bit_cast(v4u, __builtin_amdgcn_raw_buffer_load_b128(r, (int)voff, (int)soff, 0)); }
struct P3Stage { v4u q[4], s, v[2], gt; float decay, kb; };
__device__ __forceinline__ void p3_stage_load(const P3Args& a, rsrc_t rq, rsrc_t rs, rsrc_t rv, P3Stage& g, int bh, int b, int hm, int j, int c, int tid) {
    const unsigned uc = (unsigned)(bh * NCH + c), tok0 = (unsigned)(b * T + 64 * c);
#pragma unroll
    for (int k = 0; k < 4; ++k) g.q[k] = bld(rq, (unsigned)(((tid >> 5) + 16 * k) * 2048 + 512 * hm + 16 * (tid & 31)), tok0 * 2048u);
    g.s = bld(rs, (unsigned)((tid >> 3) * 128 + 16 * (tid & 7)), uc * 8192u);
#pragma unroll
    for (int k = 0; k < 2; ++k) g.v[k] = bld(rv, (unsigned)((P3W * j + (tid >> 3) + 64 * k) * 128 + 16 * (tid & 7)), uc * 32768u);
    g.decay = a.DECAY[uc]; g.kb = (tid < 256) ? a.KBAR[(size_t)uc * 256 + tid] : 0.f;
    if (tid < 48) { const long long o1 = (const char*)a.EDEN - (const char*)a.WINT, o2 = (const char*)a.DSUM - (const char*)a.WINT; const long long go = tid < 16 ? 0ll : (tid < 32 ? o1 : o2);
        g.gt = *(const v4u*)((const char*)a.WINT + go + ((size_t)bh * T + 64 * c + 4 * (tid & 15)) * 4); }
}
__device__ __forceinline__ void p3_stage_write_qs(LAS unsigned char* lds, const P3Stage& g, int tid) {
#pragma unroll
    for (int k = 0; k < 4; ++k) *(LAS v4u*)(lds + P3_QS + ((tid >> 5) + 16 * k) * (P3_CP * 2) + 16 * (tid & 31)) = g.q[k];
    *(LAS v4u*)(lds + P3_SS + (tid >> 3) * (P3_SP * 2) + 16 * (tid & 7)) = g.s;
}
__device__ __forceinline__ void p3_stage_write_v(LAS unsigned char* lds, const P3Stage& g, int buf, int tid) {
    if (tid < 48) *(LAS v4u*)(lds + P3_GS + buf * 768 + 16 * tid) = g.gt;
#pragma unroll
    for (int k = 0; k < 2; ++k) *(LAS v4u*)(lds + P3_VS + buf * (P3W * P3_SP * 2) + ((tid >> 3) + 64 * k) * (P3_SP * 2) + 16 * (tid & 7)) = g.v[k];
}
#define P3_BAR() do { asm volatile("s_waitcnt lgkmcnt(0)" ::: "memory"); __builtin_amdgcn_s_barrier(); asm volatile("" ::: "memory"); } while (0)
__device__ __forceinline__ void p3_mlstm(LAS unsigned char* lds, const P3Args& a, int vcu, int G, int wave, int lane, int tid, unsigned* chkflag = nullptr) {
    if (vcu & 3) return;
    for (int unit = vcu >> 2; unit < BATCH * MH * 2; unit += (G + 3) >> 2) {
        const int bh = unit >> 1, j = unit & 1, b = bh >> 2, hm = bh & 3;
        const int rb = wave >> 2, cg = wave & 3, m32 = lane & 31, hh = lane >> 5;
        f32x16 accC[4];
#pragma unroll
        for (int ti = 0; ti < 4; ++ti)
#pragma unroll
            for (int r = 0; r < 16; ++r) accC[ti][r] = 0.f;
        float nst = 0.f;
        const rsrc_t rq = mk_rsrc(a.QC, 0x8000000u), rs = mk_rsrc(a.SP, 0x2000000u), rv = mk_rsrc(a.VT, 0x8000000u), rk = mk_rsrc(a.KWT, 0x8000000u);
        __syncthreads();
        for (int i = tid; i < (P3_QS - P3_CT) / 4; i += NTHR) ((LAS unsigned*)(lds + P3_CT))[i] = 0u;
        P3Stage sg; p3_stage_load(a, rq, rs, rv, sg, bh, b, hm, j, 0, tid);
        p3_stage_write_qs(lds, sg, tid); p3_stage_write_v(lds, sg, 0, tid);
        float decay = sg.decay, kb = sg.kb;
        p3_stage_load(a, rq, rs, rv, sg, bh, b, hm, j, 1, tid);
        bf16x8 kA[4];
#pragma unroll
        for (int kk = 0; kk < 4; ++kk) kA[kk] = __builtin_bit_cast(bf16x8, bld(rk, (unsigned)((32 * wave + m32) * 128 + 32 * kk + 16 * hh), (unsigned)(bh * NCH) * 32768u));
        __syncthreads();
        for (int c = 0; c < NCH; ++c) {
            const int vb = c & 1; const unsigned uc = (unsigned)(bh * NCH + c); const size_t tok0 = (size_t)b * T + 64 * c, gi0 = (size_t)bh * T + 64 * c;
            { const int t = tid >> 3, part = tid & 7; float s = 0.f;
#pragma unroll
              for (int q4 = 0; q4 < 4; ++q4) { const v4u qv = *(const LAS v4u*)(lds + P3_QS + t * (P3_CP * 2) + part * 64 + 16 * q4);
                  const f32x4 n0 = *(const LAS f32x4*)(lds + P3_NL + (32 * part + 8 * q4) * 4), n1 = *(const LAS f32x4*)(lds + P3_NL + (32 * part + 8 * q4 + 4) * 4);
                  s += bflo(qv.x) * n0.x + bfhi(qv.x) * n0.y + bflo(qv.y) * n0.z + bfhi(qv.y) * n0.w + bflo(qv.z) * n1.x + bfhi(qv.z) * n1.y + bflo(qv.w) * n1.z + bfhi(qv.w) * n1.w; }
              s = dpp_add<0xB1>(s); s = dpp_add<0x4E>(s); s = dpp_add<0x141>(s);
              if (part == 0) *(LAS float*)(lds + P3_QN + 4 * t) = s; }
            f32x16 accQ, accS;
#pragma unroll
            for (int r = 0; r < 16; ++r) { accQ[r] = 0.f; accS[r] = 0.f; }
#pragma unroll
            for (int kk = 0; kk < 16; ++kk) { const bf16x8 af = *(const LAS bf16x8*)(lds + P3_QS + (32 * rb + m32) * (P3_CP * 2) + 32 * kk + 16 * hh), bf = *(const LAS bf16x8*)(lds + P3_CT + (32 * cg + m32) * (P3_CP * 2) + 32 * kk + 16 * hh);
                accQ = __builtin_amdgcn_mfma_f32_32x32x16_bf16(af, bf, accQ, 0, 0, 0); }
#pragma unroll
            for (int kk = 0; kk < 4; ++kk) { const bf16x8 af = *(const LAS bf16x8*)(lds + P3_SS + (32 * rb + m32) * (P3_SP * 2) + 32 * kk + 16 * hh), bf = *(const LAS bf16x8*)(lds + P3_VS + vb * (P3W * P3_SP * 2) + (32 * cg + m32) * (P3_SP * 2) + 32 * kk + 16 * hh);
                accS = __builtin_amdgcn_mfma_f32_32x32x16_bf16(af, bf, accS, 0, 0, 0); }
            P3_BAR();
            p3_stage_write_qs(lds, sg, tid); p3_stage_write_v(lds, sg, vb ^ 1, tid);
            const float decay_n = sg.decay, kb_n = sg.kb;
            p3_stage_load(a, rq, rs, rv, sg, bh, b, hm, j, c + 2 < NCH ? c + 2 : NCH - 1, tid);
#pragma unroll
            for (int g = 0; g < 4; ++g) { const f32x4 qn = *(const LAS f32x4*)(lds + P3_QN + (32 * rb + 8 * g + 4 * hh) * 4);
                const int ro = (32 * rb + 8 * g + 4 * hh) * 4; const f32x4 wi = *(const LAS f32x4*)(lds + P3_GS + vb * 768 + ro), ed = *(const LAS f32x4*)(lds + P3_GS + vb * 768 + 256 + ro), ds = *(const LAS f32x4*)(lds + P3_GS + vb * 768 + 512 + ro);
#pragma unroll
                for (int i = 0; i < 4; ++i) { const float den = ds[i] + wi[i] * qn[i]; const float hv = (accS[4 * g + i] + wi[i] * accQ[4 * g + i]) * __builtin_amdgcn_rcpf(fmaxf(fabsf(den), ed[i]));
                    { bf16raw* hp = a.HR + (tok0 + 32 * rb + 8 * g + 4 * hh + i) * D + 256 * hm + P3W * j + 32 * cg + m32; const bf16raw hb = (bf16raw)pk2(hv, 0.f);
                      if (chkflag) { if (*hp != hb) atomicOr(chkflag, 1u << (c & 31)); } else *hp = hb; } } }
#pragma unroll
            for (int ti = 0; ti < 4; ++ti) {
#pragma unroll
                for (int r = 0; r < 16; ++r) accC[ti][r] *= decay;
#pragma unroll
                for (int kk = 0; kk < 4; ++kk) { const bf16x8 bf = *(const LAS bf16x8*)(lds + P3_VS + vb * (P3W * P3_SP * 2) + (32 * ti + m32) * (P3_SP * 2) + 32 * kk + 16 * hh);
                    accC[ti] = __builtin_amdgcn_mfma_f32_32x32x16_bf16(kA[kk], bf, accC[ti], 0, 0, 0); }
#pragma unroll
                for (int g = 0; g < 4; ++g) *(LAS v2u*)(lds + P3_CT + (32 * ti + m32) * (P3_CP * 2) + (32 * wave + 8 * g + 4 * hh) * 2) = (v2u){pk2(accC[ti][4 * g], accC[ti][4 * g + 1]), pk2(accC[ti][4 * g + 2], accC[ti][4 * g + 3])}; }
            { const unsigned un = (unsigned)(bh * NCH + (c + 1 < NCH ? c + 1 : c));
#pragma unroll
              for (int kk = 0; kk < 4; ++kk) kA[kk] = __builtin_bit_cast(bf16x8, bld(rk, (unsigned)((32 * wave + m32) * 128 + 32 * kk + 16 * hh), un * 32768u)); }
            if (tid < 256) { nst = decay * nst + kb; *(LAS float*)(lds + P3_NL + 4 * tid) = nst; }
            decay = decay_n; kb = kb_n;
            P3_BAR();
        }
    }
}
#ifndef DBG_STAGE
#define DBG_STAGE 3
#endif
#ifndef FP8A
#define FP8A 1
#endif
#ifndef FP8B
#define FP8B 1
#endif
#ifndef FP8C
#define FP8C 1
#endif
#ifndef MK_ONE_LAUNCH
#define MK_ONE_LAUNCH 0
#endif
#ifndef PROBE_DUP
#define PROBE_DUP -1
#endif
#define NREP(k) ((PROBE_DUP == (k)) ? 2 : 1)
constexpr int NPH = 20;
struct Args { const float* in[16]; float* out; unsigned char* ws; int ph_lo, ph_hi; };
__global__ void __launch_bounds__(NTHR, 2) fwd(Args args) {
    extern __shared__ __attribute__((aligned(16))) unsigned char lds_raw[];
    LAS unsigned char* lds = (LAS unsigned char*)lds_raw;
#define PH_IDS int tid = threadIdx.x; asm volatile("" : "+v"(tid)); const int lane = tid & 63; (void)lane; const int wave = __builtin_amdgcn_readfirstlane(tid >> 6); \
    const __attribute__((address_space(4))) Args* ap_ = (const __attribute__((address_space(4))) Args*)__builtin_amdgcn_kernarg_segment_ptr(); asm volatile("" : "+s"(ap_)); \
    int G = gridDim.x; asm volatile("" : "+s"(G)); const int bx = blockIdx.x, vcu = (G % 8 == 0) ? (bx % 8) * (G / 8) + bx / 8 : bx; const int gw = vcu * NWAVES + wave, NGW = G * NWAVES; (void)gw; (void)NGW;
    if (threadIdx.x < 4) ((LAS unsigned*)(lds + LDS_MISC))[threadIdx.x] = 0u;
    __syncthreads();
#if MK_ONE_LAUNCH
    XcdBarrier bar = xcd_barrier_post((unsigned*)(args.ws + WS_CTL) + CW_BAR, (volatile LAS unsigned*)(lds + LDS_MISC));
#define GRID_BAR() xcd_barrier(bar)
#else
#define GRID_BAR() do {} while (0)
#endif
#define A_x ((const float*)ap_->in[0])
#define A_n1g ((const float*)ap_->in[1])
#define A_w_in ((const float*)ap_->in[2])
#define A_b_in ((const float*)ap_->in[3])
#define A_conv_w ((const float*)ap_->in[4])
#define A_mng ((const float*)ap_->in[5])
#define A_qng ((const float*)ap_->in[6])
#define A_kng ((const float*)ap_->in[7])
#define A_wm ((const float*)ap_->in[8])
#define A_wf ((const float*)ap_->in[9])
#define A_wo ((const float*)ap_->in[10])
#define A_n2g ((const float*)ap_->in[11])
#define A_wpq ((const float*)ap_->in[12])
#define A_skeys ((const float*)ap_->in[13])
#define A_utab ((const float*)ap_->in[14])
#define A_vtab ((const float*)ap_->in[15])
#define A_out (ap_->out)
#define RB(i) ((bf16raw*)(ap_->ws + WS_R0 + (size_t)(i) * RSZ))
#define A_O0 ((bf16raw*)ap_->out)
#define A_O1 ((bf16raw*)((unsigned char*)ap_->out + RSZ))
#define A_WinT ((bf16raw*)(ap_->ws + WS_WINT))
#define A_WinTb ((bf16raw*)(ap_->ws + 208 * MiB))
#define A_SH ((float*)(ap_->ws + WS_JLO + 65536))
#define A_SW ((float*)(ap_->ws + 13 * MiB + 163840))
#define A_SX ((float*)(ap_->ws + WS_JLO + 65536 + 262144))
#define A_SHM ((float*)(ap_->ws + WS_WGT))
#define A_XQ ((signed char*)RB(3))
#define A_XH ((unsigned char*)RB(3) + 64 * MiB)
#define A_XL ((unsigned char*)RB(3) + 96 * MiB)
#define A_SU ((const float*)((unsigned char*)A_UB + 16 * MiB))
#define A_SV ((const float*)((unsigned char*)A_VB + 16 * MiB))
#define A_W8 ((unsigned char*)A_VB + 24 * MiB)
#define A_WSC ((float*)((unsigned char*)A_VB + 40 * MiB))
#define A_WgT ((bf16raw*)(ap_->ws + WS_WGT))
#define A_WmT ((bf16raw*)(ap_->ws + WS_WMT))
#define A_WfT ((bf16raw*)(ap_->ws + WS_WFT))
#define A_WoT ((bf16raw*)(ap_->ws + WS_WOT))
#define A_WpqT ((bf16raw*)(ap_->ws + WS_WPQT))
#define A_SKB ((bf16raw*)(ap_->ws + WS_SKB))
#define A_UB ((bf16raw*)(ap_->ws + WS_UB))
#define A_VB ((bf16raw*)(ap_->ws + WS_VB))
#define A_biasP ((float*)(ap_->ws + WS_BIASP))
#define A_biasG ((float*)(ap_->ws + WS_BIASG))
#define A_Z16 ((float*)(ap_->ws + WS_Z16))
#define A_CS ((float*)(ap_->ws + WS_CS))
#define A_ROWF ((float*)(ap_->ws + WS_GROWF))
#define A_COLF ((float*)(ap_->ws + WS_GCOLF))
#define A_WINT ((float*)(ap_->ws + WS_GWINT))
#define A_EDEN ((float*)(ap_->ws + WS_GEDEN))
#define A_WSW ((float*)(ap_->ws + WS_GWSW))
#define A_DECAY ((float*)(ap_->ws + WS_GDECAY))
#define A_KBAR ((float*)(ap_->ws + WS_KBAR))
#define A_DSUM ((float*)(ap_->ws + WS_DSUM))
#define A_SP ((bf16raw*)(ap_->ws + WS_SP))
#define A_IDS ((unsigned short*)(ap_->ws + WS_IDS))
#define A_GWT ((float*)(ap_->ws + WS_GW))
#define A_JLO ((int*)(ap_->ws + WS_JLO))
#define A_DQK ((float*)(ap_->ws + 208 * MiB + 32 * MiB))
#define A_H8 ((unsigned char*)(ap_->ws + WS_IDS))
    const int lo = args.ph_lo, hi = args.ph_hi;
#define IN(k) (lo <= (k) && (k) < hi)
#define SEAM(k) do { if (IN((k) + 1)) GRID_BAR(); } while (0)
    constexpr size_t RS_E = RSZ / 2;

    if (IN(0)) { PH_IDS P0Args a{A_x, A_n1g, A_w_in, A_b_in, A_wm, A_wf, A_wo, A_wpq, A_skeys, A_utab, A_vtab, A_WinT, A_WgT, A_WmT, A_WfT, A_WoT, A_WpqT, A_SKB, A_UB, A_VB, RB(0), A_biasP, A_biasG, A_H8, A_WinTb, A_SH, (unsigned*)(ap_->ws + WS_CTL) + CW_CMAX};
        for (int rep = 0; rep < NREP(0); ++rep) { p0_prologue(lds, a, vcu, G, wave, lane, tid); __syncthreads(); } SEAM(0); }
    if (IN(1)) { PH_IDS p0b_quant_w(lds, A_w_in, A_wpq, A_wm, (signed char*)A_WinT, A_SW, (const unsigned*)(ap_->ws + WS_CTL) + CW_CMAX, gw, NGW, wave, lane); SEAM(1); }
    if (IN(2)) { PH_IDS
        { pg8::Gemm g{(const bf16raw*)A_H8, A_WinT + (size_t)12288 * D / 2, M, 256, D / 2}; pg8::StaticOrder S; S.init(M, 256, G, bx); pg8::EpiGates16I8 E{A_Z16, A_biasG, A_SW + 12288, A_SH};
          pg8::gemm_phase<pg8::EpiGates16I8, pg8::StaticOrder, false, true, 2>(lds, g, S, E); }
        SEAM(2); }
    if (IN(3)) { PH_IDS
        if (bx * NWAVES + wave < BATCH * (MH + FH)) { ScanArgs a{A_Z16, A_CS, A_ROWF, A_COLF, A_WINT, A_EDEN, A_WSW, A_DECAY}; p_scans(a, bx * NWAVES + wave, lane); }
        __syncthreads();
        { pg8::Gemm g{(const bf16raw*)A_H8, A_WinT, M, 3072, D / 2}; pg8::QueueOrder S; S.init(M, 3072, (unsigned*)(ap_->ws + WS_CTL) + CW_QM, (int)xb_xcc_id(), (LAS int*)(lds + LDS_MISC + 64)); S.prime(); __syncthreads();
          pg8::EpiI8 E{RB(1), D, A_biasP, A_SW, A_SH, RS_E};
          pg8::gemm_phase<pg8::EpiI8, pg8::QueueOrder, true, true, 2>(lds, g, S, E); }
        SEAM(3); }
    if (IN(4)) { PH_IDS
#if DBG_STAGE >= 2
        P2Args a{RB(1), RB(2), RB(3), A_conv_w, RB(4), RB(5), A_O0, A_SP, A_KBAR, A_DSUM, A_ROWF, A_COLF, A_WSW}; for (int rep = 0; rep < NREP(3); ++rep) p2_prep(lds, a, vcu, G, wave, lane, tid);
#endif
        SEAM(4); }
    if (IN(5)) { PH_IDS
#if FP8B
pg8::Gemm g{(const bf16raw*)A_H8, A_WinT + (size_t)3072 * D / 2, M, 3072, D / 2}; pg8::StaticOrder S; S.init(M, 3072, G, bx); pg8::EpiI8 E{RB(1), D, A_biasP + 3072, A_SW + 3072, A_SH, RS_E};
        pg8::gemm_phase<pg8::EpiI8, pg8::StaticOrder, true, true, 2>(lds, g, S, E);
#else
pg8::Gemm g{RB(0), A_WinTb + (size_t)3072 * D, M, 3072, D}; pg8::StaticOrder S; S.init(M, 3072, G, bx); pg8::EpiBf16<0> E{RB(1), D, A_biasP + 3072, 1024, RS_E, 1.f};
        pg8::gemm_phase<pg8::EpiBf16<0>, pg8::StaticOrder, true, true>(lds, g, S, E);
#endif
 SEAM(5); }
    if (IN(6)) { PH_IDS
        const float qkmax = fox::jlo_qkmax(A_qng, A_kng, lane);
        for (int tb = vcu; tb < M / 256; tb += G) { const int r0 = 256 * tb + 32 * wave;
            fox::JloPre jp; fox::jlo_pre(A_CS, tb >> 5, wave, tb & 31, lane, jp);
            p2b_qknorm<true>(RB(1), RB(2), A_qng, A_kng, nullptr, r0, 1, lane, r0 + 32, (LAS float*)lds, 256 * tb);
            __syncthreads();
            fox::jlo_block(jp, (const LAS float*)lds, qkmax, A_JLO, tb >> 5, wave, tb & 31, lane);
            __syncthreads(); }
        SEAM(7); }
    if (IN(8)) { PH_IDS
#if DBG_STAGE >= 2
        { P3Args a{RB(4), RB(5), A_O0, A_SP, A_KBAR, A_DSUM, A_WINT, A_EDEN, A_DECAY, A_O1}; { const int nrep = (PROBE_DUP == 60) ? (args.ph_hi - 18) : 1;
_Pragma("nounroll")
          for (int rep = 0; rep < nrep; ++rep) { p3_mlstm(lds, a, vcu, G, wave, lane, tid, rep ? (unsigned*)(ap_->ws + WS_CTL) + 16 : (unsigned*)nullptr); asm volatile("s_waitcnt vmcnt(0)" ::: "memory"); __syncthreads(); } } }
        __syncthreads();
#ifdef T1_BAR
        GRID_BAR();
#endif
#endif
        if (PROBE_DUP == 61) { fox::phase((char*)lds_raw, (const fox::bf16*)RB(1), (const fox::bf16*)RB(2), (const fox::bf16*)RB(3), (fox::bf16*)RB(0), A_CS, A_JLO, (unsigned*)(ap_->ws + WS_CTL) + CW_QF + 2048, (int)xb_xcc_id()); __syncthreads(); }
        fox::phase((char*)lds_raw, (const fox::bf16*)RB(1), (const fox::bf16*)RB(2), (const fox::bf16*)RB(3), (fox::bf16*)RB(1), A_CS, A_JLO, (unsigned*)(ap_->ws + WS_CTL) + CW_QF, (int)xb_xcc_id(), (unsigned*)(ap_->ws + WS_CTL) + CW_FDONE);
        __syncthreads();
        { pg8::Gemm g{(const bf16raw*)A_H8, A_WinT + (size_t)6144 * D / 2, M, 3072, D / 2}; pg8::QueueOrderGf S; S.init(M, 3072, (unsigned*)(ap_->ws + WS_CTL) + CW_QG, (int)xb_xcc_id(), (LAS int*)(lds + LDS_MISC + 64));
          S.fd = (const unsigned*)(ap_->ws + WS_CTL) + CW_FDONE; S.fd_goal = 2048u; S.pn_wait = 8; S.prime(); __syncthreads();
          pg8::EpiQ8 E{(signed char*)RB(0), D, A_biasP + 6144, A_SW + 6144, A_SH, (size_t)64 * MiB, 3 * RSZ};
          pg8::gemm_phase<pg8::EpiQ8, pg8::QueueOrderGf, true, true, 2>(lds, g, S, E); }
        SEAM(8); }
    if (IN(10)) { PH_IDS
#if DBG_STAGE >= 2
        for (int rep = 0; rep < NREP(8); ++rep) p4_hmnorm(A_O1, (const signed char*)RB(0), A_mng, (signed char*)RB(2), A_SHM, gw, M, NGW, lane);
#endif
        SEAM(10); }
    if (IN(11)) { PH_IDS
        pg8::Gemm g0{RB(2), A_WinT + (size_t)11264 * D / 2, M, D, D / 2}, g1{RB(1), A_WfT, M, D, D}; pg8::StaticOrder S; S.init(M, D, G, bx);
        pg8::gemm_dual(lds, g0, g1, S, (const signed char*)RB(0) + 64 * MiB, (const signed char*)RB(3), A_SW + 11264, A_SHM, RB(5), D);
        SEAM(12); }
    if (IN(13)) { PH_IDS pg8::Gemm g{RB(5), A_WoT, M, D, D}; pg8::StaticOrder S; S.init(M, D, G, bx); pg8::EpiResB16 E{A_x, RB(0), D};
        pg8::gemm_phase<pg8::EpiResB16, pg8::StaticOrder, true, true>(lds, g, S, E); SEAM(13); }
#if DBG_STAGE >= 3
    if (IN(14)) { PH_IDS for (int rep = 0; rep < NREP(12); ++rep) rms_rows_phase_b16(RB(0), A_n2g, gw, M, NGW, lane, (unsigned char*)A_XQ, A_SX, A_XH, A_XL); SEAM(14); }
    if (IN(15)) { PH_IDS pg8::Gemm g{(const bf16raw*)A_XQ, A_WinT + (size_t)9216 * D / 2, M, 2048, D / 2}; pg8::StaticOrder S; S.init(M, 2048, G, bx); pg8::EpiI8 E{RB(1), 2048, nullptr, A_SW + 9216, A_SX, 0};
        pg8::gemm_phase<pg8::EpiI8, pg8::StaticOrder, true, true, 2>(lds, g, S, E); SEAM(15); }
    if (IN(16)) { PH_IDS P9Args a{RB(1), A_SKB, A_IDS, A_GWT}; for (int rep = 0; rep < NREP(14); ++rep) p9_topk(lds, a, vcu, G, wave, lane, tid); SEAM(16); }
    if (IN(17)) { PH_IDS if (PROBE_DUP == 15) p15_udot(A_XH, A_XL, (const unsigned char*)A_UB, A_IDS, (short*)RB(1), (unsigned*)(ap_->ws + WS_CTL) + CW_QU + 2048, (int)xb_xcc_id(), lane);
        p15_udot(A_XH, A_XL, (const unsigned char*)A_UB, A_IDS, (short*)RB(1), (unsigned*)(ap_->ws + WS_CTL) + CW_QU, (int)xb_xcc_id(), lane); SEAM(17); }
    if (IN(18)) { PH_IDS p15b_act((const short*)RB(1), A_GWT, A_W8, A_WSC, A_SX, A_SU, A_SV, A_IDS, gw, NGW, lane); SEAM(18); }
#ifndef PROBE_VMODE
#define PROBE_VMODE 0
#endif
    if (IN(19)) { PH_IDS if (PROBE_DUP == 17) p16_vsum<PROBE_VMODE>(lds, (const unsigned char*)A_VB, A_IDS, A_W8, A_WSC, RB(0), (float*)RB(2), (unsigned*)(ap_->ws + WS_CTL) + CW_QV + 2048, (int)xb_xcc_id(), wave, lane);
        p16_vsum(lds, (const unsigned char*)A_VB, A_IDS, A_W8, A_WSC, RB(0), A_out, (unsigned*)(ap_->ws + WS_CTL) + CW_QV, (int)xb_xcc_id(), wave, lane); }
#endif
#undef IN
#undef SEAM
}

extern "C" void kernel_launch(void* const* d_in, const int* in_sizes, int n_in, void* d_out, int out_size, void* d_ws, size_t ws_size, hipStream_t stream) {
    static int grid = 0;
    if (grid == 0) {
        if (n_in != 16 || out_size != M * D || ws_size < WS_END) { fprintf(stderr, "kernel_launch: unexpected shapes (n_in %d out %d ws %zu)\n", n_in, out_size, ws_size); grid = -1; return; }
        int dev = 0, cus = 0, per_cu = 0;
        if (hipGetDevice(&dev) != hipSuccess || hipDeviceGetAttribute(&cus, hipDeviceAttributeMultiprocessorCount, dev) != hipSuccess) { grid = -1; return; }
        if (hipFuncSetAttribute((const void*)fwd, hipFuncAttributeMaxDynamicSharedMemorySize, LDS_BYTES) != hipSuccess) { fprintf(stderr, "kernel_launch: hipFuncSetAttribute failed\n"); grid = -1; return; }
        if (hipOccupancyMaxActiveBlocksPerMultiprocessor(&per_cu, (const void*)fwd, NTHR, LDS_BYTES) != hipSuccess || per_cu < 1) { fprintf(stderr, "kernel_launch: occupancy query says %d\n", per_cu); grid = -1; (void)hipGetLastError(); return; }
        (void)hipGetLastError();
        grid = cus;
    }
    if (grid < 0) return;
    if (hipMemsetAsync((char*)d_ws + WS_CTL, 0, CTL_ZERO_BYTES, stream) != hipSuccess) return;
    Args a{};
    for (int i = 0; i < 16; ++i) a.in[i] = (const float*)d_in[i];
    a.out = (float*)d_out; a.ws = (unsigned char*)d_ws;
#if MK_ONE_LAUNCH
    a.ph_lo = 0; a.ph_hi = NPH;
    hipLaunchKernelGGL(fwd, dim3(grid), dim3(NTHR), LDS_BYTES, stream, a);
#else
    for (int p = 0; p < NPH; ++p) { a.ph_lo = p; a.ph_hi = p + 1; hipLaunchKernelGGL(fwd, dim3(grid), dim3(NTHR), LDS_BYTES, stream, a); }
#endif
}
```
